# Optimizing an MI355X kernel written in HIP

```python
import math
import jax, jax.numpy as jnp
from jax import lax
import numpy as np

D_MODEL = 1024
BATCH = 16
SEQ = 2048
DEPTH = 2

D_MIX = D_MODEL
W_CONV = D_MIX // 4
W_GLA = D_MIX // 4
W_SSD = D_MIX // 4
W_DIFF = D_MIX - W_CONV - W_GLA - W_SSD

CONV_K = 3

GLA_HEADS = 4
GLA_DV = W_GLA // GLA_HEADS
GLA_DK = GLA_DV // 2
GLA_RANK = 16
GLA_TAU = 16.0
GLA_CHUNK = 64

SSD_HEADDIM = 64
SSD_HEADS = W_SSD // SSD_HEADDIM
SSD_GROUPS = 2
SSD_STATE = 128
SSD_CONV_K = 4
SSD_CHUNK = 128
SSD_XBC = W_SSD + 2 * SSD_GROUPS * SSD_STATE

DIFF_HEADS = 4
DIFF_DV = W_DIFF // DIFF_HEADS
DIFF_DQK = DIFF_DV // 2
ATTN_BLOCK = 128

N_GROUPS = 4
EXPERTS_PER_GROUP = 8
N_EXPERTS = N_GROUPS * EXPERTS_PER_GROUP
TOP_K = 2
D_EXPERT = 512
MOE_BLOCK = 128

DEEPNORM_ALPHA = (2 * DEPTH) ** 0.25
DEEPNORM_BETA = (8 * DEPTH) ** -0.25
LN_EPS = 1e-5
RMS_EPS = 1e-6

SPLIT_SIZES = (
    W_CONV, W_CONV, W_CONV,
    GLA_HEADS * GLA_DK, GLA_HEADS * GLA_DK,
    GLA_HEADS * GLA_DV, GLA_HEADS * GLA_DV, GLA_RANK,
    W_SSD, SSD_XBC, SSD_HEADS,
    DIFF_HEADS * 2 * DIFF_DQK, DIFF_HEADS * 2 * DIFF_DQK,
    DIFF_HEADS * DIFF_DV,
)
P_IN = sum(SPLIT_SIZES)

kernel_name = 'hybrid_parallel_heads_hmoe_deepnorm'


def layer_norm(x, g, b):
    xf = x.astype(jnp.float32)
    mu = jnp.mean(xf, axis=-1, keepdims=True)
    var = jnp.mean(jnp.square(xf - mu), axis=-1, keepdims=True)
    return ((xf - mu) * lax.rsqrt(var + LN_EPS) * g + b).astype(x.dtype)


def rms_norm(x, g):
    xf = x.astype(jnp.float32)
    return xf * lax.rsqrt(jnp.mean(jnp.square(xf), axis=-1, keepdims=True) + RMS_EPS) * g


def split_cols(p, sizes):
    outs, off = [], 0
    for sz in sizes:
        outs.append(p[..., off:off + sz])
        off += sz
    return outs


def causal_dwconv(x, w, b=None):
    k_w, s = w.shape[0], x.shape[1]
    xp = jnp.pad(x.astype(jnp.float32), ((0, 0), (k_w - 1, 0), (0, 0)))
    y = sum(xp[:, k:k + s] * w[k] for k in range(k_w))
    return y if b is None else y + b


def short_conv_mixer(u, gate_b, gate_c, conv_w):
    return gate_b.astype(jnp.float32) * causal_dwconv(gate_c * u, conv_w)


def gla_mixer(q, k, v, g, lr, w_lr, b_lr, norm_g):
    bsz, s, _ = q.shape
    h, dk, dv, c = GLA_HEADS, GLA_DK, GLA_DV, GLA_CHUNK
    nc = s // c
    f32 = jnp.float32
    q = q.astype(f32).reshape(bsz, nc, c, h, dk) * dk ** -0.5
    k = k.astype(f32).reshape(bsz, nc, c, h, dk)
    v = v.astype(f32).reshape(bsz, nc, c, h, dv)
    log_a = jax.nn.log_sigmoid(lr.astype(f32) @ w_lr.astype(f32) + b_lr) / GLA_TAU
    cum = jnp.cumsum(log_a.reshape(bsz, nc, c, h, dk), axis=2)
    cum_last = cum[:, :, -1]
    q_dec = q * jnp.exp(cum)
    k_inv = k * jnp.exp(-cum)
    causal = jnp.tril(jnp.ones((c, c), bool))
    att = jnp.where(causal, jnp.einsum('bnihd,bnjhd->bnhij', q_dec, k_inv), 0.0)
    o_intra = jnp.einsum('bnhij,bnjhe->bnihe', att, v)
    k_end = k * jnp.exp(cum_last[:, :, None] - cum)
    d_state = jnp.einsum('bnjhd,bnjhe->bnhde', k_end, v)

    def step(state, inp):
        dec, ds = inp
        return dec[..., None] * state + ds, state

    _, s_prev = lax.scan(step, jnp.zeros((bsz, h, dk, dv), f32),
                         (jnp.moveaxis(jnp.exp(cum_last), 1, 0), jnp.moveaxis(d_state, 1, 0)))
    s_prev = jnp.moveaxis(s_prev, 0, 1)
    o = o_intra + jnp.einsum('bnihd,bnhde->bnihe', q_dec, s_prev)
    o = rms_norm(o.reshape(bsz, s, h, dv), norm_g).reshape(bsz, s, h * dv)
    return o * jax.nn.silu(g.astype(f32))


def ssd_mixer(z, xbc, dt, conv_w, conv_b, a_log, d_skip, dt_bias, norm_g):
    bsz, s, _ = z.shape
    g, r, p, n, c = SSD_GROUPS, SSD_HEADS // SSD_GROUPS, SSD_HEADDIM, SSD_STATE, SSD_CHUNK
    nc = s // c
    f32 = jnp.float32
    xbc = jax.nn.silu(causal_dwconv(xbc, conv_w, conv_b))
    xs, bm, cm = split_cols(xbc, (W_SSD, g * n, g * n))
    x = xs.reshape(bsz, nc, c, g, r, p)
    bm = bm.reshape(bsz, nc, c, g, n)
    cm = cm.reshape(bsz, nc, c, g, n)
    dt = jax.nn.softplus(dt.astype(f32) + dt_bias).reshape(bsz, nc, c, g, r)
    a = -jnp.exp(a_log.astype(f32)).reshape(g, r)
    cum = jnp.cumsum(dt * a, axis=2)
    cum_t = jnp.moveaxis(cum, 2, -1)
    causal = jnp.tril(jnp.ones((c, c), bool))
    decay = jnp.exp(jnp.where(causal, cum_t[..., :, None] - cum_t[..., None, :], -jnp.inf))
    x_dt = x * dt[..., None]
    cb = jnp.einsum('bcign,bcjgn->bcgij', cm, bm)
    y_diag = jnp.einsum('bcgij,bcgrij,bcjgrp->bcigrp', cb, decay, x_dt)
    cum_last = cum[:, :, -1]
    st = jnp.einsum('bcjgn,bcjgr,bcjgrp->bcgrpn', bm, jnp.exp(cum_last[:, :, None] - cum), x_dt)

    def step(state, inp):
        dec, ds = inp
        return dec[..., None, None] * state + ds, state

    _, s_prev = lax.scan(step, jnp.zeros((bsz, g, r, p, n), f32),
                         (jnp.moveaxis(jnp.exp(cum_last), 1, 0), jnp.moveaxis(st, 1, 0)))
    s_prev = jnp.moveaxis(s_prev, 0, 1)
    y_off = jnp.einsum('bcign,bcgrpn,bcigr->bcigrp', cm, s_prev, jnp.exp(cum))
    y = y_diag + y_off + x * d_skip.astype(f32).reshape(g, r)[..., None]
    y = y.reshape(bsz, s, W_SSD) * jax.nn.silu(z.astype(f32))
    y = rms_norm(y.reshape(bsz, s, g, W_SSD // g), norm_g.reshape(g, W_SSD // g))
    return y.reshape(bsz, s, W_SSD)


def diff_attention(q, k, v, lq1, lk1, lq2, lk2, norm_g, layer_idx):
    bsz, s, _ = q.shape
    h, dqk, dv, bq = DIFF_HEADS, DIFF_DQK, DIFF_DV, ATTN_BLOCK
    f32 = jnp.float32
    q = q.astype(f32).reshape(bsz, s, h, 2, dqk) * dqk ** -0.5
    k = k.astype(f32).reshape(bsz, s, h, 2, dqk)
    v = v.astype(f32).reshape(bsz, s, h, dv)
    lam_init = 0.8 - 0.6 * math.exp(-0.3 * layer_idx)
    lam = (jnp.exp(jnp.sum(lq1.astype(f32) * lk1)) - jnp.exp(jnp.sum(lq2.astype(f32) * lk2))
           + lam_init)
    k_pos = jnp.arange(s)

    def block(i):
        qb = lax.dynamic_slice_in_dim(q, i * bq, bq, axis=1)
        q_pos = i * bq + jnp.arange(bq)
        sc = jnp.einsum('bqhcd,bkhcd->bhcqk', qb, k)
        sc = jnp.where(k_pos[None, :] <= q_pos[:, None], sc, -jnp.inf)
        pr = jax.nn.softmax(sc, axis=-1)
        w = pr[:, :, 0] - lam * pr[:, :, 1]
        return jnp.einsum('bhqk,bkhe->bqhe', w, v)

    o = lax.map(block, jnp.arange(s // bq))
    o = jnp.moveaxis(o, 0, 1).reshape(bsz, s, h, dv)
    o = rms_norm(o, norm_g) * (1.0 - lam_init)
    return o.reshape(bsz, s, h * dv)


def expert_dispatch(xf, expert, gate, w_gate, w_up, w_down):
    t, d = xf.shape
    k_sel = expert.shape[1]
    n_assign = t * k_sel
    e_n, blk = N_EXPERTS, MOE_BLOCK
    n_blocks = (n_assign + e_n * (blk - 1) + blk - 1) // blk
    n_slots = n_blocks * blk
    flat_e = expert.reshape(n_assign)
    order = jnp.argsort(flat_e)
    sorted_e = flat_e[order]
    counts = jnp.bincount(flat_e, length=e_n)
    padded = (counts + blk - 1) // blk * blk
    pad_end = jnp.cumsum(padded)
    pad_start = pad_end - padded
    start = jnp.cumsum(counts) - counts
    dest = pad_start[sorted_e] + (jnp.arange(n_assign) - start[sorted_e])
    slot_tok = jnp.full((n_slots,), t, jnp.int32).at[dest].set((order // k_sel).astype(jnp.int32))
    slot_gate = jnp.zeros((n_slots,), gate.dtype).at[dest].set(gate.reshape(n_assign)[order])
    block_e = jnp.minimum(jnp.searchsorted(pad_end, jnp.arange(n_blocks) * blk, side='right'), e_n - 1)
    x_pad = jnp.concatenate([xf, jnp.zeros((1, d), xf.dtype)], axis=0)

    def run_block(args):
        tok, e = args
        xb = x_pad[tok]
        hb = jax.nn.silu(xb @ w_gate[e]) * (xb @ w_up[e])
        return hb @ w_down[e]

    y = lax.map(run_block, (slot_tok.reshape(n_blocks, blk), block_e)).reshape(n_slots, d)
    y = y * slot_gate[:, None].astype(y.dtype)
    return jnp.zeros((t + 1, d), y.dtype).at[slot_tok].add(y)[:t]


def hierarchical_moe(x, router_g, router_e, w_gate, w_up, w_down):
    bsz, s, d = x.shape
    t = bsz * s
    xf = x.reshape(t, d)
    g_prob = jax.nn.softmax((xf @ router_g).astype(jnp.float32), axis=-1)
    p_grp, grp = lax.top_k(g_prob, 1)
    e_logits = jnp.einsum('td,dge->tge', xf, router_e).astype(jnp.float32)
    e_logits = jnp.take_along_axis(
        e_logits, jnp.broadcast_to(grp[:, :, None], (t, 1, EXPERTS_PER_GROUP)), axis=1)[:, 0]
    p_exp, idx = lax.top_k(jax.nn.softmax(e_logits, axis=-1), TOP_K)
    gate = p_grp * p_exp / jnp.sum(p_exp, axis=-1, keepdims=True)
    expert = grp * EXPERTS_PER_GROUP + idx
    y = expert_dispatch(xf, expert, gate, w_gate, w_up, w_down)
    return y.reshape(bsz, s, d)


def setup_inputs(seed: int = 0) -> dict:
    key = jax.random.key(seed)
    ks = jax.random.split(key, 32)
    L, D = DEPTH, D_MODEL

    def nrm(k, shape, scale):
        return jax.random.normal(k, shape, jnp.float32) * scale

    def gain(k, shape):
        return 1.0 + 0.02 * jax.random.normal(k, shape, jnp.float32)

    dt0 = jnp.exp(jax.random.uniform(ks[10], (L, SSD_HEADS), jnp.float32,
                                     minval=math.log(1e-3), maxval=math.log(1e-1)))
    return {
        'x': nrm(ks[0], (BATCH, SEQ, D), 1.0),
        'w_in': nrm(ks[1], (L, D, P_IN), D ** -0.5),
        'conv_w': nrm(ks[2], (L, CONV_K, W_CONV), CONV_K ** -0.5),
        'gla_w_lr': nrm(ks[3], (L, GLA_RANK, GLA_HEADS * GLA_DK), GLA_RANK ** -0.5),
        'gla_b_lr': nrm(ks[4], (L, GLA_HEADS * GLA_DK), 0.1),
        'gla_norm_g': gain(ks[5], (L, GLA_DV)),
        'ssd_conv_w': nrm(ks[6], (L, SSD_CONV_K, SSD_XBC), SSD_CONV_K ** -0.5),
        'ssd_conv_b': nrm(ks[7], (L, SSD_XBC), 0.02),
        'ssd_a_log': jnp.log(jax.random.uniform(ks[8], (L, SSD_HEADS), jnp.float32, minval=1.0, maxval=16.0)),
        'ssd_d': gain(ks[9], (L, SSD_HEADS)),
        'ssd_dt_bias': dt0 + jnp.log(-jnp.expm1(-dt0)),
        'ssd_norm_g': gain(ks[11], (L, W_SSD)),
        'diff_lq1': nrm(ks[12], (L, DIFF_DQK), 0.1),
        'diff_lk1': nrm(ks[13], (L, DIFF_DQK), 0.1),
        'diff_lq2': nrm(ks[14], (L, DIFF_DQK), 0.1),
        'diff_lk2': nrm(ks[15], (L, DIFF_DQK), 0.1),
        'diff_norm_g': gain(ks[16], (L, DIFF_DV)),
        'w_o': nrm(ks[17], (L, D_MIX, D), D_MIX ** -0.5 * DEEPNORM_BETA),
        'ln1_g': gain(ks[18], (L, D)),
        'ln1_b': nrm(ks[19], (L, D), 0.02),
        'router_g': nrm(ks[20], (L, D, N_GROUPS), D ** -0.5),
        'router_e': nrm(ks[21], (L, D, N_GROUPS, EXPERTS_PER_GROUP), D ** -0.5),
        'w_gate': nrm(ks[22], (L, N_EXPERTS, D, D_EXPERT), D ** -0.5),
        'w_up': nrm(ks[23], (L, N_EXPERTS, D, D_EXPERT), D ** -0.5),
        'w_down': nrm(ks[24], (L, N_EXPERTS, D_EXPERT, D), D_EXPERT ** -0.5 * DEEPNORM_BETA),
        'ln2_g': gain(ks[25], (L, D)),
        'ln2_b': nrm(ks[26], (L, D), 0.02),
    }


def reference(x, w_in, conv_w, gla_w_lr, gla_b_lr, gla_norm_g, ssd_conv_w, ssd_conv_b,
              ssd_a_log, ssd_d, ssd_dt_bias, ssd_norm_g, diff_lq1, diff_lk1, diff_lq2,
              diff_lk2, diff_norm_g, w_o, ln1_g, ln1_b, router_g, router_e, w_gate, w_up,
              w_down, ln2_g, ln2_b):
    for l in range(DEPTH):
        proj = x @ w_in[l]
        (cu, cgb, cgc, gq, gk, gv, gg, glr, sz, sxbc, sdt,
         dfq, dfk, dfv) = split_cols(proj, SPLIT_SIZES)
        y_conv = short_conv_mixer(cu, cgb, cgc, conv_w[l])
        y_gla = gla_mixer(gq, gk, gv, gg, glr, gla_w_lr[l], gla_b_lr[l], gla_norm_g[l])
        y_ssd = ssd_mixer(sz, sxbc, sdt, ssd_conv_w[l], ssd_conv_b[l], ssd_a_log[l], ssd_d[l],
                          ssd_dt_bias[l], ssd_norm_g[l])
        y_diff = diff_attention(dfq, dfk, dfv, diff_lq1[l], diff_lk1[l], diff_lq2[l],
                                diff_lk2[l], diff_norm_g[l], l)
        mix = jnp.concatenate([y_conv, y_gla, y_ssd, y_diff], axis=-1).astype(x.dtype) @ w_o[l]
        x = layer_norm(DEEPNORM_ALPHA * x + mix, ln1_g[l], ln1_b[l])
        moe = hierarchical_moe(x, router_g[l], router_e[l], w_gate[l], w_up[l], w_down[l])
        x = layer_norm(DEEPNORM_ALPHA * x + moe, ln2_g[l], ln2_b[l])
    return x
```

```cpp
#include <hip/hip_runtime.h>
#include <hip/hip_cooperative_groups.h>
#include <cstdio>
#include <cstdint>
namespace cg = cooperative_groups;
namespace pg8 {
#define PG8_LAS __attribute__((address_space(3)))
typedef unsigned short bf16_t;
typedef short bf16x8 __attribute__((ext_vector_type(8)));
typedef float f32x4 __attribute__((ext_vector_type(4)));
typedef unsigned u32x4 __attribute__((ext_vector_type(4)));
constexpr int BM = 256, BK = 64, HALF = 128, HTB = HALF * BK * 2  , STAGE_BYTES = 8 * HTB, NXCD = 8, WGM = 8;

__host__ __device__ __forceinline__ int lds_byte(int r, int c) { const int st = (r >> 4) * 2 + (c >> 5), rr = r & 15, cc = c & 31, ob = rr * 64 + cc * 2; return st * 1024 + (ob ^ (((ob >> 9) & 1) << 5)); }
__host__ __device__ __forceinline__ void stage_rc(int b, int& R, int& C) { const int st = b / 1024, sb = b % 1024, swz = sb ^ (((sb >> 9) & 1) << 5); R = (st >> 1) * 16 + swz / 64; C = (st & 1) * 32 + (swz % 64) / 2; }
__host__ __device__ __forceinline__ int perm32(int rho) { const int n = rho >> 4, i = rho & 15; return 8 * (i >> 2) + 4 * n + (i & 3); }

struct Unit { int pm, pn; };
struct Gemm { const bf16_t* A; const bf16_t* Bt; int M, N, K; };
__device__ __forceinline__ unsigned cvt_pk_bf16(float lo, float hi) { unsigned r; asm volatile("v_cvt_pk_bf16_f32 %0, %1, %2" : "=v"(r) : "v"(lo), "v"(hi)); return r; }
struct StaticOrder {
    int nM, nN, nwg, G, c; int i0 = 0, ni = 1 << 30;
    __host__ __device__ void init(int M, int N, int G_, int c_) { nM = M / BM; nN = N / BM; nwg = nM * nN; G = G_; c = c_; }
    __host__ __device__ bool next(int i, Unit& u) const {
        const long L = (long)(i + i0) * G + c; if (i >= ni || L >= nwg) return false;
        int wgid = (int)L; { const int q = nwg / NXCD, r = nwg % NXCD, xcd = wgid % NXCD, off = wgid / NXCD; wgid = (xcd < r ? xcd * (q + 1) : r * (q + 1) + (xcd - r) * q) + off; }
        const int nig = WGM * nN, gid = wgid / nig, fm = gid * WGM, gsz = (nM - fm) < WGM ? (nM - fm) : WGM;
        u.pm = fm + ((wgid % nig) % gsz); u.pn = (wgid % nig) / gsz; return true;
    }
    __device__ __forceinline__ void a_ready(const Unit&) const {}
    __device__ __forceinline__ void done(const Unit&) const {}
};
typedef unsigned u32x2 __attribute__((ext_vector_type(2)));
__device__ __forceinline__ float bf_lo(unsigned w) { return __uint_as_float(w << 16); }
__device__ __forceinline__ float bf_hi(unsigned w) { return __uint_as_float(w & 0xffff0000u); }
__device__ __forceinline__ float silu_f(float x) { return x * __builtin_amdgcn_rcpf(1.0f + __builtin_amdgcn_exp2f(-1.4426950408889634f * x)); }

struct EpiStore {
    static constexpr bool PERM = true, AFTER_DRAIN = false;
    bf16_t* O; int ldc;
    __device__ __forceinline__ void operator()(const f32x4 (&acc)[2][2][4][2], const Unit& u, int wr, int wc, int fr, int fq) const {
        const int row0 = u.pm * BM + wr * 64 + fr, col0 = u.pn * BM + wc * 32 + 8 * fq;
#pragma unroll
        for (int ai = 0; ai < 2; ++ai)
#pragma unroll
            for (int m = 0; m < 4; ++m) { bf16_t* rowp = O + (size_t)(row0 + ai * HALF + m * 16) * ldc + col0;
#pragma unroll
                for (int bj = 0; bj < 2; ++bj) { const f32x4 v0 = acc[ai][bj][m][0], v1 = acc[ai][bj][m][1];
                    u32x4 w; w.x = cvt_pk_bf16(v0[0], v0[1]); w.y = cvt_pk_bf16(v0[2], v0[3]); w.z = cvt_pk_bf16(v1[0], v1[1]); w.w = cvt_pk_bf16(v1[2], v1[3]);
                    *(u32x4*)(rowp + bj * HALF) = w; } }
    }
};
struct EpiRes {
    static constexpr bool PERM = true, AFTER_DRAIN = false;
    bf16_t* O; const bf16_t* R; int ldc; float alpha;
    __device__ __forceinline__ void operator()(const f32x4 (&acc)[2][2][4][2], const Unit& u, int wr, int wc, int fr, int fq) const {
        const int row0 = u.pm * BM + wr * 64 + fr, col0 = u.pn * BM + wc * 32 + 8 * fq;
        u32x4 rr[2][4][2];
#pragma unroll
        for (int ai = 0; ai < 2; ++ai)
#pragma unroll
            for (int m = 0; m < 4; ++m)
#pragma unroll
                for (int bj = 0; bj < 2; ++bj) rr[ai][m][bj] = *(const u32x4*)(R + (size_t)(row0 + ai * HALF + m * 16) * ldc + col0 + bj * HALF);
#pragma unroll
        for (int ai = 0; ai < 2; ++ai)
#pragma unroll
            for (int m = 0; m < 4; ++m) { const size_t off = (size_t)(row0 + ai * HALF + m * 16) * ldc + col0;
#pragma unroll
                for (int bj = 0; bj < 2; ++bj) { const f32x4 v0 = acc[ai][bj][m][0], v1 = acc[ai][bj][m][1];
                    const u32x4 r = rr[ai][m][bj];
                    u32x4 w; w.x = cvt_pk_bf16(alpha * bf_lo(r.x) + v0[0], alpha * bf_hi(r.x) + v0[1]); w.y = cvt_pk_bf16(alpha * bf_lo(r.y) + v0[2], alpha * bf_hi(r.y) + v0[3]);
                    w.z = cvt_pk_bf16(alpha * bf_lo(r.z) + v1[0], alpha * bf_hi(r.z) + v1[1]); w.w = cvt_pk_bf16(alpha * bf_lo(r.w) + v1[2], alpha * bf_hi(r.w) + v1[3]);
                    *(u32x4*)(O + off + bj * HALF) = w; } }
    }
};
__device__ __forceinline__ float clamp448(float x) { return __builtin_fminf(__builtin_fmaxf(x, -448.f), 448.f); }
__device__ __forceinline__ unsigned pk4_fp8(float a, float b, float c, float d) { unsigned w = 0; w = __builtin_amdgcn_cvt_pk_fp8_f32(clamp448(a), clamp448(b), w, false); w = __builtin_amdgcn_cvt_pk_fp8_f32(clamp448(c), clamp448(d), w, true); return w; }
struct EpiSwiglu8 {
    static constexpr bool PERM = true, AFTER_DRAIN = false;
    unsigned char* H;
    __device__ __forceinline__ void operator()(const f32x4 (&acc)[2][2][4][2], const Unit& u, int wr, int wc, int fr, int fq) const {
        const int row0 = u.pm * BM + wr * 64 + fr, col0 = (u.pn & 3) * HALF + wc * 32 + 8 * fq; const float si = 0.001953125f, so = 4.0f * 0.001953125f;
#pragma unroll
        for (int ai = 0; ai < 2; ++ai)
#pragma unroll
            for (int m = 0; m < 4; ++m) { unsigned char* rowp = H + (size_t)(row0 + ai * HALF + m * 16) * 512 + col0;
                const f32x4 g0 = acc[ai][0][m][0] * si, g1 = acc[ai][0][m][1] * si, u0 = acc[ai][1][m][0] * so, u1 = acc[ai][1][m][1] * so;
                u32x2 w; w.x = pk4_fp8(silu_f(g0[0]) * u0[0], silu_f(g0[1]) * u0[1], silu_f(g0[2]) * u0[2], silu_f(g0[3]) * u0[3]);
                w.y = pk4_fp8(silu_f(g1[0]) * u1[0], silu_f(g1[1]) * u1[1], silu_f(g1[2]) * u1[2], silu_f(g1[3]) * u1[3]);
                __hip_atomic_store((unsigned long long*)rowp, (unsigned long long)w.x | ((unsigned long long)w.y << 32), __ATOMIC_RELAXED, __HIP_MEMORY_SCOPE_AGENT); }
    }
};
struct EpiSwiglu {
    static constexpr bool PERM = true, AFTER_DRAIN = false;
    bf16_t* H;
    __device__ __forceinline__ void operator()(const f32x4 (&acc)[2][2][4][2], const Unit& u, int wr, int wc, int fr, int fq) const {
        const int row0 = u.pm * BM + wr * 64 + fr, col0 = (u.pn & 3) * HALF + wc * 32 + 8 * fq;
#pragma unroll
        for (int ai = 0; ai < 2; ++ai)
#pragma unroll
            for (int m = 0; m < 4; ++m) { bf16_t* rowp = H + (size_t)(row0 + ai * HALF + m * 16) * 512 + col0;
                const f32x4 g0 = acc[ai][0][m][0], g1 = acc[ai][0][m][1], u0 = acc[ai][1][m][0], u1 = acc[ai][1][m][1];
                u32x4 w; w.x = cvt_pk_bf16(silu_f(g0[0]) * u0[0], silu_f(g0[1]) * u0[1]); w.y = cvt_pk_bf16(silu_f(g0[2]) * u0[2], silu_f(g0[3]) * u0[3]);
                w.z = cvt_pk_bf16(silu_f(g1[0]) * u1[0], silu_f(g1[1]) * u1[1]); w.w = cvt_pk_bf16(silu_f(g1[2]) * u1[2], silu_f(g1[3]) * u1[3]);
                *(u32x4*)rowp = w; }
    }
};
struct EpiDown {
    static constexpr bool PERM = true, AFTER_DRAIN = false;
    bf16_t* Y; const float* gate; float oscale;
    __device__ __forceinline__ void operator()(const f32x4 (&acc)[2][2][4][2], const Unit& u, int wr, int wc, int fr, int fq) const {
        const int row0 = u.pm * BM + wr * 64 + fr, col0 = (u.pn & 3) * BM + wc * 32 + 8 * fq;
#pragma unroll
        for (int ai = 0; ai < 2; ++ai)
#pragma unroll
            for (int m = 0; m < 4; ++m) { const int row = row0 + ai * HALF + m * 16; const float gt = gate[row] * oscale; bf16_t* rowp = Y + (size_t)row * 1024 + col0;
#pragma unroll
                for (int bj = 0; bj < 2; ++bj) { const f32x4 v0 = acc[ai][bj][m][0] * gt, v1 = acc[ai][bj][m][1] * gt;
                    u32x4 w; w.x = cvt_pk_bf16(v0[0], v0[1]); w.y = cvt_pk_bf16(v0[2], v0[3]); w.z = cvt_pk_bf16(v1[0], v1[1]); w.w = cvt_pk_bf16(v1[2], v1[3]);
                    *(u32x4*)(rowp + bj * HALF) = w; } }
    }
};
struct EpiDown8 {
    static constexpr bool PERM = true, AFTER_DRAIN = false;
    unsigned char* Y; const float* gate; float oscale;
    __device__ __forceinline__ void operator()(const f32x4 (&acc)[2][2][4][2], const Unit& u, int wr, int wc, int fr, int fq) const {
        const int row0 = u.pm * BM + wr * 64 + fr, col0 = (u.pn & 3) * BM + wc * 32 + 8 * fq;
        float gts[2][4];
#pragma unroll
        for (int ai = 0; ai < 2; ++ai)
#pragma unroll
            for (int m = 0; m < 4; ++m) gts[ai][m] = gate[row0 + ai * HALF + m * 16];
#pragma unroll
        for (int ai = 0; ai < 2; ++ai)
#pragma unroll
            for (int m = 0; m < 4; ++m) { const int row = row0 + ai * HALF + m * 16; const float gt = gts[ai][m] * oscale * 64.0f; unsigned char* rowp = Y + (size_t)row * 1024 + col0;
#pragma unroll
                for (int bj = 0; bj < 2; ++bj) { const f32x4 v0 = acc[ai][bj][m][0] * gt, v1 = acc[ai][bj][m][1] * gt;
                    u32x2 w; w.x = pk4_fp8(v0[0], v0[1], v0[2], v0[3]); w.y = pk4_fp8(v1[0], v1[1], v1[2], v1[3]);
                    *(u32x2*)(rowp + bj * HALF) = w; } }
    }
};
struct MoeOrder {
    const int* blk_expert; int b0, nu, j, nj;
    __device__ __forceinline__ void init(const int* be, int G, int c) {
        blk_expert = be; const int x = c & 7; nj = G >> 3; j = c >> 3;
        if ((G & 7) == 0) { b0 = be[289 + 4 * x]; nu = 4 * (be[289 + 4 * x + 4] - b0); }
        else { b0 = 0; nu = 4 * be[288]; nj = G; j = c; }
    }
    __device__ __forceinline__ bool next(int i, Unit& u) const {
        const int L = i * nj + j; if (L >= nu) return false;
        const int blk = b0 + (L >> 2); u.pm = blk; u.pn = blk_expert[blk] * 4 + (L & 3); return true;
    }
    unsigned* ready = nullptr; int mode = 0;
    __device__ __forceinline__ void a_ready(const Unit& u) const {
        if (mode == 2) {
            if (threadIdx.x < 64) { unsigned sp = 0;
                while ((unsigned)__builtin_amdgcn_readfirstlane((int)__hip_atomic_load(ready + 64 * u.pm, __ATOMIC_RELAXED, __HIP_MEMORY_SCOPE_AGENT)) < 32u) { __builtin_amdgcn_s_sleep(2); if (++sp > (1u << 22)) break; }
                __builtin_amdgcn_fence(__ATOMIC_ACQUIRE, "agent"); asm volatile("s_waitcnt vmcnt(0)" ::: "memory"); }
            asm volatile("" ::: "memory"); __builtin_amdgcn_s_barrier(); asm volatile("" ::: "memory");
        }
    }
    __device__ __forceinline__ void done(const Unit& u) const {
        if (mode == 1) { asm volatile("s_waitcnt vmcnt(0)" ::: "memory"); if ((threadIdx.x & 63) == 0) __hip_atomic_fetch_add(ready + 64 * u.pm, 1u, __ATOMIC_RELAXED, __HIP_MEMORY_SCOPE_AGENT); }
    }
};
typedef int i32x8 __attribute__((ext_vector_type(8)));
__device__ __forceinline__ i32x8 cat16(bf16x8 a, bf16x8 b) { const u32x4 x = __builtin_bit_cast(u32x4, a), y = __builtin_bit_cast(u32x4, b); return (i32x8){(int)x.x, (int)x.y, (int)x.z, (int)x.w, (int)y.x, (int)y.y, (int)y.z, (int)y.w}; }
template <class Epi, class Sched, bool ALIGN_EPI = false, bool SP2 = false, bool FP8 = false>
__device__ __forceinline__ void gemm_phase(PG8_LAS unsigned char* lds, const Gemm g, const Sched& S, const Epi& E) {
    int tid_o_ = threadIdx.x; asm volatile("" : "+v"(tid_o_)); const int tid = tid_o_, wid = __builtin_amdgcn_readfirstlane(tid >> 6), lane = tid & 63, wr = wid >> 2, wc = wid & 3, fr = lane & 15, fq = lane >> 4;
    const int K = g.K, nt = K / BK;
    unsigned voffA[2], voffB[2];
#pragma unroll
    for (int i = 0; i < 2; ++i) { int R, C; stage_rc(tid * 16 + i * 8192, R, C); const int Rb = Epi::PERM ? ((R & ~31) + perm32(R & 31)) : R;
        voffA[i] = (unsigned)(R * K + C) * 2u; voffB[i] = (unsigned)(Rb * K + C) * 2u; }
    const size_t kstep = (size_t)(BK * 2);
    const size_t hstep = (size_t)HALF * K * 2;
    const size_t tstep = 2 * hstep;
    const unsigned ldsw = (unsigned)wid * 1024u;
    const int aoff = lds_byte(wr * 64 + fr, fq * 8), boff = lds_byte(wc * 32 + fr, fq * 8);
#define PG8_SA(b, h) (((b) * 2 + (h)) * HTB)
#define PG8_SB(b, h) ((4 + (b) * 2 + (h)) * HTB)
#define PG8_STAGE(bufoff, gbase, voff) do { _Pragma("unroll") for (int _i = 0; _i < 2; ++_i) \
        __builtin_amdgcn_global_load_lds((const unsigned*)((const char*)(gbase) + (voff)[_i]), (PG8_LAS unsigned*)(lds + (bufoff) + ldsw + _i * 8192), 16, 0, 0); } while (0)
#define PG8_LDA(dst, b, h) do { if constexpr (FP8) { _Pragma("unroll") for (int m = 0; m < 4; ++m) dst##_8[m] = cat16(*(const PG8_LAS bf16x8*)(lds + PG8_SA(b, h) + aoff + m * 2048), *(const PG8_LAS bf16x8*)(lds + PG8_SA(b, h) + aoff + m * 2048 + 1024)); } \
        else { _Pragma("unroll") for (int m = 0; m < 4; ++m) _Pragma("unroll") for (int k = 0; k < 2; ++k) dst[m][k] = *(const PG8_LAS bf16x8*)(lds + PG8_SA(b, h) + aoff + m * 2048 + k * 1024); } } while (0)
#define PG8_LDB(dst, b, h) do { if constexpr (FP8) { _Pragma("unroll") for (int n = 0; n < 2; ++n) dst##_8[n] = cat16(*(const PG8_LAS bf16x8*)(lds + PG8_SB(b, h) + boff + n * 2048), *(const PG8_LAS bf16x8*)(lds + PG8_SB(b, h) + boff + n * 2048 + 1024)); } \
        else { _Pragma("unroll") for (int n = 0; n < 2; ++n) _Pragma("unroll") for (int k = 0; k < 2; ++k) dst[n][k] = *(const PG8_LAS bf16x8*)(lds + PG8_SB(b, h) + boff + n * 2048 + k * 1024); } } while (0)
#define PG8_MMA(ai, bj, At, Bt) do { __builtin_amdgcn_s_setprio(1); \
        if constexpr (FP8) { _Pragma("unroll") for (int m = 0; m < 4; ++m) _Pragma("unroll") for (int n = 0; n < 2; ++n) \
            asm volatile("s_nop 1\n\tv_mfma_scale_f32_16x16x128_f8f6f4 %0, %1, %2, %0, %3, %3 op_sel_hi:[0,0,0]" : "+v"(acc[ai][bj][m][n]) : "v"(Bt##_8[n]), "v"(At##_8[m]), "v"(sc1_)); } \
        else { _Pragma("unroll") for (int m = 0; m < 4; ++m) _Pragma("unroll") for (int n = 0; n < 2; ++n) _Pragma("unroll") for (int k = 0; k < 2; ++k) \
            acc[ai][bj][m][n] = __builtin_amdgcn_mfma_f32_16x16x32_bf16(Bt[n][k], At[m][k], acc[ai][bj][m][n], 0, 0, 0); } \
        __builtin_amdgcn_s_setprio(0); } while (0)
#define PG8_WAIT_V(n) asm volatile("s_waitcnt vmcnt(" #n ")" ::: "memory")
#define PG8_WAIT_L(n) asm volatile("s_waitcnt lgkmcnt(" #n ")" ::: "memory")
#define PG8_BAR __builtin_amdgcn_s_barrier()
#define PG8_SCHED __builtin_amdgcn_sched_barrier(0)
    Unit cur, nxt; int ui = 0;
    if (!S.next(0, cur)) return;
    f32x4 acc[2][2][4][2];
#pragma unroll
    for (int a = 0; a < 2; ++a)
#pragma unroll
        for (int b = 0; b < 2; ++b)
#pragma unroll
            for (int m = 0; m < 4; ++m)
#pragma unroll
                for (int n = 0; n < 2; ++n) acc[a][b][m][n] = (f32x4){0.f, 0.f, 0.f, 0.f};
    bf16x8 At[4][2], B0[2][2], B1[2][2]; i32x8 At_8[4], B0_8[2], B1_8[2]; int sc1_ = 0x7f7f7f7f; asm volatile("" : "+v"(sc1_));
    const char* cA = (const char*)g.A + (size_t)cur.pm * tstep; const char* cB = (const char*)g.Bt + (size_t)cur.pn * tstep;
    S.a_ready(cur);
    if constexpr (SP2) {
        PG8_STAGE(PG8_SB(0, 0), cB, voffB); PG8_STAGE(PG8_SB(0, 1), cB + hstep, voffB); PG8_STAGE(PG8_SA(0, 0), cA, voffA); PG8_STAGE(PG8_SA(0, 1), cA + hstep, voffA);
        if (wr == 1) PG8_BAR;
        PG8_WAIT_V(2); PG8_BAR;
        PG8_STAGE(PG8_SB(1, 0), cB + kstep, voffB); PG8_STAGE(PG8_SA(1, 0), cA + kstep, voffA); PG8_STAGE(PG8_SB(1, 1), cB + hstep + kstep, voffB);
        PG8_WAIT_V(6); PG8_BAR;
    } else {
        PG8_STAGE(PG8_SB(0, 0), cB, voffB); PG8_STAGE(PG8_SA(0, 0), cA, voffA); PG8_STAGE(PG8_SB(0, 1), cB + hstep, voffB); PG8_STAGE(PG8_SA(0, 1), cA + hstep, voffA);
        if (wr == 1) PG8_BAR;
        PG8_WAIT_V(4); PG8_BAR;
        PG8_STAGE(PG8_SB(1, 0), cB + kstep, voffB); PG8_STAGE(PG8_SA(1, 0), cA + kstep, voffA); PG8_STAGE(PG8_SB(1, 1), cB + hstep + kstep, voffB);
        PG8_WAIT_V(6); PG8_BAR;
    }
    for (;;) {
        const bool has_next = S.next(ui + 1, nxt);
        const char* nA = has_next ? (const char*)g.A + (size_t)nxt.pm * tstep : cA; const char* nB = has_next ? (const char*)g.Bt + (size_t)nxt.pn * tstep : cB;
        for (int t = 0; t < nt; t += 2) {
            const bool last = (t == nt - 2);
            const char* a1 = cA + (size_t)(t + 1) * kstep;
            const char* a2 = last ? nA : cA + (size_t)(t + 2) * kstep; const char* b2 = last ? nB : cB + (size_t)(t + 2) * kstep;
            const char* a3 = a2 + kstep; const char* b3 = b2 + kstep;
            if (last && has_next) S.a_ready(nxt);
            if constexpr (SP2) {
            PG8_LDB(B0, 0, 0); PG8_LDB(B1, 0, 1); PG8_SCHED; PG8_LDA(At, 0, 0); PG8_STAGE(PG8_SA(1, 1), a1 + hstep, voffA);
            PG8_WAIT_V(8); PG8_WAIT_L(0); PG8_BAR; PG8_MMA(0, 0, At, B0); PG8_MMA(0, 1, At, B1); PG8_BAR; PG8_SCHED;
            PG8_LDA(At, 0, 1); PG8_STAGE(PG8_SB(0, 0), b2, voffB); PG8_STAGE(PG8_SB(0, 1), b2 + hstep, voffB); PG8_STAGE(PG8_SA(0, 0), a2, voffA);
            PG8_WAIT_V(8); PG8_WAIT_L(0); PG8_BAR; PG8_MMA(1, 0, At, B0); PG8_MMA(1, 1, At, B1); PG8_BAR; PG8_SCHED;
            PG8_LDB(B0, 1, 0); PG8_LDB(B1, 1, 1); PG8_SCHED; PG8_LDA(At, 1, 0); PG8_STAGE(PG8_SA(0, 1), a2 + hstep, voffA);
            PG8_WAIT_V(8); PG8_WAIT_L(0); PG8_BAR; PG8_MMA(0, 0, At, B0); PG8_MMA(0, 1, At, B1); PG8_BAR; PG8_SCHED;
            PG8_LDA(At, 1, 1); PG8_STAGE(PG8_SB(1, 0), b3, voffB); PG8_STAGE(PG8_SB(1, 1), b3 + hstep, voffB); PG8_STAGE(PG8_SA(1, 0), a3, voffA);
            PG8_WAIT_V(8); PG8_WAIT_L(0); PG8_BAR; PG8_MMA(1, 0, At, B0); PG8_MMA(1, 1, At, B1); PG8_BAR; PG8_SCHED;
            } else {
            PG8_LDB(B0, 0, 0); PG8_SCHED; PG8_LDA(At, 0, 0); PG8_STAGE(PG8_SA(1, 1), a1 + hstep, voffA);
            PG8_WAIT_L(8); PG8_BAR; PG8_WAIT_L(0); PG8_MMA(0, 0, At, B0); PG8_BAR; PG8_SCHED;
            PG8_LDB(B1, 0, 1); PG8_STAGE(PG8_SB(0, 0), b2, voffB);
            PG8_BAR; PG8_WAIT_L(0); PG8_MMA(0, 1, At, B1); PG8_BAR;
            PG8_LDA(At, 0, 1); PG8_STAGE(PG8_SA(0, 0), a2, voffA);
            PG8_BAR; PG8_WAIT_L(0); PG8_MMA(1, 0, At, B0); PG8_BAR; PG8_SCHED;
            PG8_STAGE(PG8_SB(0, 1), b2 + hstep, voffB);
            PG8_WAIT_V(6); PG8_BAR; PG8_MMA(1, 1, At, B1); PG8_BAR;
            PG8_LDB(B0, 1, 0); PG8_SCHED; PG8_LDA(At, 1, 0); PG8_STAGE(PG8_SA(0, 1), a2 + hstep, voffA);
            PG8_WAIT_L(8); PG8_BAR; PG8_WAIT_L(0); PG8_MMA(0, 0, At, B0); PG8_BAR; PG8_SCHED;
            PG8_LDB(B1, 1, 1); PG8_STAGE(PG8_SB(1, 0), b3, voffB);
            PG8_BAR; PG8_WAIT_L(0); PG8_MMA(0, 1, At, B1); PG8_BAR;
            PG8_LDA(At, 1, 1); PG8_STAGE(PG8_SA(1, 0), a3, voffA);
            PG8_BAR; PG8_WAIT_L(0); PG8_MMA(1, 0, At, B0); PG8_BAR; PG8_SCHED;
            PG8_STAGE(PG8_SB(1, 1), b3 + hstep, voffB);
            PG8_WAIT_V(6); PG8_BAR; PG8_MMA(1, 1, At, B1); PG8_BAR;
            }
        }
        if constexpr (FP8) asm volatile("s_nop 15\n\ts_nop 15" ::: "memory");
        if constexpr (ALIGN_EPI) { if (wr == 0) PG8_BAR; }
        if constexpr (!Epi::AFTER_DRAIN) { E(acc, cur, wr, wc, fr, fq); S.done(cur); }
        if (!has_next) break;
#pragma unroll
        for (int a = 0; a < 2; ++a)
#pragma unroll
            for (int b = 0; b < 2; ++b)
#pragma unroll
                for (int m = 0; m < 4; ++m)
#pragma unroll
                    for (int n = 0; n < 2; ++n) acc[a][b][m][n] = (f32x4){0.f, 0.f, 0.f, 0.f};
        cur = nxt; cA = nA; cB = nB; ++ui;
        if constexpr (ALIGN_EPI) { if (wr == 1) PG8_BAR; }
    }
    PG8_WAIT_V(0);
    if constexpr (!ALIGN_EPI) { if (wr == 0) PG8_BAR; }
    PG8_BAR;
    if constexpr (Epi::AFTER_DRAIN) { E.fused(acc, cur, wr, wc, fr, fq, lds, wid, lane); S.done(cur); }
}
template <class Epi, class Sched, bool FP8 = false>
__device__ __forceinline__ void gemm_phase_gather(PG8_LAS unsigned char* lds, const Gemm g, const int* slot_tok, const Sched& S, const Epi& E) {
    constexpr bool ALIGN_EPI = true, SP2 = true;
    int tid_o_ = threadIdx.x; asm volatile("" : "+v"(tid_o_)); const int tid = tid_o_, wid = __builtin_amdgcn_readfirstlane(tid >> 6), lane = tid & 63, wr = wid >> 2, wc = wid & 3, fr = lane & 15, fq = lane >> 4;
    const int K = g.K, nt = K / BK;
    unsigned voffB[2]; unsigned vC[2][2];
#pragma unroll
    for (int i = 0; i < 2; ++i) { int R, C; stage_rc(tid * 16 + i * 8192, R, C); const int Rb = Epi::PERM ? ((R & ~31) + perm32(R & 31)) : R;
        voffB[i] = (unsigned)(Rb * K + C) * 2u; }
    const size_t kstep = (size_t)(BK * 2);
    const size_t hstep = (size_t)HALF * K * 2;
    const size_t tstep = 2 * hstep;
    const unsigned ldsw = (unsigned)wid * 1024u;
    const int aoff = lds_byte(wr * 64 + fr, fq * 8), boff = lds_byte(wc * 32 + fr, fq * 8);
    Unit cur, nxt; int ui = 0;
    if (!S.next(0, cur)) return;
    f32x4 acc[2][2][4][2];
#pragma unroll
    for (int a = 0; a < 2; ++a)
#pragma unroll
        for (int b = 0; b < 2; ++b)
#pragma unroll
            for (int m = 0; m < 4; ++m)
#pragma unroll
                for (int n = 0; n < 2; ++n) acc[a][b][m][n] = (f32x4){0.f, 0.f, 0.f, 0.f};
    bf16x8 At[4][2], B0[2][2], B1[2][2]; i32x8 At_8[4], B0_8[2], B1_8[2]; int sc1_ = 0x7f7f7f7f; asm volatile("" : "+v"(sc1_));
    const char* XA = (const char*)g.A; const char* cB = (const char*)g.Bt + (size_t)cur.pn * tstep;
#pragma unroll
    for (int h = 0; h < 2; ++h)
#pragma unroll
        for (int i = 0; i < 2; ++i) { int R_, C_; stage_rc(tid * 16 + i * 8192, R_, C_); vC[h][i] = (unsigned)slot_tok[cur.pm * BM + h * HALF + R_] * (unsigned)(K * 2) + (unsigned)C_ * 2u; }
    S.a_ready(cur);
    if constexpr (SP2) {
        PG8_STAGE(PG8_SB(0, 0), cB, voffB); PG8_STAGE(PG8_SB(0, 1), cB + hstep, voffB); PG8_STAGE(PG8_SA(0, 0), XA, vC[0]); PG8_STAGE(PG8_SA(0, 1), XA, vC[1]);
        if (wr == 1) PG8_BAR;
        PG8_WAIT_V(2); PG8_BAR;
        PG8_STAGE(PG8_SB(1, 0), cB + kstep, voffB); PG8_STAGE(PG8_SA(1, 0), XA + kstep, vC[0]); PG8_STAGE(PG8_SB(1, 1), cB + hstep + kstep, voffB);
        PG8_WAIT_V(6); PG8_BAR;
    }
    for (;;) {
        const bool has_next = S.next(ui + 1, nxt);
        const char* nB = has_next ? (const char*)g.Bt + (size_t)nxt.pn * tstep : cB;
        PG8_LAS unsigned char* tab = lds + STAGE_BYTES + ((ui + 1) & 1) * 1024;
        if (has_next && wid == 0) __builtin_amdgcn_global_load_lds((const unsigned*)(slot_tok + (size_t)nxt.pm * BM + lane * 4), (PG8_LAS unsigned*)tab, 16, 0, 0);
        for (int t = 0; t < nt; t += 2) {
            const bool last = (t == nt - 2);
            const char* a1 = XA + (size_t)(t + 1) * kstep;
            const char* a2 = last ? XA : XA + (size_t)(t + 2) * kstep; const char* b2 = last ? nB : cB + (size_t)(t + 2) * kstep;
            const char* a3 = a2 + kstep; const char* b3 = b2 + kstep;
            unsigned vN[2][2];
            if (last && has_next) {
#pragma unroll
                for (int h = 0; h < 2; ++h)
#pragma unroll
                    for (int i = 0; i < 2; ++i) { int R_, C_; stage_rc(tid * 16 + i * 8192, R_, C_); vN[h][i] = *(const PG8_LAS unsigned*)(tab + (h * HALF + R_) * 4) * (unsigned)(K * 2) + (unsigned)C_ * 2u; }
            } else {
#pragma unroll
                for (int h = 0; h < 2; ++h)
#pragma unroll
                    for (int i = 0; i < 2; ++i) vN[h][i] = vC[h][i];
            }
            const unsigned vS0[2] = {vN[0][0], vN[0][1]}, vS1[2] = {vN[1][0], vN[1][1]};
            if (last && has_next) S.a_ready(nxt);
            if constexpr (SP2) {
            PG8_LDB(B0, 0, 0); PG8_LDB(B1, 0, 1); PG8_SCHED; PG8_LDA(At, 0, 0); PG8_STAGE(PG8_SA(1, 1), a1, vC[1]);
            PG8_WAIT_V(8); PG8_WAIT_L(0); PG8_BAR; PG8_MMA(0, 0, At, B0); PG8_MMA(0, 1, At, B1); PG8_BAR; PG8_SCHED;
            PG8_LDA(At, 0, 1); PG8_STAGE(PG8_SB(0, 0), b2, voffB); PG8_STAGE(PG8_SB(0, 1), b2 + hstep, voffB); PG8_STAGE(PG8_SA(0, 0), a2, vS0);
            PG8_WAIT_V(8); PG8_WAIT_L(0); PG8_BAR; PG8_MMA(1, 0, At, B0); PG8_MMA(1, 1, At, B1); PG8_BAR; PG8_SCHED;
            PG8_LDB(B0, 1, 0); PG8_LDB(B1, 1, 1); PG8_SCHED; PG8_LDA(At, 1, 0); PG8_STAGE(PG8_SA(0, 1), a2, vS1);
            PG8_WAIT_V(8); PG8_WAIT_L(0); PG8_BAR; PG8_MMA(0, 0, At, B0); PG8_MMA(0, 1, At, B1); PG8_BAR; PG8_SCHED;
            PG8_LDA(At, 1, 1); PG8_STAGE(PG8_SB(1, 0), b3, voffB); PG8_STAGE(PG8_SB(1, 1), b3 + hstep, voffB); PG8_STAGE(PG8_SA(1, 0), a3, vS0);
            PG8_WAIT_V(8); PG8_WAIT_L(0); PG8_BAR; PG8_MMA(1, 0, At, B0); PG8_MMA(1, 1, At, B1); PG8_BAR; PG8_SCHED;
            }
        }
        if constexpr (FP8) asm volatile("s_nop 15\n\ts_nop 15" ::: "memory");
        if constexpr (ALIGN_EPI) { if (wr == 0) PG8_BAR; }
        if constexpr (!Epi::AFTER_DRAIN) { E(acc, cur, wr, wc, fr, fq); S.done(cur); }
        if (!has_next) break;
#pragma unroll
        for (int a = 0; a < 2; ++a)
#pragma unroll
            for (int b = 0; b < 2; ++b)
#pragma unroll
                for (int m = 0; m < 4; ++m)
#pragma unroll
                    for (int n = 0; n < 2; ++n) acc[a][b][m][n] = (f32x4){0.f, 0.f, 0.f, 0.f};
        cur = nxt; cB = nB; ++ui;
        { const PG8_LAS unsigned char* tabc = lds + STAGE_BYTES + (ui & 1) * 1024;
#pragma unroll
          for (int h = 0; h < 2; ++h)
#pragma unroll
              for (int i = 0; i < 2; ++i) { int R_, C_; stage_rc(tid * 16 + i * 8192, R_, C_); vC[h][i] = *(const PG8_LAS unsigned*)(tabc + (h * HALF + R_) * 4) * (unsigned)(K * 2) + (unsigned)C_ * 2u; } }
        if constexpr (ALIGN_EPI) { if (wr == 1) PG8_BAR; }
    }
    PG8_WAIT_V(0);
    if constexpr (!ALIGN_EPI) { if (wr == 0) PG8_BAR; }
    PG8_BAR;
    if constexpr (Epi::AFTER_DRAIN) { E.fused(acc, cur, wr, wc, fr, fq, lds, wid, lane); S.done(cur); }
}
#undef PG8_SA
#undef PG8_SB
#undef PG8_STAGE
#undef PG8_LDA
#undef PG8_LDB
#undef PG8_MMA
#undef PG8_WAIT_V
#undef PG8_WAIT_L
#undef PG8_BAR
#undef PG8_SCHED
}
#define LAS __attribute__((address_space(3)))
typedef unsigned short bf16;
typedef short bf16x8 __attribute__((ext_vector_type(8)));
typedef short v4i16 __attribute__((ext_vector_type(4)));
typedef float f32x4 __attribute__((ext_vector_type(4)));
typedef float f32x16 __attribute__((ext_vector_type(16)));
typedef unsigned u32x4 __attribute__((ext_vector_type(4)));
typedef unsigned u32x2 __attribute__((ext_vector_type(2)));
typedef float f32x2 __attribute__((ext_vector_type(2)));

constexpr int NB = 16, SEQ = 2048, T = NB * SEQ, D = 1024, DEPTH = 2;
constexpr int PIN = 3348;
constexpr int PP = 3584;
constexpr int NEXP = 32, DEXP = 512;
constexpr int NBLK_MAX = 288, NSLOT_MAX = NBLK_MAX * 256;
constexpr int NWAVES = 8, NTHREADS = 512;
constexpr float ALPHA = 1.41421356237f;
constexpr float LN_EPS = 1e-5f, RMS_EPS = 1e-6f;

constexpr int C_CU = 0, C_CGB = 256, C_CGC = 512, C_GQ = 768, C_GK = 896, C_GV = 1024, C_GG = 1280, C_SZ = 1536, C_SX = 1792, C_SB = 2048, C_SC = 2304,
              C_DQ = 2560, C_DK = 2816, C_DV = 3072, C_GLR = 3328, C_SDT = 3344;
__host__ __device__ __forceinline__ int orig_col(int c) {
    if (c < 1536) return c;
    if (c < 2560) return 1552 + (c - 1536);
    if (c < 3328) return 2580 + (c - 2560);
    if (c < 3344) return 1536 + (c - 3328);
    if (c < 3348) return 2576 + (c - 3344);
    return -1;
}

enum { I_X = 0, I_WIN, I_CONVW, I_GLA_WLR, I_GLA_BLR, I_GLA_NG, I_SSD_CW, I_SSD_CB, I_SSD_ALOG, I_SSD_D, I_SSD_DTB, I_SSD_NG, I_LQ1, I_LK1, I_LQ2, I_LK2, I_DIFF_NG,
       I_WO, I_LN1G, I_LN1B, I_RG, I_RE, I_WG, I_WU, I_WD, I_LN2G, I_LN2B, N_IN };

constexpr size_t MiB = 1u << 20;
constexpr size_t WS_WGCNT = 0;
constexpr size_t WS_BLKEXP = 64 * 1024;
constexpr size_t WS_SLOTGATE = 128 * 1024;
constexpr size_t WS_SLOTOF = 512 * 1024;
constexpr size_t WS_LNSTAT = 768 * 1024;
constexpr size_t WS_WRT = 1024 * 1024, WRT_LAYER = 128 * 1024;
constexpr size_t WS_RCS = WS_WRT + 98304;
constexpr size_t WS_LAM = 1700 * 1024;
constexpr size_t WS_SLOTTOK = 2560 * 1024;
constexpr size_t WS_SSDDEC = 1792 * 1024;
constexpr size_t WS_GLACL = 2048 * 1024;
constexpr size_t WS_BAR = 3 * MiB;
constexpr size_t WS_RDY = WS_BAR + 16384;
constexpr size_t WS_W = 4 * MiB;
constexpr size_t W_WIN = WS_W, W_WO = W_WIN + (size_t)PP * 1024 * 2, W_WGU = W_WO + (size_t)1024 * 1024 * 2, W_WD = W_WGU + (size_t)NEXP * 1024 * 1024 * 2,
                 W_END = W_WD + (size_t)NEXP * 1024 * 512 * 2;
constexpr size_t WS_A = 112 * MiB;
static_assert(W_END <= WS_A, "weights region");
constexpr size_t A_XB = WS_A, A_PROJ = WS_A + 64 * MiB, A_MIX = A_PROJ + 224 * MiB, A_ST = A_MIX + 64 * MiB, A_DST = A_ST + 32 * MiB, A_SP = A_DST + 16 * MiB, A_GP = A_SP + 16 * MiB, A_END = A_GP + 8 * MiB;
constexpr size_t A_V = WS_A + 64 * MiB;
constexpr size_t A_X1 = WS_A + 128 * MiB;
constexpr size_t A_XS = WS_A + 192 * MiB;
constexpr size_t A_X8 = A_X1;
constexpr size_t A_Y = A_XS;
constexpr size_t A_H = WS_A;
static_assert(A_XS + (size_t)NSLOT_MAX * 1024 * 2 <= A_ST, "Xs/Y overlay");
static_assert(A_H + (size_t)NSLOT_MAX * 512 * 2 <= A_X1, "h overlay");
static_assert((size_t)T * PP * 2 == 224 * MiB, "proj size");
constexpr size_t WS_NEED = A_END;
static_assert(WS_NEED <= 572000000ull, "workspace budget");

constexpr int LDS_BYTES = 163840;

__device__ __forceinline__ float bf2f(unsigned short b) { return __uint_as_float((unsigned)b << 16); }
__device__ __forceinline__ float bflo(unsigned w) { return __uint_as_float(w << 16); }
__device__ __forceinline__ float bfhi(unsigned w) { return __uint_as_float(w & 0xffff0000u); }
__device__ __forceinline__ unsigned pk2(float lo, float hi) { return pg8::cvt_pk_bf16(lo, hi); }
__device__ __forceinline__ unsigned short f2bf(float f) { return (unsigned short)(pk2(f, 0.f) & 0xffffu); }
__device__ __forceinline__ float siluf(float x) { return x * __builtin_amdgcn_rcpf(1.0f + __builtin_amdgcn_exp2f(-1.4426950408889634f * x)); }
__device__ __forceinline__ float softplusf(float x) { return fmaxf(x, 0.f) + __logf(1.0f + __expf(-fabsf(x))); }
__device__ __forceinline__ float logsigmoidf(float x) { return fminf(x, 0.f) - __logf(1.0f + __expf(-fabsf(x))); }
__device__ __forceinline__ int crow(int i, int h) { return (i & 3) + 8 * (i >> 2) + 4 * h; }
__device__ __forceinline__ float shflx(float v, int mask, int lane) { return __int_as_float(__builtin_amdgcn_ds_bpermute((lane ^ mask) << 2, __float_as_int(v))); }
__device__ __forceinline__ float shfl_from(float v, int src, int lane) { (void)lane; return __int_as_float(__builtin_amdgcn_ds_bpermute(src << 2, __float_as_int(v))); }
__device__ __forceinline__ float xor32_add(float v) { auto rr = __builtin_amdgcn_permlane32_swap(__float_as_uint(v), __float_as_uint(v), false, false); return __uint_as_float(rr[0]) + __uint_as_float(rr[1]); }
__device__ __forceinline__ float wave_sum(float v, int lane) {
#pragma unroll
    for (int o = 1; o < 32; o <<= 1) v += shflx(v, o, lane);
    return xor32_add(v);
}
__device__ __forceinline__ bf16x8 fragN(const LAS unsigned char* X, int stride, int r0, int k0, int lane) {
    return *(const LAS bf16x8*)(X + (r0 + (lane & 31)) * stride + (k0 + 8 * (lane >> 5)) * 2);
}
__device__ __forceinline__ bf16x8 fragT(const LAS unsigned char* X, int stride, int k0, int c0, int lane) {
    const int g = lane >> 4, i = lane & 15, q = i >> 2, pp = i & 3, h = g >> 1;
    const LAS unsigned char* p = X + (k0 + 8 * h + q) * stride + (c0 + 16 * (g & 1) + 4 * pp) * 2;
    const v4i16 a = __builtin_amdgcn_ds_read_tr16_b64_v4i16((LAS v4i16*)p);
    const v4i16 b = __builtin_amdgcn_ds_read_tr16_b64_v4i16((LAS v4i16*)(p + 4 * stride));
    return (bf16x8){a[0], a[1], a[2], a[3], b[0], b[1], b[2], b[3]};
}
#define MFMA32(a, b, c) __builtin_amdgcn_mfma_f32_32x32x16_bf16((a), (b), (c), 0, 0, 0)
#define ZERO16 ((f32x16){0.f,0.f,0.f,0.f,0.f,0.f,0.f,0.f,0.f,0.f,0.f,0.f,0.f,0.f,0.f,0.f})

struct Ctx {
    const float* in[N_IN]; float* out; unsigned char* ws;
};
struct Args { const float* in[N_IN]; float* out; unsigned char* ws; };

struct CvtItem { const float* cp; unsigned char* dst; int ld, K, n0, k0; float sc; bool valid, f8; };
__device__ __forceinline__ void cvt_load(const CvtItem& d, f32x4 (&v)[8], int lane) {
#pragma unroll
    for (int i = 0; i < 8; ++i) { const int kk = 8 * i + (lane >> 3); v[i] = d.valid ? *(const f32x4*)(d.cp + (size_t)(d.k0 + kk) * d.ld) : (f32x4){0.f, 0.f, 0.f, 0.f}; }
}
__device__ __forceinline__ void cvt_finish(const CvtItem& d, const f32x4 (&v)[8], LAS float* scr, int lane) {
#pragma unroll
    for (int i = 0; i < 8; ++i) { const int kk = 8 * i + (lane >> 3); LAS float* p = scr + kk * 33 + 4 * (lane & 7); p[0] = v[i][0] * d.sc; p[1] = v[i][1] * d.sc; p[2] = v[i][2] * d.sc; p[3] = v[i][3] * d.sc; }
    const int c = lane & 7;
#pragma unroll
    for (int j = 0; j < 4; ++j) { const int n = (lane >> 3) + 8 * j; const LAS float* s = scr + (8 * c) * 33 + n;
        if (d.f8) { u32x2 o; o.x = pg8::pk4_fp8(s[0 * 33], s[1 * 33], s[2 * 33], s[3 * 33]); o.y = pg8::pk4_fp8(s[4 * 33], s[5 * 33], s[6 * 33], s[7 * 33]);
            *(u32x2*)(d.dst + (size_t)(d.n0 + n) * d.K + d.k0 + 8 * c) = o; }
        else { u32x4 o; o.x = pk2(s[0 * 33], s[1 * 33]); o.y = pk2(s[2 * 33], s[3 * 33]); o.z = pk2(s[4 * 33], s[5 * 33]); o.w = pk2(s[6 * 33], s[7 * 33]);
            *(u32x4*)(d.dst + ((size_t)(d.n0 + n) * d.K + d.k0 + 8 * c) * 2) = o; } }
}
#ifndef MOE_FP8
#define MOE_FP8 1
#endif
__device__ __forceinline__ unsigned char* wbuf(const Args& A, int l) { return (l & 1) ? (unsigned char*)A.out : A.ws + WS_W; }
#ifndef CVT_NP
#define CVT_NP 4
#endif
constexpr int CV_IT_IN = 16 * (PP / 32), CV_NIT = CV_IT_IN + 16 * 32 + 16 * (NEXP * 1024 / 32) + 8 * (NEXP * 1024 / 32);
__device__ __forceinline__ void convert_weights(const Args& A, int l, LAS unsigned char* lds, int gw, int ngw, int wave, int lane, int it0, int it1, bool tables) {
    LAS float* scr = (LAS float*)(lds + wave * 8704);
    unsigned char* ws = A.ws; unsigned char* wb = wbuf(A, l) - WS_W;
    const float* w_in = A.in[I_WIN] + (size_t)l * 1024 * PIN;
    const float* w_o = A.in[I_WO] + (size_t)l * 1024 * 1024;
    const float* w_g = A.in[I_WG] + (size_t)l * NEXP * 1024 * 512;
    const float* w_u = A.in[I_WU] + (size_t)l * NEXP * 1024 * 512;
    const float* w_d = A.in[I_WD] + (size_t)l * NEXP * 512 * 1024;
    constexpr int IT_IN = 16 * (PP / 32), IT_O = 16 * 32, IT_GU = 16 * (NEXP * 1024 / 32), IT_D = 8 * (NEXP * 1024 / 32);
    constexpr int NIT = IT_IN + IT_O + IT_GU + IT_D;
    const int nl = 4 * (lane & 7);
    auto desc = [&](int it) -> CvtItem {
        CvtItem d; int r = it; d.sc = 1.0f; d.valid = true; d.f8 = false;
        if (r < IT_IN) { const int kb = r / (PP / 32), nb = r % (PP / 32); const int oc = orig_col(nb * 32 + nl);
            d.cp = w_in + (oc >= 0 ? oc : 0); d.valid = oc >= 0; d.ld = PIN; d.dst = wb + W_WIN; d.K = 1024; d.n0 = nb * 32; d.k0 = kb * 64; return d; }
        r -= IT_IN;
        if (r < IT_O) { const int kb = r / 32, nb = r % 32; d.cp = w_o + nb * 32 + nl; d.ld = 1024; d.dst = wb + W_WO; d.K = 1024; d.n0 = nb * 32; d.k0 = kb * 64; return d; }
        r -= IT_O;
        if (r < IT_GU) { const int kb = r / 1024, nb = r % 1024; const int n = nb * 32 + nl, e = n >> 10, np = n & 1023, pnl = np >> 8, half = (np >> 7) & 1, j = np & 127;
            d.cp = (half ? w_u : w_g) + (size_t)e * 1024 * 512 + pnl * 128 + j; d.ld = 512; d.dst = wb + W_WGU; d.K = 1024; d.n0 = nb * 32; d.k0 = kb * 64; d.f8 = MOE_FP8 != 0; d.sc = MOE_FP8 ? 64.0f : 1.0f; return d; }
        r -= IT_GU;
        { const int kb = r / 1024, nb = r % 1024; const int n = nb * 32 + nl, e = n >> 10, np = n & 1023;
            d.cp = w_d + (size_t)e * 512 * 1024 + np; d.ld = 1024; d.dst = wb + W_WD; d.K = 512; d.n0 = nb * 32; d.k0 = kb * 64; d.f8 = MOE_FP8 != 0; d.sc = MOE_FP8 ? 64.0f : 1.0f; return d; }
    };
    static_assert(NIT == CV_NIT && IT_IN == CV_IT_IN, "item counts");
    {
        CvtItem d[CVT_NP]; f32x4 v[CVT_NP][8];
#pragma unroll
        for (int j = 0; j < CVT_NP; ++j) { const int itj = it0 + gw + j * ngw; d[j] = desc(itj < it1 ? itj : it1 - 1); cvt_load(d[j], v[j], lane); }
        for (int it = it0 + gw; it < it1; it += CVT_NP * ngw) {
#pragma unroll
            for (int j = 0; j < CVT_NP; ++j) { const int itj = it + j * ngw;
                if (itj < it1) cvt_finish(d[j], v[j], scr, lane);
                const int itn = itj + CVT_NP * ngw; d[j] = desc(itn < it1 ? itn : it1 - 1); cvt_load(d[j], v[j], lane); }
        }
    }
    if (!tables) return;
    bf16* wrt = (bf16*)(ws + WS_WRT + l * WRT_LAYER); float* rcs = (float*)(ws + WS_RCS + l * WRT_LAYER);
    const float* rg = A.in[I_RG] + (size_t)l * 1024 * 4; const float* re = A.in[I_RE] + (size_t)l * 1024 * 32;
    const float* g1 = A.in[I_LN1G] + l * 1024; const float* b1 = A.in[I_LN1B] + l * 1024;
    for (int j = gw; j < 48; j += ngw) {
        float cs = 0.f, cb = 0.f;
        for (int k = lane; k < 1024; k += 64) {
            const float w = j < 4 ? rg[k * 4 + j] : (j < 36 ? re[k * 32 + (j - 4)] : 0.f);
            const unsigned short wb = f2bf(g1[k] * w); wrt[j * 1024 + k] = wb; cs += bf2f(wb); cb += b1[k] * w;
        }
        cs = wave_sum(cs, lane); cb = wave_sum(cb, lane);
        if (lane == 0) { rcs[j] = cs; rcs[48 + j] = cb; }
    }
    if (l == 0 && gw == 48) {
        for (int ll = 0; ll < DEPTH; ++ll) {
            float s1 = (lane < 32) ? A.in[I_LQ1][ll * 32 + (lane & 31)] * A.in[I_LK1][ll * 32 + (lane & 31)] : 0.f, s2 = (lane < 32) ? A.in[I_LQ2][ll * 32 + (lane & 31)] * A.in[I_LK2][ll * 32 + (lane & 31)] : 0.f;
            s1 = wave_sum(s1, lane); s2 = wave_sum(s2, lane);
            const float lam_init = 0.8f - 0.6f * __expf(-0.3f * (float)ll);
            if (lane == 0) ((float*)(ws + WS_LAM))[ll] = __expf(s1) - __expf(s2) + lam_init; }
    }
}
__device__ __forceinline__ void convert_x(const Args& A, int gtid, int gthreads) {
    const f32x4* x = (const f32x4*)A.in[I_X]; u32x4* xb = (u32x4*)(A.ws + A_XB);
    constexpr size_t NCH = (size_t)T * D / 8;
    for (size_t i = gtid; i < NCH; i += (size_t)gthreads * 4) {
        f32x4 a[4], b[4];
#pragma unroll
        for (int u = 0; u < 4; ++u) { const size_t j = i + (size_t)u * gthreads; if (j < NCH) { a[u] = x[2 * j]; b[u] = x[2 * j + 1]; } }
#pragma unroll
        for (int u = 0; u < 4; ++u) { const size_t j = i + (size_t)u * gthreads; if (j < NCH) { u32x4 o; o.x = pk2(a[u][0], a[u][1]); o.y = pk2(a[u][2], a[u][3]); o.z = pk2(b[u][0], b[u][1]); o.w = pk2(b[u][2], b[u][3]); xb[j] = o; } }
    }
}
__device__ __forceinline__ int opaque_tid() { int t = threadIdx.x; asm volatile("" : "+v"(t)); return t; }
#define XB_TMO      128
#define XB_XCNT(j)  (256  + 64 * (j))
#define XB_XSUB(j)  (1280 + 64 * (j))
#define XB_XGEN(j)  (2304 + 64 * (j))
#define XB_TOP      3328
#define XB_TOPGEN   3392
#define XCD_BAR_WORDS 3456
#define XB_SPIN_CAP (1u << 18)

__device__ __forceinline__ unsigned xb_ld(unsigned* p)              { return __hip_atomic_load(p, __ATOMIC_RELAXED, __HIP_MEMORY_SCOPE_AGENT); }
__device__ __forceinline__ unsigned xb_add(unsigned* p, unsigned v) { return __hip_atomic_fetch_add(p, v, __ATOMIC_RELAXED, __HIP_MEMORY_SCOPE_AGENT); }
__device__ __forceinline__ unsigned xb_xcc_id() { return (unsigned)__builtin_amdgcn_s_getreg((3 << 11) | 20) & 0xFu; }
#define XB_SPIN(cond, bar) do { unsigned _sp = 0; while (cond) { __builtin_amdgcn_s_sleep(1); \
    if ((++_sp & 255u) == 0u) { if (xb_ld(&(bar)[XB_TMO])) break; if (_sp > XB_SPIN_CAP) { atomicAdd(&(bar)[XB_TMO], 1u); break; } } } } while (0)

struct XcdBarrier {
    unsigned* bar; unsigned x;
    volatile LAS unsigned* st;
};

__device__ __forceinline__ XcdBarrier xcd_barrier_post(unsigned* bar, volatile LAS unsigned* st) {
    XcdBarrier b; b.bar = bar; b.x = xb_xcc_id(); b.st = st;
    if (threadIdx.x == 0) (void)xb_add(&bar[XB_XCNT(b.x)], 1u);
    return b;
}
__device__ __forceinline__ void xcd_barrier_complete(unsigned* bar, unsigned x, unsigned& nloc, unsigned& nx) {
    const unsigned G = gridDim.x * gridDim.y * gridDim.z;
    unsigned sum, cnt, mine, sp = 0u;
    for (;;) {
        sum = 0u; cnt = 0u; mine = 0u;
#pragma unroll
        for (unsigned j = 0; j < 16; ++j) { const unsigned c = xb_ld(&bar[XB_XCNT(j)]); sum += c; cnt += (c > 0u) ? 1u : 0u; mine = (j == x) ? c : mine; }
        if (sum == G) break;
        __builtin_amdgcn_s_sleep(1);
        if ((++sp & 255u) == 0u) { if (xb_ld(&bar[XB_TMO])) break; if (sp > XB_SPIN_CAP) { atomicAdd(&bar[XB_TMO], 1u); break; } }
    }
    nloc = mine > 0u ? mine : 1u; nx = cnt > 0u ? cnt : 1u;
}

__device__ __forceinline__ void xcd_barrier(const XcdBarrier& b) {
    asm volatile("s_waitcnt vmcnt(0)" ::: "memory");
    __syncthreads();
    if (threadIdx.x == 0) {
        unsigned* bar = b.bar; unsigned bx_ = (unsigned)__builtin_amdgcn_readfirstlane((int)b.x); asm volatile("" : "+s"(bx_));
        __builtin_amdgcn_s_waitcnt(0);
        unsigned nloc = b.st[0], nx = b.st[1];
        if (nloc == 0u) { xcd_barrier_complete(bar, bx_, nloc, nx); b.st[0] = nloc; b.st[1] = nx; }
        const unsigned old = xb_add(&bar[XB_XSUB(bx_)], 1u);
        const unsigned gen = old / nloc;
        if (old + 1u == (gen + 1u) * nloc) {
            __builtin_amdgcn_fence(__ATOMIC_RELEASE, "agent");
            asm volatile("s_waitcnt vmcnt(0)" ::: "memory");
            const unsigned og = xb_add(&bar[XB_TOP], 1u);
            const unsigned tg = og / nx;
            if (og + 1u == (tg + 1u) * nx) xb_add(&bar[XB_TOPGEN], 1u);
            else XB_SPIN(xb_ld(&bar[XB_TOPGEN]) == tg, bar);
            __builtin_amdgcn_fence(__ATOMIC_ACQUIRE, "agent");
            xb_add(&bar[XB_XGEN(bx_)], 1u);
            asm volatile("s_waitcnt vmcnt(0)" ::: "memory");
        } else {
            XB_SPIN(xb_ld(&bar[XB_XGEN(bx_)]) == gen, bar);
            __builtin_amdgcn_fence(__ATOMIC_ACQUIRE, "agent");
            asm volatile("s_waitcnt vmcnt(0)" ::: "memory");
        }
    }
    __syncthreads();
}
constexpr int AT_Q = 0, AT_RING = 18432, AT_NSLOT = 6, AT_SLOT = 16384, AT_CMB = AT_RING + AT_NSLOT * AT_SLOT;
static_assert(AT_CMB + 32768 <= LDS_BYTES - 64, "attention LDS map");
#define EX2(x) __builtin_amdgcn_exp2f(x)
__device__ __forceinline__ void attn_mask(f32x16& s0, f32x16& s1, int kb0, int qrel, int hh) {
#pragma unroll
    for (int i = 0; i < 16; ++i) { const int kv = kb0 + crow(i, hh); if (kv > qrel) s0[i] = -INFINITY; if (kv + 32 > qrel) s1[i] = -INFINITY; }
}
__device__ __forceinline__ float xhalf_max(float v) { auto rr = __builtin_amdgcn_permlane32_swap(__float_as_uint(v), __float_as_uint(v), false, false); return fmaxf(__uint_as_float(rr[0]), __uint_as_float(rr[1])); }
__device__ __forceinline__ bf16x8 pack8(const f32x16& c, int b) {
    u32x4 w; w.x = pk2(c[b], c[b + 1]); w.y = pk2(c[b + 2], c[b + 3]); w.z = pk2(c[b + 4], c[b + 5]); w.w = pk2(c[b + 6], c[b + 7]); return __builtin_bit_cast(bf16x8, w);
}
__device__ __forceinline__ bf16x8 tr2(const LAS unsigned char* p) {
    const v4i16 a = __builtin_amdgcn_ds_read_tr16_b64_v4i16((LAS v4i16*)p), b = __builtin_amdgcn_ds_read_tr16_b64_v4i16((LAS v4i16*)(p + 1024));
    return (bf16x8){a[0], a[1], a[2], a[3], b[0], b[1], b[2], b[3]};
}
__device__ __forceinline__ void glds16(const void* gsrc, unsigned lds_dst) { unsigned keep;
    asm volatile("s_mov_b32 %0, m0\n\ts_mov_b32 m0, %2\n\ts_nop 0\n\tglobal_load_lds_dwordx4 %1, off\n\ts_mov_b32 m0, %0" : "=&s"(keep) : "v"(gsrc), "s"(lds_dst) : "memory"); }
__device__ __forceinline__ void attn_unit(LAS unsigned char* lds, const bf16* proj, bf16* mix, int b, int h, int qb, float lam, const float* normg, float oscale, bool first, int nb, int nh, int nqb, u32x4 (&qn)[2]) {
    const int tid = opaque_tid(), lane = tid & 63, wid = __builtin_amdgcn_readfirstlane(tid >> 6), ws = wid & 3, comp = wid >> 2, r32 = lane & 31, hh = lane >> 5;
    const size_t tb = (size_t)b * SEQ;
    LAS unsigned char* Qs = lds + AT_Q; LAS unsigned char* ring = lds + AT_RING; const unsigned ring0 = (unsigned)(uintptr_t)ring;
    const bf16* qsrc = proj + (tb + qb * 128) * PP + C_DQ + h * 64;
    const int NT = 2 * qb + 2, qrel = ws * 32 + r32;
    const bf16* kdma = proj + (tb + 8 * wid + (lane >> 3)) * PP + C_DK + h * 64 + (((lane & 7) ^ (lane >> 3)) << 3);
    const bf16* vdma = kdma + (C_DV - C_DK);
#define DMA_TILE_P(kp, nt, tile, slot) do { const int tl_ = (tile) < (nt) ? (tile) : (nt) - 1; \
        glds16((kp) + (size_t)tl_ * 64 * PP, (unsigned)__builtin_amdgcn_readfirstlane((int)(ring0 + (slot) * AT_SLOT + wid * 1024))); \
        glds16((kp) + (C_DV - C_DK) + (size_t)tl_ * 64 * PP, (unsigned)__builtin_amdgcn_readfirstlane((int)(ring0 + (slot) * AT_SLOT + 8192 + wid * 1024))); } while (0)
    if (first) { DMA_TILE_P(kdma, NT, 0, 0); DMA_TILE_P(kdma, NT, 1, 1); DMA_TILE_P(kdma, NT, 2, 2); DMA_TILE_P(kdma, NT, 3, 3);
#pragma unroll
        for (int i = 0; i < 2; ++i) { const int id = tid + 512 * i; qn[i] = *(const u32x4*)(qsrc + (size_t)(id >> 3) * PP + (id & 7) * 8); } }
    const float c2 = 0.25503486f;
#pragma unroll
    for (int i = 0; i < 2; ++i) { const int id = tid + 512 * i, row = id >> 3, ch = id & 7; const u32x4 q = qn[i];
        u32x4 o; o.x = pk2(bflo(q.x) * c2, bfhi(q.x) * c2); o.y = pk2(bflo(q.y) * c2, bfhi(q.y) * c2); o.z = pk2(bflo(q.z) * c2, bfhi(q.z) * c2); o.w = pk2(bflo(q.w) * c2, bfhi(q.w) * c2);
        *(LAS u32x4*)(Qs + row * 144 + ch * 16) = o; }
    asm volatile("s_waitcnt vmcnt(0) lgkmcnt(0)" ::: "memory"); __builtin_amdgcn_s_barrier(); asm volatile("" ::: "memory");
    bf16x8 qf[2];
    qf[0] = fragN(Qs, 144, ws * 32, comp * 32, lane); qf[1] = fragN(Qs, 144, ws * 32, comp * 32 + 16, lane);
    const int kx = r32 & 7;
    const int koff0 = r32 * 128 + (((comp * 4 + hh) ^ kx) << 4), koff1 = r32 * 128 + (((comp * 4 + 2 + hh) ^ kx) << 4);
    const int g_ = lane >> 4, i_ = lane & 15, q_ = i_ >> 2, pp_ = i_ & 3, vrow = 4 * (g_ >> 1) + q_, vch = 2 * (g_ & 1) + (pp_ >> 1);
    const int voff0 = 8192 + vrow * 128 + (((vch) ^ vrow) << 4) + 8 * (pp_ & 1), voff1 = 8192 + vrow * 128 + (((vch + 4) ^ vrow) << 4) + 8 * (pp_ & 1);
    float l = 0.f;
    f32x16 o0 = ZERO16, o1 = ZERO16, negm = ZERO16; float m = 0.f;
    f32x16 sA0, sA1, sB0, sB1;
    bf16x8 pA[4], pB[4];
#pragma unroll
    for (int i = 0; i < 4; ++i) pA[i] = (bf16x8){0, 0, 0, 0, 0, 0, 0, 0};
#define QK4(N0, N1, k00, k10, k01, k11) do { \
        asm volatile("s_nop 1\n\tv_mfma_f32_32x32x16_bf16 %0, %1, %2, %3" : "=&v"(N0) : "v"(k00), "v"(qf[0]), "v"(negm)); \
        asm volatile("v_mfma_f32_32x32x16_bf16 %0, %1, %2, %3" : "=&v"(N1) : "v"(k10), "v"(qf[0]), "v"(negm)); \
        asm volatile("v_mfma_f32_32x32x16_bf16 %0, %1, %2, %0" : "+v"(N0) : "v"(k01), "v"(qf[1])); \
        asm volatile("v_mfma_f32_32x32x16_bf16 %0, %1, %2, %0\n\ts_nop 15\n\ts_nop 3" : "+v"(N1) : "v"(k11), "v"(qf[1])); } while (0)
#define KFR(Kb) const bf16x8 k00 = *(const LAS bf16x8*)((Kb) + koff0), k10 = *(const LAS bf16x8*)((Kb) + 4096 + koff0), k01 = *(const LAS bf16x8*)((Kb) + koff1), k11 = *(const LAS bf16x8*)((Kb) + 4096 + koff1)
    { KFR(ring); QK4(sA0, sA1, k00, k10, k01, k11); }
    if (qb == 0) attn_mask(sA0, sA1, 0, qrel, hh);
#define SB() __builtin_amdgcn_sched_barrier(0)
#define E4(X, B) do { X[B] = EX2(X[B]); X[B + 1] = EX2(X[B + 1]); X[B + 2] = EX2(X[B + 2]); X[B + 3] = EX2(X[B + 3]); l += X[B]; l += X[B + 1]; l += X[B + 2]; l += X[B + 3]; } while (0)
#define ATT_STEP(C0, C1, N0, N1, PP_, PN_, tt, SV, SK, SD) do { \
        const bool nx = (tt) + 1 < NT; \
        { const int tl_ = (tt) + 4 < NT ? (tt) + 4 : NT - 1; \
          glds16(kdma + (size_t)tl_ * 64 * PP, (unsigned)__builtin_amdgcn_readfirstlane((int)(ring0 + (SD) * AT_SLOT + wid * 1024))); \
          glds16(vdma + (size_t)tl_ * 64 * PP, (unsigned)__builtin_amdgcn_readfirstlane((int)(ring0 + (SD) * AT_SLOT + 8192 + wid * 1024))); } \
        const LAS unsigned char* Vb = ring + (SV) * AT_SLOT; const LAS unsigned char* Kb = ring + (SK) * AT_SLOT; \
        bf16x8 va0 = tr2(Vb + voff0), vb0 = tr2(Vb + voff1), va1 = tr2(Vb + 2048 + voff0), vb1 = tr2(Vb + 2048 + voff1); \
        float mx = fmaxf(C0[0], C1[0]); \
        _Pragma("unroll") for (int i = 1; i < 16; ++i) mx = fmaxf(fmaxf(mx, C0[i]), C1[i]); \
        mx = xhalf_max(mx); \
        if ((tt) == 0 || __any(mx > 8.0f)) { const float d = ((tt) == 0) ? mx : fmaxf(mx, 0.f), al = EX2(-d); m += d; \
            _Pragma("unroll") for (int i = 0; i < 16; ++i) { o0[i] *= al; o1[i] *= al; C0[i] -= d; C1[i] -= d; negm[i] = -m; } l *= al; \
            _Pragma("unroll") for (int i = 0; i < 4; ++i) { u32x4 w = __builtin_bit_cast(u32x4, PP_[i]); \
                w.x = pk2(bflo(w.x) * al, bfhi(w.x) * al); w.y = pk2(bflo(w.y) * al, bfhi(w.y) * al); w.z = pk2(bflo(w.z) * al, bfhi(w.z) * al); w.w = pk2(bflo(w.w) * al, bfhi(w.w) * al); PP_[i] = __builtin_bit_cast(bf16x8, w); } } \
        SB(); \
        o0 = MFMA32(va0, PP_[0], o0); E4(C0, 0); SB(); \
        o1 = MFMA32(vb0, PP_[0], o1); E4(C0, 4); SB(); \
        const bf16x8 va2 = tr2(Vb + 4096 + voff0), vb2 = tr2(Vb + 4096 + voff1), va3 = tr2(Vb + 6144 + voff0), vb3 = tr2(Vb + 6144 + voff1); \
        o0 = MFMA32(va1, PP_[1], o0); E4(C0, 8); SB(); \
        o1 = MFMA32(vb1, PP_[1], o1); E4(C0, 12); SB(); \
        o0 = MFMA32(va2, PP_[2], o0); PN_[0] = pack8(C0, 0); PN_[1] = pack8(C0, 8); SB(); \
        o1 = MFMA32(vb2, PP_[2], o1); E4(C1, 0); SB(); \
        KFR(Kb); \
        o0 = MFMA32(va3, PP_[3], o0); E4(C1, 4); SB(); \
        o1 = MFMA32(vb3, PP_[3], o1); E4(C1, 8); SB(); \
        E4(C1, 12); PN_[2] = pack8(C1, 0); PN_[3] = pack8(C1, 8); SB(); \
        QK4(N0, N1, k00, k10, k01, k11); \
        if (nx && (tt) + 1 >= 2 * qb) attn_mask(N0, N1, ((tt) + 1 - 2 * qb) * 64, qrel, hh); \
        asm volatile("s_waitcnt vmcnt(4)" ::: "memory"); asm volatile("s_waitcnt lgkmcnt(0)" ::: "memory"); __builtin_amdgcn_s_barrier(); asm volatile("" ::: "memory"); \
    } while (0)
    int t = 0;
    for (; t + 6 <= NT; t += 6) {
        ATT_STEP(sA0, sA1, sB0, sB1, pA, pB, t, (t == 0 ? 0 : 5), 1, 4);
        ATT_STEP(sB0, sB1, sA0, sA1, pB, pA, t + 1, 0, 2, 5);
        ATT_STEP(sA0, sA1, sB0, sB1, pA, pB, t + 2, 1, 3, 0);
        ATT_STEP(sB0, sB1, sA0, sA1, pB, pA, t + 3, 2, 4, 1);
        ATT_STEP(sA0, sA1, sB0, sB1, pA, pB, t + 4, 3, 5, 2);
        ATT_STEP(sB0, sB1, sA0, sA1, pB, pA, t + 5, 4, 0, 3);
    }
    if (t < NT) {
        ATT_STEP(sA0, sA1, sB0, sB1, pA, pB, t, (t == 0 ? 0 : 5), 1, 4);
        ATT_STEP(sB0, sB1, sA0, sA1, pB, pA, t + 1, 0, 2, 5);
        if (t + 2 < NT) {
            ATT_STEP(sA0, sA1, sB0, sB1, pA, pB, t + 2, 1, 3, 0);
            ATT_STEP(sB0, sB1, sA0, sA1, pB, pA, t + 3, 2, 4, 1);
        }
    }
#undef ATT_STEP
#undef QK4
#undef KFR
    { const LAS unsigned char* Vb = ring + ((NT - 1) % AT_NSLOT) * AT_SLOT;
#pragma unroll
      for (int kk = 0; kk < 4; ++kk) { o0 = MFMA32(tr2(Vb + kk * 2048 + voff0), pA[kk], o0); o1 = MFMA32(tr2(Vb + kk * 2048 + voff1), pA[kk], o1); } }
#undef E4
#undef SB
    l = xor32_add(l);
    const float inv = 1.0f / l;
    LAS float* cmb = (LAS float*)(lds + AT_CMB) + ws * 2048;
    if (comp == 1) {
#pragma unroll
        for (int i = 0; i < 16; ++i) { cmb[i * 64 + lane] = o0[i] * inv; cmb[(16 + i) * 64 + lane] = o1[i] * inv; }
    }
    asm volatile("s_waitcnt vmcnt(0) lgkmcnt(0)" ::: "memory"); __builtin_amdgcn_s_barrier(); asm volatile("" ::: "memory");
    {
        const bool hn = nqb >= 0; const int nqb_ = hn ? nqb : 0;
        if (hn) { const bf16* nk = proj + ((size_t)nb * SEQ + 8 * wid + (lane >> 3)) * PP + C_DK + nh * 64 + (((lane & 7) ^ (lane >> 3)) << 3); const int nnt = 2 * nqb + 2;
            DMA_TILE_P(nk, nnt, 0, 0); DMA_TILE_P(nk, nnt, 1, 1); DMA_TILE_P(nk, nnt, 2, 2); DMA_TILE_P(nk, nnt, 3, 3); }
        const bf16* nq = proj + ((size_t)nb * SEQ + nqb_ * 128) * PP + C_DQ + nh * 64;
#pragma unroll
        for (int i = 0; i < 2; ++i) { const int id = tid + 512 * i; qn[i] = *(const u32x4*)(nq + (size_t)(id >> 3) * PP + (id & 7) * 8); } }
#undef DMA_TILE_P
    if (comp == 0) {
        float ss = 0.f;
#pragma unroll
        for (int i = 0; i < 16; ++i) { o0[i] = o0[i] * inv - lam * cmb[i * 64 + lane]; o1[i] = o1[i] * inv - lam * cmb[(16 + i) * 64 + lane]; ss += o0[i] * o0[i] + o1[i] * o1[i]; }
        ss = xor32_add(ss);
        const float rn = rsqrtf(ss * (1.0f / 64.0f) + RMS_EPS) * oscale;
        bf16* orow = mix + (tb + qb * 128 + ws * 32 + r32) * 1024 + 768 + h * 64;
#pragma unroll
        for (int g4 = 0; g4 < 4; ++g4) { const int e0 = 8 * g4 + 4 * hh;
            const f32x4 n0 = *(const f32x4*)(normg + e0), n1 = *(const f32x4*)(normg + 32 + e0);
            u32x2 w0, w1; w0.x = pk2(o0[4 * g4] * rn * n0[0], o0[4 * g4 + 1] * rn * n0[1]); w0.y = pk2(o0[4 * g4 + 2] * rn * n0[2], o0[4 * g4 + 3] * rn * n0[3]);
            w1.x = pk2(o1[4 * g4] * rn * n1[0], o1[4 * g4 + 1] * rn * n1[1]); w1.y = pk2(o1[4 * g4 + 2] * rn * n1[2], o1[4 * g4 + 3] * rn * n1[3]);
            *(u32x2*)(orow + e0) = w0; *(u32x2*)(orow + 32 + e0) = w1; }
    }
    __syncthreads();
}

__device__ __forceinline__ void conv_unit(const bf16* proj, bf16* mix, const float* cw, int t0) {
    const int tid = opaque_tid();
    const int c = 8 * (tid & 31), tg = tid >> 5;
    float w0[8], w1[8], w2[8];
#pragma unroll
    for (int i = 0; i < 8; ++i) { w0[i] = cw[c + i]; w1[i] = cw[256 + c + i]; w2[i] = cw[512 + c + i]; }
#pragma unroll
    for (int pass = 0; pass < 2; ++pass) {
        const int ts = t0 + pass * 64 + tg * 4, spos = ts & (SEQ - 1);
        float z[6][8];
#pragma unroll
        for (int r = 0; r < 6; ++r) {
            if (spos - 2 + r >= 0) { const bf16* p = proj + (size_t)(ts - 2 + r) * PP; const u32x4 u = *(const u32x4*)(p + C_CU + c), g = *(const u32x4*)(p + C_CGC + c);
                z[r][0] = bflo(u.x) * bflo(g.x); z[r][1] = bfhi(u.x) * bfhi(g.x); z[r][2] = bflo(u.y) * bflo(g.y); z[r][3] = bfhi(u.y) * bfhi(g.y);
                z[r][4] = bflo(u.z) * bflo(g.z); z[r][5] = bfhi(u.z) * bfhi(g.z); z[r][6] = bflo(u.w) * bflo(g.w); z[r][7] = bfhi(u.w) * bfhi(g.w); }
            else {
#pragma unroll
                for (int i = 0; i < 8; ++i) z[r][i] = 0.f; } }
#pragma unroll
        for (int r = 0; r < 4; ++r) { const u32x4 bb = *(const u32x4*)(proj + (size_t)(ts + r) * PP + C_CGB + c);
            const float g8[8] = {bflo(bb.x), bfhi(bb.x), bflo(bb.y), bfhi(bb.y), bflo(bb.z), bfhi(bb.z), bflo(bb.w), bfhi(bb.w)};
            float y[8];
#pragma unroll
            for (int i = 0; i < 8; ++i) y[i] = g8[i] * (w0[i] * z[r][i] + w1[i] * z[r + 1][i] + w2[i] * z[r + 2][i]);
            u32x4 o; o.x = pk2(y[0], y[1]); o.y = pk2(y[2], y[3]); o.z = pk2(y[4], y[5]); o.w = pk2(y[6], y[7]);
            *(u32x4*)(mix + (size_t)(ts + r) * 1024 + c) = o; }
    }
}

__device__ __forceinline__ void scan128(float& v0, float& v1, int lane) {
    float s = v0 + v1, inc = s;
#pragma unroll
    for (int o = 1; o < 64; o <<= 1) { const float t = shfl_from(inc, lane >= o ? lane - o : lane, lane); if (lane >= o) inc += t; }
    const float ex = inc - s; v0 = ex + v0; v1 = v0 + v1;
}

template <int ROWS, int NCOLS> struct TileRegs { static constexpr int CPR = NCOLS / 8, N = ROWS * CPR, IT = (N + NTHREADS - 1) / NTHREADS; u32x4 v[IT]; };
template <int ROWS, int NCOLS> __device__ __forceinline__ void tile_fetch(TileRegs<ROWS, NCOLS>& r, const bf16* src, int pitch, int tid) {
    typedef TileRegs<ROWS, NCOLS> TR;
#pragma unroll
    for (int i = 0; i < TR::IT; ++i) { int id = tid + NTHREADS * i; if (TR::N % NTHREADS != 0) id = id < TR::N ? id : TR::N - 1; const int row = id / TR::CPR, ch = id % TR::CPR; r.v[i] = *(const u32x4*)(src + (size_t)row * pitch + ch * 8); }
}
template <int NCOLS> __device__ __forceinline__ void conv_fetch(TileRegs<131, NCOLS>& r, const bf16* proj, int col, int t0, int tid) {
    typedef TileRegs<131, NCOLS> TR; const bool first = (t0 & (SEQ - 1)) == 0;
#pragma unroll
    for (int i = 0; i < TR::IT; ++i) { int id = tid + NTHREADS * i; id = id < TR::N ? id : TR::N - 1; const int row = id / TR::CPR, ch = id % TR::CPR; const bool z = first && row < 3;
        const u32x4 v = *(const u32x4*)(proj + (size_t)(t0 - 3 + (z ? 3 : row)) * PP + col + ch * 8); r.v[i] = z ? (u32x4){0u, 0u, 0u, 0u} : v; }
}
template <int ROWS, int NCOLS> __device__ __forceinline__ void tile_commit(const TileRegs<ROWS, NCOLS>& r, LAS unsigned char* dst, int dstride, int tid) {
    typedef TileRegs<ROWS, NCOLS> TR;
#pragma unroll
    for (int i = 0; i < TR::IT; ++i) { const int id = tid + NTHREADS * i; if (TR::N % NTHREADS == 0 || id < TR::N) { const int row = id / TR::CPR, ch = id % TR::CPR; *(LAS u32x4*)(dst + row * dstride + ch * 16) = r.v[i]; } }
}
struct ConvWin { float h0a, h0b, h1a, h1b, h2a, h2b; };
__device__ __forceinline__ void conv_win_init(ConvWin& w, const LAS unsigned char* tile, int stride, int col, int j0) {
    const unsigned u0 = *(const LAS unsigned*)(tile + j0 * stride + col * 2), u1 = *(const LAS unsigned*)(tile + (j0 + 1) * stride + col * 2), u2 = *(const LAS unsigned*)(tile + (j0 + 2) * stride + col * 2);
    w.h0a = bflo(u0); w.h0b = bfhi(u0); w.h1a = bflo(u1); w.h1b = bfhi(u1); w.h2a = bflo(u2); w.h2b = bfhi(u2);
}
__device__ __forceinline__ void conv_run(ConvWin& w, LAS unsigned char* tile, int stride, int col, int j0, int nj, const float* cw, const float* cb, int xc, const LAS float* sc, int scs) {
    const float w0a = cw[xc], w0b = cw[xc + 1], w1a = cw[768 + xc], w1b = cw[769 + xc], w2a = cw[1536 + xc], w2b = cw[1537 + xc], w3a = cw[2304 + xc], w3b = cw[2305 + xc];
    const float ba = cb[xc], bb = cb[xc + 1];
    unsigned raw[16];
#pragma unroll
    for (int i = 0; i < 16; ++i) raw[i] = *(const LAS unsigned*)(tile + (j0 + i + 3) * stride + col * 2);
#pragma unroll
    for (int i = 0; i < 16; ++i) { const int j = j0 + i;
        const unsigned u = raw[i]; const float xa = bflo(u), xb = bfhi(u);
        float ya = siluf(w0a * w.h0a + w1a * w.h1a + w2a * w.h2a + w3a * xa + ba), yb = siluf(w0b * w.h0b + w1b * w.h1b + w2b * w.h2b + w3b * xb + bb);
        if (sc) { const float f = sc[j * scs]; ya *= f; yb *= f; }
        *(LAS unsigned*)(tile + (j + 3) * stride + col * 2) = pk2(ya, yb);
        w.h0a = w.h1a; w.h0b = w.h1b; w.h1a = w.h2a; w.h1b = w.h2b; w.h2a = xa; w.h2b = xb; }
    (void)nj;
}

constexpr int SA_X = 0, SA_B = 69632, SA_DT = 139264, SA_SC = 141312, SA_OFF = 3 * 528;
__device__ __forceinline__ void ssd_a_unit(LAS unsigned char* lds, const Args& A, int l, const bf16* proj, int b, int ch) {
    const int tid = opaque_tid(), lane = tid & 63, wid = __builtin_amdgcn_readfirstlane(tid >> 6), r32 = lane & 31, hh = lane >> 5;
    const int t0 = b * SEQ + ch * 128;
    LAS float* dts = (LAS float*)(lds + SA_DT); LAS float* scs = (LAS float*)(lds + SA_SC);
    const float* alog = A.in[I_SSD_ALOG] + l * 4; const float* dtb = A.in[I_SSD_DTB] + l * 4;
    { TileRegs<131, 256> rx, rb; conv_fetch<256>(rx, proj, C_SX, t0, tid); conv_fetch<256>(rb, proj, C_SB, t0, tid);
      const unsigned short dt_raw = proj[(size_t)(t0 + (tid >> 2)) * PP + C_SDT + (tid & 3)];
      tile_commit<131, 256>(rx, lds + SA_X, 528, tid); tile_commit<131, 256>(rb, lds + SA_B, 528, tid);
      dts[(tid >> 2) * 4 + (tid & 3)] = softplusf(bf2f(dt_raw) + dtb[tid & 3]); }
    __syncthreads();
    ConvWin cwn[4];
#pragma unroll
    for (int k = 0; k < 4; ++k) { const int id = tid + NTHREADS * k, cp = id & 255, rg = id >> 8, xc = 2 * cp; conv_win_init(cwn[k], lds + (xc < 256 ? SA_X : SA_B), 528, xc & 255, rg * 16); }
    if (wid < 4) { const int hd = wid; const float a = -__expf(alog[hd]); const float d0 = dts[(2 * lane) * 4 + hd], d1 = dts[(2 * lane + 1) * 4 + hd];
        float c0 = d0 * a, c1 = d1 * a; scan128(c0, c1, lane);
        const float cl = shfl_from(c1, 63, lane);
        scs[(2 * lane) * 4 + hd] = d0 * __expf(cl - c0); scs[(2 * lane + 1) * 4 + hd] = d1 * __expf(cl - c1);
        if (lane == 0) ((float*)(A.ws + WS_SSDDEC))[(b * 16 + ch) * 4 + hd] = __expf(cl); }
    __syncthreads();
#pragma unroll
    for (int k = 0; k < 4; ++k) { const int id = tid + NTHREADS * k, cp = id & 255, rg = id >> 8, xc = 2 * cp;
        conv_run(cwn[k], lds + (xc < 256 ? SA_X : SA_B), 528, xc & 255, rg * 16, 16, A.in[I_SSD_CW] + l * 4 * 768, A.in[I_SSD_CB] + l * 768, xc, xc < 256 ? scs + (xc >> 6) : nullptr, 4); }
    __syncthreads();
    { const int hd = wid >> 1, tp = wid & 1, g = hd >> 1;
      const LAS unsigned char* Xd = lds + SA_X + SA_OFF; const LAS unsigned char* Bd = lds + SA_B + SA_OFF;
      f32x16 acc[4] = {ZERO16, ZERO16, ZERO16, ZERO16};
#pragma unroll 2
      for (int ks = 0; ks < 8; ++ks) { const bf16x8 a = fragT(Xd, 528, ks * 16, hd * 64 + tp * 32, lane);
#pragma unroll
          for (int tn = 0; tn < 4; ++tn) acc[tn] = MFMA32(a, fragT(Bd, 528, ks * 16, g * 128 + tn * 32, lane), acc[tn]); }
      float* st = (float*)(A.ws + A_ST) + ((size_t)((b * 16 + ch) * 4 + hd)) * 8192;
#pragma unroll
      for (int tn = 0; tn < 4; ++tn)
#pragma unroll
          for (int i = 0; i < 16; ++i) st[(tp * 32 + crow(i, hh)) * 128 + tn * 32 + r32] = acc[tn][i]; }
    __syncthreads();
}

__device__ __forceinline__ void gla_cum(const LAS unsigned char* lrs, LAS float* cum, const float* wlr, const float* blr, int tid) {
    LAS float* tot = cum + 64 * 128;
    const int col = tid & 127, seg = tid >> 7;
    float c16[16];
    { float w[16];
#pragma unroll
      for (int r = 0; r < 16; ++r) w[r] = wlr[r * 128 + col];
      const float bias = blr[col]; float run = 0.f;
#pragma unroll
      for (int i = 0; i < 16; ++i) { const int j = seg * 16 + i; const u32x4 a = *(const LAS u32x4*)(lrs + j * 48), c = *(const LAS u32x4*)(lrs + j * 48 + 16);
          float d = bias;
          d += bflo(a.x) * w[0] + bfhi(a.x) * w[1] + bflo(a.y) * w[2] + bfhi(a.y) * w[3] + bflo(a.z) * w[4] + bfhi(a.z) * w[5] + bflo(a.w) * w[6] + bfhi(a.w) * w[7];
          d += bflo(c.x) * w[8] + bfhi(c.x) * w[9] + bflo(c.y) * w[10] + bfhi(c.y) * w[11] + bflo(c.z) * w[12] + bfhi(c.z) * w[13] + bflo(c.w) * w[14] + bfhi(c.w) * w[15];
          run += logsigmoidf(d) * (1.0f / 16.0f); c16[i] = run; }
      tot[seg * 128 + col] = run; }
    __syncthreads();
    { float off = 0.f;
#pragma unroll
      for (int q = 0; q < 3; ++q) off += (q < seg) ? tot[q * 128 + col] : 0.f;
#pragma unroll
      for (int i = 0; i < 16; ++i) cum[(seg * 16 + i) * 128 + col] = c16[i] + off; }
    __syncthreads();
}
constexpr int GA_LR = 0, GA_K = 3072, GA_V = 20480, GA_CUM = 54272;
__device__ __forceinline__ void gla_a_unit(LAS unsigned char* lds, const Args& A, int l, const bf16* proj, int b, int ch) {
    const int tid = opaque_tid(), lane = tid & 63, wid = __builtin_amdgcn_readfirstlane(tid >> 6), r32 = lane & 31, hh = lane >> 5;
    const size_t t0 = (size_t)b * SEQ + ch * 64;
    LAS float* cum = (LAS float*)(lds + GA_CUM);
    { TileRegs<64, 16> rl; TileRegs<64, 128> rk; TileRegs<64, 256> rv;
      tile_fetch<64, 16>(rl, proj + t0 * PP + C_GLR, PP, tid); tile_fetch<64, 128>(rk, proj + t0 * PP + C_GK, PP, tid); tile_fetch<64, 256>(rv, proj + t0 * PP + C_GV, PP, tid);
      tile_commit<64, 16>(rl, lds + GA_LR, 48, tid); tile_commit<64, 128>(rk, lds + GA_K, 272, tid); tile_commit<64, 256>(rv, lds + GA_V, 528, tid); }
    __syncthreads();
    gla_cum(lds + GA_LR, cum, A.in[I_GLA_WLR] + l * 16 * 128, A.in[I_GLA_BLR] + l * 128, tid);
    if (tid < 128) ((float*)(A.ws + WS_GLACL))[(b * 32 + ch) * 128 + tid] = cum[63 * 128 + tid];
    for (int id = tid; id < 64 * 64; id += NTHREADS) { const int j = id >> 6, c = (id & 63) * 2;
        LAS unsigned* p = (LAS unsigned*)(lds + GA_K + j * 272 + c * 2); const unsigned u = *p;
        *p = pk2(bflo(u) * __expf(cum[63 * 128 + c] - cum[j * 128 + c]), bfhi(u) * __expf(cum[63 * 128 + c + 1] - cum[j * 128 + c + 1])); }
    __syncthreads();
    { const int h = wid >> 1, te = wid & 1; f32x16 acc = ZERO16;
#pragma unroll
      for (int ks = 0; ks < 4; ++ks) acc = MFMA32(fragT(lds + GA_K, 272, ks * 16, h * 32, lane), fragT(lds + GA_V, 528, ks * 16, h * 64 + te * 32, lane), acc);
      float* ds = (float*)(A.ws + A_DST) + ((size_t)((b * 32 + ch) * 4 + h)) * 2048;
#pragma unroll
      for (int i = 0; i < 16; ++i) ds[crow(i, hh) * 64 + te * 32 + r32] = acc[i]; }
    __syncthreads();
}
constexpr int SM_X = 816, SM_B = 35840 + 816, SM_C = 71680 + 816, SM_S = 107520, SM_DT = 142336, SM_CUM = 143360, SM_RED = 144384;
__device__ __forceinline__ void ssd_main_unit(LAS unsigned char* lds, const Args& A, int l, const bf16* proj, bf16* mix, int b, int ch, int g) {
    const int tid = opaque_tid(), lane = tid & 63, wid = __builtin_amdgcn_readfirstlane(tid >> 6), r32 = lane & 31, hh = lane >> 5;
    const int t0 = b * SEQ + ch * 128;
    LAS float* dts = (LAS float*)(lds + SM_DT); LAS float* cums = (LAS float*)(lds + SM_CUM); LAS float* red = (LAS float*)(lds + SM_RED);
    TileRegs<128, 128> rz;
    const unsigned short dt_raw = proj[(size_t)(t0 + ((tid & 255) >> 1)) * PP + C_SDT + 2 * g + (tid & 1)];
    { const bf16* sp = (const bf16*)(A.ws + A_SP) + ((size_t)((b * 16 + ch) * 4 + 2 * g)) * 8192;
      TileRegs<128, 128> rs; TileRegs<131, 128> rx, rb, rc;
      tile_fetch<128, 128>(rs, sp, 128, tid);
      conv_fetch<128>(rx, proj, C_SX + g * 128, t0, tid); conv_fetch<128>(rb, proj, C_SB + g * 128, t0, tid); conv_fetch<128>(rc, proj, C_SC + g * 128, t0, tid);
      tile_fetch<128, 128>(rz, proj + (size_t)t0 * PP + C_SZ + g * 128, PP, tid);
      tile_commit<128, 128>(rs, lds + SM_S, 272, tid);
      tile_commit<131, 128>(rx, lds + SM_X - 816, 272, tid); tile_commit<131, 128>(rb, lds + SM_B - 816, 272, tid); tile_commit<131, 128>(rc, lds + SM_C - 816, 272, tid); }
    if (tid < 256) { const int j = tid >> 1, r = tid & 1; dts[j * 2 + r] = softplusf(bf2f(dt_raw) + A.in[I_SSD_DTB][l * 4 + 2 * g + r]); }
    __syncthreads();
    if (wid < 2) { const int r = wid; const float a = -__expf(A.in[I_SSD_ALOG][l * 4 + 2 * g + r]); float c0 = dts[(2 * lane) * 2 + r] * a, c1 = dts[(2 * lane + 1) * 2 + r] * a; scan128(c0, c1, lane);
        cums[(2 * lane) * 2 + r] = c0; cums[(2 * lane + 1) * 2 + r] = c1; }
    { ConvWin cwn[3];
#pragma unroll
      for (int k = 0; k < 3; ++k) { const int id = tid + NTHREADS * k, cp = id % 192, rg = id / 192, c2 = 2 * cp, sel = c2 >> 7, cc = c2 & 127;
          conv_win_init(cwn[k], lds + (sel == 0 ? SM_X : sel == 1 ? SM_B : SM_C) - 816, 272, cc, rg * 16); }
      __syncthreads();
#pragma unroll
      for (int k = 0; k < 3; ++k) { const int id = tid + NTHREADS * k, cp = id % 192, rg = id / 192, c2 = 2 * cp, sel = c2 >> 7, cc = c2 & 127;
          conv_run(cwn[k], lds + (sel == 0 ? SM_X : sel == 1 ? SM_B : SM_C) - 816, 272, cc, rg * 16, 16, A.in[I_SSD_CW] + l * 4 * 768, A.in[I_SSD_CB] + l * 768, sel * 256 + g * 128 + cc, nullptr, 0); } }
    __syncthreads();
    const int ti = wid & 3, tp = wid >> 2;
    f32x16 cb0 = ZERO16, cb1 = ZERO16, of0 = ZERO16, of1 = ZERO16;
#pragma unroll 2
    for (int ks = 0; ks < 8; ++ks) { const bf16x8 cf = fragN(lds + SM_C, 272, ti * 32, ks * 16, lane);
        cb0 = MFMA32(fragN(lds + SM_B, 272, (2 * tp) * 32, ks * 16, lane), cf, cb0); cb1 = MFMA32(fragN(lds + SM_B, 272, (2 * tp + 1) * 32, ks * 16, lane), cf, cb1);
        of0 = MFMA32(fragN(lds + SM_S, 272, tp * 32, ks * 16, lane), cf, of0); of1 = MFMA32(fragN(lds + SM_S + 17408, 272, tp * 32, ks * 16, lane), cf, of1); }
    __syncthreads();
    const int irow = ti * 32 + r32;
    f32x16 dg[2] = {ZERO16, ZERO16};
#pragma unroll
    for (int r = 0; r < 2; ++r) {
        const float ci = cums[irow * 2 + r];
#pragma unroll
        for (int s = 0; s < 2; ++s) { const f32x16& cbv = s ? cb1 : cb0; const int jb = (2 * tp + s) * 32;
#pragma unroll
            for (int g4 = 0; g4 < 4; ++g4) { float w[4];
#pragma unroll
                for (int e = 0; e < 4; ++e) { const int j = jb + 8 * g4 + 4 * hh + e; w[e] = (j <= irow) ? cbv[4 * g4 + e] * __expf(ci - cums[j * 2 + r]) * dts[j * 2 + r] : 0.f; }
                u32x2 o; o.x = pk2(w[0], w[1]); o.y = pk2(w[2], w[3]); *(LAS u32x2*)(lds + SM_B + irow * 272 + (jb + 8 * g4 + 4 * hh) * 2) = o; } }
        __syncthreads();
#pragma unroll 2
        for (int ks = 0; ks < 8; ++ks) dg[r] = MFMA32(fragT(lds + SM_X, 272, ks * 16, r * 64 + tp * 32, lane), fragN(lds + SM_B, 272, ti * 32, ks * 16, lane), dg[r]);
        __syncthreads();
    }
    tile_commit<128, 128>(rz, lds + SM_B, 272, tid);
    __syncthreads();
    float ss = 0.f;
#pragma unroll
    for (int r = 0; r < 2; ++r) { const float ec = __expf(cums[irow * 2 + r]), dsk = A.in[I_SSD_D][l * 4 + 2 * g + r]; const f32x16& ofv = r ? of1 : of0;
#pragma unroll
        for (int g4 = 0; g4 < 4; ++g4) { const int col = r * 64 + tp * 32 + 8 * g4 + 4 * hh;
            const u32x2 xu = *(const LAS u32x2*)(lds + SM_X + irow * 272 + col * 2), zu = *(const LAS u32x2*)(lds + SM_B + irow * 272 + col * 2);
            const float xv[4] = {bflo(xu.x), bfhi(xu.x), bflo(xu.y), bfhi(xu.y)}, zv[4] = {bflo(zu.x), bfhi(zu.x), bflo(zu.y), bfhi(zu.y)};
#pragma unroll
            for (int e = 0; e < 4; ++e) { const int i = 4 * g4 + e; const float y = (dg[r][i] + ec * ofv[i] + dsk * xv[e]) * siluf(zv[e]); dg[r][i] = y; ss += y * y; } } }
    ss = xor32_add(ss);
    if (hh == 0) red[tp * 128 + irow] = ss;
    __syncthreads();
    const float rn = rsqrtf((red[irow] + red[128 + irow]) * (1.0f / 128.0f) + RMS_EPS);
    const float* ng = A.in[I_SSD_NG] + l * 256 + g * 128;
    bf16* orow = mix + (size_t)(t0 + irow) * 1024 + 512 + g * 128;
#pragma unroll
    for (int r = 0; r < 2; ++r)
#pragma unroll
        for (int g4 = 0; g4 < 4; ++g4) { const int c0 = r * 64 + tp * 32 + 8 * g4 + 4 * hh; const f32x4 nv = *(const f32x4*)(ng + c0);
            u32x2 o; o.x = pk2(dg[r][4 * g4] * rn * nv[0], dg[r][4 * g4 + 1] * rn * nv[1]); o.y = pk2(dg[r][4 * g4 + 2] * rn * nv[2], dg[r][4 * g4 + 3] * rn * nv[3]);
            *(u32x2*)(orow + c0) = o; }
    __syncthreads();
}

constexpr int GM_LR = 0, GM_Q = 3072, GM_K = 20480, GM_V = 37888, GM_E = 71680, GM_S = 108544;
__device__ __forceinline__ void gla_main_unit(LAS unsigned char* lds, const Args& A, int l, const bf16* proj, bf16* mix, int b, int ch) {
    const int tid = opaque_tid(), lane = tid & 63, wid = __builtin_amdgcn_readfirstlane(tid >> 6), r32 = lane & 31, hh = lane >> 5;
    const size_t t0 = (size_t)b * SEQ + ch * 64;
    LAS float* cum = (LAS float*)(lds + GM_E);
    TileRegs<64, 256> rg;
    { TileRegs<64, 16> rl; TileRegs<64, 128> rq, rk; TileRegs<64, 256> rv; TileRegs<128, 64> rs;
      tile_fetch<64, 16>(rl, proj + t0 * PP + C_GLR, PP, tid); tile_fetch<64, 128>(rq, proj + t0 * PP + C_GQ, PP, tid); tile_fetch<64, 128>(rk, proj + t0 * PP + C_GK, PP, tid);
      tile_fetch<64, 256>(rv, proj + t0 * PP + C_GV, PP, tid);
      tile_fetch<128, 64>(rs, (const bf16*)(A.ws + A_GP) + ((size_t)(b * 32 + ch) * 4) * 2048, 64, tid);
      tile_fetch<64, 256>(rg, proj + t0 * PP + C_GG, PP, tid);
      tile_commit<64, 16>(rl, lds + GM_LR, 48, tid); tile_commit<64, 128>(rq, lds + GM_Q, 272, tid); tile_commit<64, 128>(rk, lds + GM_K, 272, tid);
      tile_commit<64, 256>(rv, lds + GM_V, 528, tid); tile_commit<128, 64>(rs, lds + GM_S, 144, tid); }
    __syncthreads();
    gla_cum(lds + GM_LR, cum, A.in[I_GLA_WLR] + l * 16 * 128, A.in[I_GLA_BLR] + l * 128, tid);
    for (int id = tid; id < 64 * 64; id += NTHREADS) { const int j = id >> 6, c = (id & 63) * 2; const float c0 = cum[j * 128 + c], c1 = cum[j * 128 + c + 1];
        LAS unsigned* qp = (LAS unsigned*)(lds + GM_Q + j * 272 + c * 2); LAS unsigned* kp = (LAS unsigned*)(lds + GM_K + j * 272 + c * 2); const unsigned qu = *qp, ku = *kp;
        *qp = pk2(bflo(qu) * 0.17677669529663687f * __expf(c0), bfhi(qu) * 0.17677669529663687f * __expf(c1));
        *kp = pk2(bflo(ku) * __expf(-c0), bfhi(ku) * __expf(-c1)); }
    __syncthreads();
    const int h = wid >> 1, ti = wid & 1, irow = ti * 32 + r32;
    { f32x16 a0 = ZERO16, a1 = ZERO16;
#pragma unroll
      for (int ks = 0; ks < 2; ++ks) { const bf16x8 qf = fragN(lds + GM_Q, 272, ti * 32, h * 32 + ks * 16, lane);
          a0 = MFMA32(fragN(lds + GM_K, 272, 0, h * 32 + ks * 16, lane), qf, a0); a1 = MFMA32(fragN(lds + GM_K, 272, 32, h * 32 + ks * 16, lane), qf, a1); }
      LAS unsigned char* ar = lds + GM_E + h * 9216 + irow * 144;
#pragma unroll
      for (int g4 = 0; g4 < 4; ++g4) { float w0[4], w1[4];
#pragma unroll
          for (int e = 0; e < 4; ++e) { const int j = 8 * g4 + 4 * hh + e; w0[e] = (j <= irow) ? a0[4 * g4 + e] : 0.f; w1[e] = (j + 32 <= irow) ? a1[4 * g4 + e] : 0.f; }
          u32x2 o0, o1; o0.x = pk2(w0[0], w0[1]); o0.y = pk2(w0[2], w0[3]); o1.x = pk2(w1[0], w1[1]); o1.y = pk2(w1[2], w1[3]);
          *(LAS u32x2*)(ar + (8 * g4 + 4 * hh) * 2) = o0; *(LAS u32x2*)(ar + (32 + 8 * g4 + 4 * hh) * 2) = o1; } }
    __syncthreads();
    f32x16 o[2] = {ZERO16, ZERO16};
#pragma unroll
    for (int te = 0; te < 2; ++te) {
#pragma unroll
        for (int ks = 0; ks < 4; ++ks) o[te] = MFMA32(fragT(lds + GM_V, 528, ks * 16, h * 64 + te * 32, lane), fragN(lds + GM_E + h * 9216, 144, ti * 32, ks * 16, lane), o[te]);
#pragma unroll
        for (int ks = 0; ks < 2; ++ks) o[te] = MFMA32(fragT(lds + GM_S + h * 4608, 144, ks * 16, te * 32, lane), fragN(lds + GM_Q, 272, ti * 32, h * 32 + ks * 16, lane), o[te]); }
    __syncthreads();
    tile_commit<64, 256>(rg, lds + GM_V, 528, tid);
    __syncthreads();
    { float ss = 0.f;
#pragma unroll
      for (int i = 0; i < 16; ++i) ss += o[0][i] * o[0][i] + o[1][i] * o[1][i];
      ss = xor32_add(ss);
      const float rn = rsqrtf(ss * (1.0f / 64.0f) + RMS_EPS);
      const float* ng = A.in[I_GLA_NG] + l * 64;
      bf16* orow = mix + (t0 + irow) * 1024 + 256 + h * 64;
#pragma unroll
      for (int te = 0; te < 2; ++te)
#pragma unroll
          for (int g4 = 0; g4 < 4; ++g4) { const int e0 = te * 32 + 8 * g4 + 4 * hh; const f32x4 nv = *(const f32x4*)(ng + e0);
              const u32x2 gz = *(const LAS u32x2*)(lds + GM_V + irow * 528 + (h * 64 + e0) * 2);
              u32x2 w; w.x = pk2(o[te][4 * g4] * rn * nv[0] * siluf(bflo(gz.x)), o[te][4 * g4 + 1] * rn * nv[1] * siluf(bfhi(gz.x)));
              w.y = pk2(o[te][4 * g4 + 2] * rn * nv[2] * siluf(bflo(gz.y)), o[te][4 * g4 + 3] * rn * nv[3] * siluf(bfhi(gz.y)));
              *(u32x2*)(orow + e0) = w; } }
    __syncthreads();
}

__device__ __forceinline__ void scan_phase(const Args& A, int gtid, int gthreads) {
    for (int gi = gtid; gi < NB * 4 * 2048; gi += gthreads) {
        const int bh = gi >> 11, b = bh >> 2, h = bh & 3, i4 = (gi & 2047) * 4;
        const float* st = (const float*)(A.ws + A_ST) + ((size_t)(b * 16) * 4 + h) * 8192 + i4;
        const float* dec = (const float*)(A.ws + WS_SSDDEC) + (b * 16) * 4 + h;
        bf16* sp = (bf16*)(A.ws + A_SP) + ((size_t)(b * 16) * 4 + h) * 8192 + i4;
        f32x4 v[16];
#pragma unroll
        for (int c = 0; c < 16; ++c) v[c] = *(const f32x4*)(st + (size_t)c * 4 * 8192);
        f32x4 s = {0.f, 0.f, 0.f, 0.f};
#pragma unroll
        for (int c = 0; c < 16; ++c) { u32x2 o; o.x = pk2(s[0], s[1]); o.y = pk2(s[2], s[3]); *(u32x2*)(sp + (size_t)c * 4 * 8192) = o; s = s * dec[c * 4] + v[c]; }
    }
    for (int gi = gtid; gi < NB * 4 * 2048; gi += gthreads) {
        const int bh = gi >> 11, b = bh >> 2, h = bh & 3, idx = gi & 2047, d = idx >> 6;
        const float* ds = (const float*)(A.ws + A_DST) + ((size_t)(b * 32) * 4 + h) * 2048 + idx;
        const float* cl = (const float*)(A.ws + WS_GLACL) + (size_t)(b * 32) * 128 + h * 32 + d;
        bf16* gp = (bf16*)(A.ws + A_GP) + ((size_t)(b * 32) * 4 + h) * 2048 + idx;
        float v[32], dc[32];
#pragma unroll
        for (int c = 0; c < 32; ++c) { v[c] = ds[(size_t)c * 4 * 2048]; dc[c] = cl[c * 128]; }
        float s = 0.f;
#pragma unroll
        for (int c = 0; c < 32; ++c) { gp[(size_t)c * 4 * 2048] = f2bf(s); s = s * __expf(dc[c]) + v[c]; }
    }
}
constexpr int R4_W = 0, R4_WS = 99072, R4_G = 124672, R4_B = 128768, R4_HIST = 132864, R4_CS = 132992, R4_ASG = 133376;
__device__ __forceinline__ void p4_route(LAS unsigned char* lds, const Args& A, int l, int blk) {
    const int tid = opaque_tid(), lane = tid & 63, wid = __builtin_amdgcn_readfirstlane(tid >> 6);
    const bf16* v = (const bf16*)(A.ws + A_V); bf16* x1 = (bf16*)(A.ws + A_X1);
    { const bf16* wrt = (const bf16*)(A.ws + WS_WRT + l * WRT_LAYER);
      { TileRegs<48, 1024> rt; tile_fetch<48, 1024>(rt, wrt, 1024, tid); tile_commit<48, 1024>(rt, lds + R4_W, 2064, tid); }
      LAS float* gs = (LAS float*)(lds + R4_G); LAS float* bs = (LAS float*)(lds + R4_B);
      for (int k = tid; k < 1024; k += NTHREADS) { gs[k] = A.in[I_LN1G][l * 1024 + k]; bs[k] = A.in[I_LN1B][l * 1024 + k]; }
      if (tid < 32) ((LAS int*)(lds + R4_HIST))[tid] = 0;
      if (tid < 96) ((LAS float*)(lds + R4_CS))[tid] = ((const float*)(A.ws + WS_RCS + l * WRT_LAYER))[tid]; }
    __syncthreads();
    const int tok0 = blk * 128 + wid * 16, fr = lane & 15, fq = lane >> 4;
    LAS float* stat = (LAS float*)(lds + R4_WS + wid * 3200); LAS float* lg = stat + 32;
    const LAS float* cs = (const LAS float*)(lds + R4_CS);
    pg8::f32x4 acc[3] = {{0.f, 0.f, 0.f, 0.f}, {0.f, 0.f, 0.f, 0.f}, {0.f, 0.f, 0.f, 0.f}};
    float s1 = 0.f, s2 = 0.f;
    const bf16* vrow = v + (size_t)(tok0 + fr) * 1024 + 8 * fq;
#pragma unroll 8
    for (int s = 0; s < 32; ++s) {
        const u32x4 au = *(const u32x4*)(vrow + 32 * s); const bf16x8 a = __builtin_bit_cast(bf16x8, au);
#pragma unroll
        for (int bk = 0; bk < 3; ++bk) { const bf16x8 bfr = *(const LAS bf16x8*)(lds + R4_W + (bk * 16 + fr) * 2064 + (32 * s + 8 * fq) * 2);
            acc[bk] = __builtin_amdgcn_mfma_f32_16x16x32_bf16(a, bfr, acc[bk], 0, 0, 0); }
        const float e0 = bflo(au.x), e1 = bfhi(au.x), e2 = bflo(au.y), e3 = bfhi(au.y), e4 = bflo(au.z), e5 = bfhi(au.z), e6 = bflo(au.w), e7 = bfhi(au.w);
        s1 += ((e0 + e1) + (e2 + e3)) + ((e4 + e5) + (e6 + e7));
        s2 += ((e0 * e0 + e1 * e1) + (e2 * e2 + e3 * e3)) + ((e4 * e4 + e5 * e5) + (e6 * e6 + e7 * e7));
    }
    s1 += shflx(s1, 16, lane); s1 = xor32_add(s1); s2 += shflx(s2, 16, lane); s2 = xor32_add(s2);
    { const float mean = s1 * (1.0f / 1024.0f), var = fmaxf(s2 * (1.0f / 1024.0f) - mean * mean, 0.f), rstd = rsqrtf(var + LN_EPS);
      if (lane < 16) { stat[2 * lane] = mean; stat[2 * lane + 1] = rstd; f32x2 mr; mr.x = mean; mr.y = rstd; ((f32x2*)(A.ws + WS_LNSTAT))[tok0 + lane] = mr; } }
#pragma unroll
    for (int r = 0; r < 4; ++r) { const int tk = 4 * fq + r; const float mean = stat[2 * tk], rstd = stat[2 * tk + 1];
#pragma unroll
        for (int bk = 0; bk < 3; ++bk) { const int j = bk * 16 + fr; lg[tk * 48 + j] = rstd * (acc[bk][r] - mean * cs[j]) + cs[48 + j]; } }
    if (lane < 16) {
        const LAS float* q = lg + lane * 48;
        int grp = 0; float gm = q[0];
#pragma unroll
        for (int i = 1; i < 4; ++i) if (q[i] > gm) { gm = q[i]; grp = i; }
        float gsum = 0.f;
#pragma unroll
        for (int i = 0; i < 4; ++i) gsum += __expf(q[i] - gm);
        const float pg = 1.0f / gsum;
        float el[8];
#pragma unroll
        for (int i = 0; i < 8; ++i) el[i] = q[4 + grp * 8 + i];
        int i1 = 0; float m1 = el[0];
#pragma unroll
        for (int i = 1; i < 8; ++i) if (el[i] > m1) { m1 = el[i]; i1 = i; }
        int i2 = -1; float m2 = -INFINITY;
#pragma unroll
        for (int i = 0; i < 8; ++i) if (i != i1 && el[i] > m2) { m2 = el[i]; i2 = i; }
        const float p2 = __expf(m2 - m1), den = 1.0f / (1.0f + p2);
        const int tokn = tok0 + lane, ex1 = grp * 8 + i1, ex2 = grp * 8 + i2;
        LAS int* hist = (LAS int*)(lds + R4_HIST);
        const int r1 = atomicAdd((int*)(hist + ex1), 1), r2 = atomicAdd((int*)(hist + ex2), 1);
        LAS int* ae = (LAS int*)(lds + R4_ASG); LAS float* ag = (LAS float*)(lds + R4_ASG + 1024); LAS int* ar = (LAS int*)(lds + R4_ASG + 2048); const int lt = wid * 16 + lane; (void)tokn;
        ae[2 * lt] = ex1; ae[2 * lt + 1] = ex2; ag[2 * lt] = pg * den; ag[2 * lt + 1] = pg * p2 * den; ar[2 * lt] = r1; ar[2 * lt + 1] = r2;
    }
    __syncthreads();
    if (tid < NSLOT_MAX / 256) ((int*)(A.ws + WS_SLOTTOK))[blk * (NSLOT_MAX / 256) + tid] = 0;
    if (tid < 32) ((int*)(A.ws + WS_WGCNT))[blk * 32 + tid] = ((LAS int*)(lds + R4_HIST))[tid];
    asm volatile("s_waitcnt vmcnt(0)" ::: "memory"); __syncthreads();
    unsigned* pubcnt = (unsigned*)(A.ws + WS_BAR + 14336) + l * 64;
    if (tid == 0) { __builtin_amdgcn_fence(__ATOMIC_RELEASE, "agent"); asm volatile("s_waitcnt vmcnt(0)" ::: "memory"); __hip_atomic_fetch_add(pubcnt, 1u, __ATOMIC_RELAXED, __HIP_MEMORY_SCOPE_AGENT); }
    { const LAS float* gs = (const LAS float*)(lds + R4_G); const LAS float* bs = (const LAS float*)(lds + R4_B); unsigned char* x8 = A.ws + A_X8;
      for (int tk0 = 0; tk0 < 16; tk0 += 8) {
          u32x4 uu[8][2];
#pragma unroll
          for (int q = 0; q < 8; ++q)
#pragma unroll
              for (int i = 0; i < 2; ++i) uu[q][i] = *(const u32x4*)(v + (size_t)(tok0 + tk0 + q) * 1024 + (lane + 64 * i) * 8);
#pragma unroll
          for (int q = 0; q < 8; ++q) { const int tk = tk0 + q; const float mean = stat[2 * tk], rstd = stat[2 * tk + 1];
#pragma unroll
              for (int i = 0; i < 2; ++i) { const int k0 = (lane + 64 * i) * 8; const u32x4 u = uu[q][i];
                  const f32x4 ga = *(const LAS f32x4*)(gs + k0), gb = *(const LAS f32x4*)(gs + k0 + 4), ba = *(const LAS f32x4*)(bs + k0), bb = *(const LAS f32x4*)(bs + k0 + 4);
                  const float y0 = (bflo(u.x) - mean) * rstd * ga[0] + ba[0], y1 = (bfhi(u.x) - mean) * rstd * ga[1] + ba[1], y2 = (bflo(u.y) - mean) * rstd * ga[2] + ba[2], y3 = (bfhi(u.y) - mean) * rstd * ga[3] + ba[3];
                  const float y4 = (bflo(u.z) - mean) * rstd * gb[0] + bb[0], y5 = (bfhi(u.z) - mean) * rstd * gb[1] + bb[1], y6 = (bflo(u.w) - mean) * rstd * gb[2] + bb[2], y7 = (bfhi(u.w) - mean) * rstd * gb[3] + bb[3];
                  u32x4 o; o.x = pk2(y0, y1); o.y = pk2(y2, y3); o.z = pk2(y4, y5); o.w = pk2(y6, y7);
                  if (!MOE_FP8) *(u32x4*)(x1 + (size_t)(tok0 + tk) * 1024 + k0) = o;
                  if (MOE_FP8) { u32x2 qv; qv.x = pg8::pk4_fp8(8.f * y0, 8.f * y1, 8.f * y2, 8.f * y3); qv.y = pg8::pk4_fp8(8.f * y4, 8.f * y5, 8.f * y6, 8.f * y7); *(u32x2*)(x8 + (size_t)(tok0 + tk) * 1024 + k0) = qv; } } } } }
    if (tid == 0) { unsigned sp = 0; while (__hip_atomic_load(pubcnt, __ATOMIC_RELAXED, __HIP_MEMORY_SCOPE_AGENT) < (unsigned)gridDim.x) { __builtin_amdgcn_s_sleep(2); if (++sp > (1u << 22)) break; }
        __builtin_amdgcn_fence(__ATOMIC_ACQUIRE, "agent"); asm volatile("s_waitcnt vmcnt(0)" ::: "memory"); }
    __syncthreads();
    LAS int* base = (LAS int*)lds;
    const int* wgc = (const int*)(A.ws + WS_WGCNT);
    LAS int* part_tot = base + 128; LAS int* part_bef = part_tot + 512;
    { const int e = tid & 31, part = tid >> 5; int tot = 0, before = 0;
#pragma unroll
      for (int i = 0; i < 16; ++i) { const int w = part * 16 + i; const int c = __hip_atomic_load(wgc + w * 32 + e, __ATOMIC_RELAXED, __HIP_MEMORY_SCOPE_AGENT); tot += c; before += (w < blk) ? c : 0; }
      part_tot[part * 32 + e] = tot; part_bef[part * 32 + e] = before; }
    __syncthreads();
    if (tid < 32) {
        int tot = 0, before = 0;
#pragma unroll
        for (int p = 0; p < 16; ++p) { tot += part_tot[p * 32 + tid]; before += part_bef[p * 32 + tid]; }
        const int padded = (tot + 255) & ~255;
        int inc = padded;
#pragma unroll
        for (int o = 1; o < 32; o <<= 1) { const int t = __builtin_amdgcn_ds_bpermute((lane >= o ? lane - o : lane) << 2, inc); if (lane >= o) inc += t; }
        const int start = inc - padded;
        base[tid] = start + before;
        if (blk == 0) { int* be = (int*)(A.ws + WS_BLKEXP); for (int k = 0; k < (padded >> 8); ++k) be[(start >> 8) + k] = tid; be[NBLK_MAX + 1 + tid] = start >> 8; if (tid == 31) { be[NBLK_MAX] = inc >> 8; be[NBLK_MAX + 33] = inc >> 8; } }
    }
    __syncthreads();
    if (tid < 256) { const LAS int* ae = (const LAS int*)(lds + R4_ASG); const LAS float* ag = (const LAS float*)(lds + R4_ASG + 1024); const LAS int* ar = (const LAS int*)(lds + R4_ASG + 2048);
        const int a = blk * 256 + tid; const int slot = base[ae[tid]] + ar[tid]; ((int*)(A.ws + WS_SLOTOF))[a] = slot; ((float*)(A.ws + WS_SLOTGATE))[slot] = ag[tid]; ((int*)(A.ws + WS_SLOTTOK))[slot] = blk * 128 + (tid >> 1); }
    __syncthreads();
}

#ifndef P8_NT
#define P8_NT 4
#endif
__device__ __forceinline__ void p8_ln2(const Args& A, int l, bool last, int gw, int ngw, int lane) {
    const bf16* x1 = (const bf16*)(A.ws + A_X1); const bf16* Y = (const bf16*)(A.ws + A_Y); const int* so = (const int*)(A.ws + WS_SLOTOF);
    bf16* xb = (bf16*)(A.ws + A_XB);
    const float* g2 = A.in[I_LN2G] + l * 1024; const float* b2 = A.in[I_LN2B] + l * 1024;
    f32x4 gv[4], bv[4];
#pragma unroll
    for (int i = 0; i < 2; ++i) { const int k0 = (lane + 64 * i) * 8; gv[2 * i] = *(const f32x4*)(g2 + k0); gv[2 * i + 1] = *(const f32x4*)(g2 + k0 + 4); bv[2 * i] = *(const f32x4*)(b2 + k0); bv[2 * i + 1] = *(const f32x4*)(b2 + k0 + 4); }
    const bf16* v = (const bf16*)(A.ws + A_V); const f32x2* lnst = (const f32x2*)(A.ws + WS_LNSTAT);
    f32x4 g1v[4], b1v[4];
#pragma unroll
    for (int i = 0; i < 2; ++i) { const int k0 = (lane + 64 * i) * 8; const float* g1 = A.in[I_LN1G] + l * 1024; const float* b1 = A.in[I_LN1B] + l * 1024;
        g1v[2 * i] = *(const f32x4*)(g1 + k0) * ALPHA; g1v[2 * i + 1] = *(const f32x4*)(g1 + k0 + 4) * ALPHA; b1v[2 * i] = *(const f32x4*)(b1 + k0) * ALPHA; b1v[2 * i + 1] = *(const f32x4*)(b1 + k0 + 4) * ALPHA; }
    static_assert(MOE_FP8, "p8_ln2 reads the fp8 expert outputs"); (void)x1;
    constexpr int NT = P8_NT;
    for (int tb = gw; tb < T; tb += NT * ngw) {
        int s0[NT], s1[NT]; f32x2 mr[NT]; u32x4 av[NT][2]; u32x2 ya[NT][2], yc[NT][2];
#pragma unroll
        for (int n = 0; n < NT; ++n) { const int t = min(tb + n * ngw, T - 1); s0[n] = so[2 * t]; s1[n] = so[2 * t + 1]; mr[n] = lnst[t];
#pragma unroll
            for (int i = 0; i < 2; ++i) av[n][i] = *(const u32x4*)(v + (size_t)t * 1024 + (lane + 64 * i) * 8); }
#pragma unroll
        for (int n = 0; n < NT; ++n)
#pragma unroll
            for (int i = 0; i < 2; ++i) { const int k0 = (lane + 64 * i) * 8; const unsigned char* Y8 = (const unsigned char*)Y; ya[n][i] = *(const u32x2*)(Y8 + (size_t)s0[n] * 1024 + k0); yc[n][i] = *(const u32x2*)(Y8 + (size_t)s1[n] * 1024 + k0); }
#pragma unroll
        for (int n = 0; n < NT; ++n) { const int t = tb + n * ngw; if (t < T) {
        float x[16]; float sum = 0.f;
#pragma unroll
        for (int i = 0; i < 2; ++i) { const u32x4 a = av[n][i]; const u32x2 y0 = ya[n][i], y1 = yc[n][i];
                typedef float f32x2_ __attribute__((ext_vector_type(2)));
                const f32x2_ a0 = __builtin_amdgcn_cvt_pk_f32_fp8(y0.x, false), a1 = __builtin_amdgcn_cvt_pk_f32_fp8(y0.x, true), a2 = __builtin_amdgcn_cvt_pk_f32_fp8(y0.y, false), a3 = __builtin_amdgcn_cvt_pk_f32_fp8(y0.y, true);
                const f32x2_ b0 = __builtin_amdgcn_cvt_pk_f32_fp8(y1.x, false), b1 = __builtin_amdgcn_cvt_pk_f32_fp8(y1.x, true), b2 = __builtin_amdgcn_cvt_pk_f32_fp8(y1.y, false), b3 = __builtin_amdgcn_cvt_pk_f32_fp8(y1.y, true);
                const float ys = 1.0f / 64.0f;
                const float mean = mr[n].x, rstd = mr[n].y; const f32x4 ga = g1v[2 * i], gb = g1v[2 * i + 1], ba = b1v[2 * i], bb = b1v[2 * i + 1];
                x[8 * i + 0] = ((bflo(a.x) - mean) * rstd * ga[0] + ba[0]) + (a0[0] + b0[0]) * ys; x[8 * i + 1] = ((bfhi(a.x) - mean) * rstd * ga[1] + ba[1]) + (a0[1] + b0[1]) * ys;
                x[8 * i + 2] = ((bflo(a.y) - mean) * rstd * ga[2] + ba[2]) + (a1[0] + b1[0]) * ys; x[8 * i + 3] = ((bfhi(a.y) - mean) * rstd * ga[3] + ba[3]) + (a1[1] + b1[1]) * ys;
                x[8 * i + 4] = ((bflo(a.z) - mean) * rstd * gb[0] + bb[0]) + (a2[0] + b2[0]) * ys; x[8 * i + 5] = ((bfhi(a.z) - mean) * rstd * gb[1] + bb[1]) + (a2[1] + b2[1]) * ys;
                x[8 * i + 6] = ((bflo(a.w) - mean) * rstd * gb[2] + bb[2]) + (a3[0] + b3[0]) * ys; x[8 * i + 7] = ((bfhi(a.w) - mean) * rstd * gb[3] + bb[3]) + (a3[1] + b3[1]) * ys; }
#pragma unroll
        for (int u = 0; u < 16; ++u) sum += x[u];
        const float mean = wave_sum(sum, lane) * (1.0f / 1024.0f); float sq = 0.f;
#pragma unroll
        for (int u = 0; u < 16; ++u) { x[u] -= mean; sq += x[u] * x[u]; }
        const float rstd = rsqrtf(wave_sum(sq, lane) * (1.0f / 1024.0f) + LN_EPS);
#pragma unroll
        for (int i = 0; i < 2; ++i) { const int k0 = (lane + 64 * i) * 8;
            float o[8];
#pragma unroll
            for (int u = 0; u < 4; ++u) { o[u] = x[8 * i + u] * rstd * gv[2 * i][u] + bv[2 * i][u]; o[4 + u] = x[8 * i + 4 + u] * rstd * gv[2 * i + 1][u] + bv[2 * i + 1][u]; }
            if (last) { float* op = A.out + (size_t)t * 1024 + k0; *(f32x4*)op = (f32x4){o[0], o[1], o[2], o[3]}; *(f32x4*)(op + 4) = (f32x4){o[4], o[5], o[6], o[7]}; }
            else { u32x4 w; w.x = pk2(o[0], o[1]); w.y = pk2(o[2], o[3]); w.z = pk2(o[4], o[5]); w.w = pk2(o[6], o[7]); *(u32x4*)(xb + (size_t)t * 1024 + k0) = w; } }
        } }
    }
}
constexpr int LDS_ST = LDS_BYTES - 64;
#ifndef USE_CG_SYNC
#define SYNC() xcd_barrier(xbar)
#else
#define SYNC() grid.sync()
#endif
#ifndef SKIP_MASK
#define SKIP_MASK 0
#endif
#define ON(k) (!((SKIP_MASK) & (1 << (k))))
#ifndef DUP_PHASE
#define DUP_PHASE -1
#endif
#ifndef DUP_SUB
#define DUP_SUB -1
#endif
#define REPS(k) for (int reps_ = 0; reps_ < ((DUP_SUB) == (k) ? 2 : 1); ++reps_)
#define REP(k) for (int rep_ = 0; rep_ < ((DUP_PHASE) == (k) ? 2 : 1); ++rep_)
__global__ void __launch_bounds__(NTHREADS, 2) fwd_kernel(Args A) {
    extern __shared__ __attribute__((aligned(16))) unsigned char lds_raw[];
    LAS unsigned char* lds = (LAS unsigned char*)lds_raw;
#ifdef USE_CG_SYNC
    cg::grid_group grid = cg::this_grid();
#endif
    const int G = gridDim.x, bx = blockIdx.x, vcu = (G % 8 == 0) ? (bx % 8) * (G / 8) + bx / 8 : bx;
    const int ngw = G * NWAVES;
#define WAVE_IDS() const int tid = opaque_tid(), lane = tid & 63, wave = __builtin_amdgcn_readfirstlane(tid >> 6), gw = bx * NWAVES + wave; (void)tid; (void)lane; (void)gw
    unsigned char* ws = A.ws;
    if (threadIdx.x < 16) ((LAS unsigned*)(lds + LDS_ST))[threadIdx.x] = 0u;
    __syncthreads();
    XcdBarrier xbar = xcd_barrier_post((unsigned*)(ws + WS_BAR), (volatile LAS unsigned*)(lds + LDS_ST));
    bf16* xb = (bf16*)(ws + A_XB); bf16* proj = (bf16*)(ws + A_PROJ); bf16* mix = (bf16*)(ws + A_MIX); bf16* vbuf = (bf16*)(ws + A_V);
    bf16* hb = (bf16*)(ws + A_H); bf16* yb = (bf16*)(ws + A_Y);

    REP(0) if (ON(10)) { WAVE_IDS(); convert_weights(A, 0, lds, gw, ngw, wave, lane, 0, CV_IT_IN, true);
      convert_x(A, bx * NTHREADS + tid, G * NTHREADS); }
    SYNC();

    static_assert(DEPTH == 2 && W_END - WS_W <= (size_t)T * D * 4, "layer 1's weights live in the output buffer");
    for (int l = 0; l < DEPTH; ++l) {
        REP(1) { pg8::Gemm g{xb, (const bf16*)(wbuf(A, l) + (W_WIN - WS_W)), T, PP, 1024}; pg8::StaticOrder S; S.init(T, PP, G, bx); pg8::EpiStore E{proj, PP};
          const int kx = (l == 0) ? ((bx >> 3) & 7) : 0;
          for (int part = 0; part < 2; ++part) {
              if (part == 0) { S.i0 = 0; S.ni = kx; } else { S.i0 = kx; S.ni = 1 << 30; }
              pg8::gemm_phase<pg8::EpiStore, pg8::StaticOrder, true, true>(lds, g, S, E);
              if (part == 0 && l == 0) { WAVE_IDS(); __syncthreads(); convert_weights(A, 0, lds, gw, ngw, wave, lane, CV_IT_IN, CV_NIT, false); convert_weights(A, 1, lds, gw, ngw, wave, lane, 0, CV_NIT, true); __syncthreads(); } } }
        SYNC();
        REP(2) { const float lam_init = (l == 0) ? 0.2f : 0.35550907f, lam = ((const float*)(ws + WS_LAM))[l];
          const bool attn_first = ((bx >> 3) & 1) != 0;
          for (int ps = 0; ps < 2; ++ps) {
          if ((ps == 1) == attn_first) {
          const int rot = (bx >> 4) % 3;
          for (int q = 0; q < 3; ++q) { const int kind = (q + rot) % 3;
          if (kind == 0) { REPS(0) if (ON(0)) for (int u = vcu; u < 256; u += G) ssd_a_unit(lds, A, l, proj, u >> 4, u & 15); }
          else if (kind == 1) { REPS(1) if (ON(1)) for (int u = vcu; u < 512; u += G) gla_a_unit(lds, A, l, proj, u >> 5, u & 31); }
          else { REPS(2) if (ON(2)) for (int u = vcu; u < 256; u += G) conv_unit(proj, mix, A.in[I_CONVW] + l * 768, u * 128); } }
          } else {
          REPS(3) if (ON(3)) { u32x4 qn[2] = {{0u, 0u, 0u, 0u}, {0u, 0u, 0u, 0u}}; bool first = true;
              for (int p = vcu; p < 512; p += G) { const int bh = p >> 3, s = p & 7; const bool more = p + G < 512; const int nbh = (p + G) >> 3, ns = (p + G) & 7;
                  attn_unit(lds, proj, mix, bh >> 2, bh & 3, 15 - s, lam, A.in[I_DIFF_NG] + l * 64, 1.0f - lam_init, first, bh >> 2, bh & 3, s, qn); first = false;
                  attn_unit(lds, proj, mix, bh >> 2, bh & 3, s, lam, A.in[I_DIFF_NG] + l * 64, 1.0f - lam_init, false, more ? nbh >> 2 : bh >> 2, more ? nbh & 3 : bh & 3, more ? 15 - ns : -1, qn); } }
          } } }
        SYNC();
        REP(11) if (ON(6)) { const int tid = opaque_tid(); scan_phase(A, bx * NTHREADS + tid, G * NTHREADS); }
        SYNC();
        REP(3) { const bool gla_first = ((bx >> 3) & 1) != 0;
          for (int ps = 0; ps < 2; ++ps) {
            if ((ps == 1) == gla_first) { REPS(4) if (ON(4)) for (int u = vcu; u < 512; u += G) ssd_main_unit(lds, A, l, proj, mix, u >> 5, (u >> 1) & 15, u & 1); }
            else { REPS(5) if (ON(5)) for (int u = vcu; u < 512; u += G) gla_main_unit(lds, A, l, proj, mix, u >> 5, u & 31); } } }
        SYNC();
        REP(4) { pg8::Gemm g{mix, (const bf16*)(wbuf(A, l) + (W_WO - WS_W)), T, 1024, 1024}; pg8::StaticOrder S; S.init(T, 1024, G, bx); pg8::EpiRes E{vbuf, xb, 1024, ALPHA};
          pg8::gemm_phase<pg8::EpiRes, pg8::StaticOrder, true, true>(lds, g, S, E); }
        SYNC();
        REP(5) if (ON(7)) for (int blk = bx; blk < 256; blk += G) p4_route(lds, A, l, blk);
        SYNC();
        const int nblk = ((const int*)(ws + WS_BLKEXP))[NBLK_MAX];
        REP(7) { if (MOE_FP8) { pg8::Gemm g{(const bf16*)(ws + A_X8), (const bf16*)(wbuf(A, l) + (W_WGU - WS_W)), NSLOT_MAX, NEXP * 1024, 512}; pg8::MoeOrder S; S.init((const int*)(ws + WS_BLKEXP), G, bx); S.ready = (unsigned*)(ws + WS_RDY) + (size_t)l * NBLK_MAX * 64; S.mode = 1; pg8::EpiSwiglu8 E{(unsigned char*)hb};
            pg8::gemm_phase_gather<pg8::EpiSwiglu8, pg8::MoeOrder, true>(lds, g, (const int*)(ws + WS_SLOTTOK), S, E); }
          else { pg8::Gemm g{(const bf16*)(ws + A_X1), (const bf16*)(wbuf(A, l) + (W_WGU - WS_W)), NSLOT_MAX, NEXP * 1024, 1024}; pg8::MoeOrder S; S.init((const int*)(ws + WS_BLKEXP), G, bx); pg8::EpiSwiglu E{hb};
            pg8::gemm_phase_gather<pg8::EpiSwiglu, pg8::MoeOrder, false>(lds, g, (const int*)(ws + WS_SLOTTOK), S, E); } }
        if (!MOE_FP8) SYNC();
        REP(8) { pg8::Gemm g{hb, (const bf16*)(wbuf(A, l) + (W_WD - WS_W)), NSLOT_MAX, NEXP * 1024, MOE_FP8 ? 256 : 512}; pg8::MoeOrder S; S.init((const int*)(ws + WS_BLKEXP), G, bx);
          if (MOE_FP8) { S.ready = (unsigned*)(ws + WS_RDY) + (size_t)l * NBLK_MAX * 64; S.mode = 2; pg8::EpiDown8 E{(unsigned char*)yb, (const float*)(ws + WS_SLOTGATE), 0.00390625f}; pg8::gemm_phase<pg8::EpiDown8, pg8::MoeOrder, true, true, true>(lds, g, S, E); }
          else { pg8::EpiDown E{yb, (const float*)(ws + WS_SLOTGATE), 1.0f}; pg8::gemm_phase<pg8::EpiDown, pg8::MoeOrder, true, true, false>(lds, g, S, E); } }
        SYNC();
        REP(9) if (ON(9)) { WAVE_IDS(); p8_ln2(A, l, l == DEPTH - 1, gw, ngw, lane); }
        if (l + 1 < DEPTH) SYNC();
    }
}

extern "C" void kernel_launch(void* const* d_in, const int* in_sizes, int n_in, void* d_out, int out_size, void* d_ws, size_t ws_size, hipStream_t stream) {
    static int grid = 0;
    if (grid == 0) {
        if (n_in != N_IN || in_sizes[0] != T * D || out_size != T * D || ws_size < WS_NEED) { fprintf(stderr, "kernel_launch: unexpected shapes (n_in %d, ws %zu < %zu)\n", n_in, ws_size, (size_t)WS_NEED); grid = -1; return; }
        int dev = 0, cus = 0, per_cu = 0;
        (void)hipGetDevice(&dev); (void)hipDeviceGetAttribute(&cus, hipDeviceAttributeMultiprocessorCount, dev);
        if (hipFuncSetAttribute((const void*)fwd_kernel, hipFuncAttributeMaxDynamicSharedMemorySize, LDS_BYTES) != hipSuccess) { fprintf(stderr, "kernel_launch: hipFuncSetAttribute failed\n"); }
        (void)hipOccupancyMaxActiveBlocksPerMultiprocessor(&per_cu, (const void*)fwd_kernel, NTHREADS, LDS_BYTES);
        (void)hipGetLastError();
        grid = (cus >= 256 && per_cu >= 1) ? 256 : -1;
        if (grid < 0) { fprintf(stderr, "kernel_launch: needs 256 CUs with one resident workgroup each (CUs %d, blocks per CU %d)\n", cus, per_cu); return; }
    }
    if (grid < 0) return;
    if (hipMemsetAsync((char*)d_ws + WS_BAR, 0, 16384 + (size_t)DEPTH * NBLK_MAX * 256, stream) != hipSuccess) { fprintf(stderr, "kernel_launch: memset failed\n"); return; }
    Args a{};
    for (int i = 0; i < N_IN; ++i) a.in[i] = (const float*)d_in[i];
    a.out = (float*)d_out; a.ws = (unsigned char*)d_ws;
    void* args[] = {&a};
    const hipError_t e = hipLaunchCooperativeKernel((const void*)fwd_kernel, dim3(grid), dim3(NTHREADS), args, LDS_BYTES, stream);
    if (e != hipSuccess) fprintf(stderr, "kernel_launch: cooperative launch failed: %s (grid %d)\n", hipGetErrorString(e), grid);
}
```

```cpp
#include <hip/hip_runtime.h>
#include <hip/hip_cooperative_groups.h>
#include <cstdio>
#include <cstdint>
namespace cg = cooperative_groups;
namespace pg8 {
#define PG8_LAS __attribute__((address_space(3)))
typedef unsigned short bf16_t;
typedef short bf16x8 __attribute__((ext_vector_type(8)));
typedef float f32x4 __attribute__((ext_vector_type(4)));
typedef unsigned u32x4 __attribute__((ext_vector_type(4)));
constexpr int BM = 256, BK = 64, HALF = 128, HTB = HALF * BK * 2  , STAGE_BYTES = 8 * HTB, NXCD = 8, WGM = 8;

__host__ __device__ __forceinline__ int lds_byte(int r, int c) { const int st = (r >> 4) * 2 + (c >> 5), rr = r & 15, cc = c & 31, ob = rr * 64 + cc * 2; return st * 1024 + (ob ^ (((ob >> 9) & 1) << 5)); }
__host__ __device__ __forceinline__ void stage_rc(int b, int& R, int& C) { const int st = b / 1024, sb = b % 1024, swz = sb ^ (((sb >> 9) & 1) << 5); R = (st >> 1) * 16 + swz / 64; C = (st & 1) * 32 + (swz % 64) / 2; }
__host__ __device__ __forceinline__ int perm32(int rho) { const int n = rho >> 4, i = rho & 15; return 8 * (i >> 2) + 4 * n + (i & 3); }

struct Unit { int pm, pn; };
struct Gemm { const bf16_t* A; const bf16_t* Bt; int M, N, K; };
__device__ __forceinline__ unsigned cvt_pk_bf16(float lo, float hi) { unsigned r; asm volatile("v_cvt_pk_bf16_f32 %0, %1, %2" : "=v"(r) : "v"(lo), "v"(hi)); return r; }
struct StaticOrder {
    int nM, nN, nwg, G, c; int i0 = 0, ni = 1 << 30;
    __host__ __device__ void init(int M, int N, int G_, int c_) { nM = M / BM; nN = N / BM; nwg = nM * nN; G = G_; c = c_; }
    __host__ __device__ bool next(int i, Unit& u) const {
        const long L = (long)(i + i0) * G + c; if (i >= ni || L >= nwg) return false;
        int wgid = (int)L; { const int q = nwg / NXCD, r = nwg % NXCD, xcd = wgid % NXCD, off = wgid / NXCD; wgid = (xcd < r ? xcd * (q + 1) : r * (q + 1) + (xcd - r) * q) + off; }
        const int nig = WGM * nN, gid = wgid / nig, fm = gid * WGM, gsz = (nM - fm) < WGM ? (nM - fm) : WGM;
        u.pm = fm + ((wgid % nig) % gsz); u.pn = (wgid % nig) / gsz; return true;
    }
    __device__ __forceinline__ void a_ready(const Unit&) const {}
    __device__ __forceinline__ void done(const Unit&) const {}
};
typedef unsigned u32x2 __attribute__((ext_vector_type(2)));
__device__ __forceinline__ float bf_lo(unsigned w) { return __uint_as_float(w << 16); }
__device__ __forceinline__ float bf_hi(unsigned w) { return __uint_as_float(w & 0xffff0000u); }
__device__ __forceinline__ float silu_f(float x) { return x * __builtin_amdgcn_rcpf(1.0f + __builtin_amdgcn_exp2f(-1.4426950408889634f * x)); }

struct EpiStore {
    static constexpr bool PERM = true, AFTER_DRAIN = false;
    bf16_t* O; int ldc;
    __device__ __forceinline__ void operator()(const f32x4 (&acc)[2][2][4][2], const Unit& u, int wr, int wc, int fr, int fq) const {
        const int row0 = u.pm * BM + wr * 64 + fr, col0 = u.pn * BM + wc * 32 + 8 * fq;
#pragma unroll
        for (int ai = 0; ai < 2; ++ai)
#pragma unroll
            for (int m = 0; m < 4; ++m) { bf16_t* rowp = O + (size_t)(row0 + ai * HALF + m * 16) * ldc + col0;
#pragma unroll
                for (int bj = 0; bj < 2; ++bj) { const f32x4 v0 = acc[ai][bj][m][0], v1 = acc[ai][bj][m][1];
                    u32x4 w; w.x = cvt_pk_bf16(v0[0], v0[1]); w.y = cvt_pk_bf16(v0[2], v0[3]); w.z = cvt_pk_bf16(v1[0], v1[1]); w.w = cvt_pk_bf16(v1[2], v1[3]);
                    *(u32x4*)(rowp + bj * HALF) = w; } }
    }
};
struct EpiRes {
    static constexpr bool PERM = true, AFTER_DRAIN = false;
    bf16_t* O; const bf16_t* R; int ldc; float alpha;
    __device__ __forceinline__ void operator()(const f32x4 (&acc)[2][2][4][2], const Unit& u, int wr, int wc, int fr, int fq) const {
        const int row0 = u.pm * BM + wr * 64 + fr, col0 = u.pn * BM + wc * 32 + 8 * fq;
        u32x4 rr[2][4][2];
#pragma unroll
        for (int ai = 0; ai < 2; ++ai)
#pragma unroll
            for (int m = 0; m < 4; ++m)
#pragma unroll
                for (int bj = 0; bj < 2; ++bj) rr[ai][m][bj] = *(const u32x4*)(R + (size_t)(row0 + ai * HALF + m * 16) * ldc + col0 + bj * HALF);
#pragma unroll
        for (int ai = 0; ai < 2; ++ai)
#pragma unroll
            for (int m = 0; m < 4; ++m) { const size_t off = (size_t)(row0 + ai * HALF + m * 16) * ldc + col0;
#pragma unroll
                for (int bj = 0; bj < 2; ++bj) { const f32x4 v0 = acc[ai][bj][m][0], v1 = acc[ai][bj][m][1];
                    const u32x4 r = rr[ai][m][bj];
                    u32x4 w; w.x = cvt_pk_bf16(alpha * bf_lo(r.x) + v0[0], alpha * bf_hi(r.x) + v0[1]); w.y = cvt_pk_bf16(alpha * bf_lo(r.y) + v0[2], alpha * bf_hi(r.y) + v0[3]);
                    w.z = cvt_pk_bf16(alpha * bf_lo(r.z) + v1[0], alpha * bf_hi(r.z) + v1[1]); w.w = cvt_pk_bf16(alpha * bf_lo(r.w) + v1[2], alpha * bf_hi(r.w) + v1[3]);
                    *(u32x4*)(O + off + bj * HALF) = w; } }
    }
};
__device__ __forceinline__ float clamp448(float x) { return __builtin_fminf(__builtin_fmaxf(x, -448.f), 448.f); }
__device__ __forceinline__ unsigned pk4_fp8(float a, float b, float c, float d) { unsigned w = 0; w = __builtin_amdgcn_cvt_pk_fp8_f32(clamp448(a), clamp448(b), w, false); w = __builtin_amdgcn_cvt_pk_fp8_f32(clamp448(c), clamp448(d), w, true); return w; }
struct EpiSwiglu8 {
    static constexpr bool PERM = true, AFTER_DRAIN = false;
    unsigned char* H;
    __device__ __forceinline__ void operator()(const f32x4 (&acc)[2][2][4][2], const Unit& u, int wr, int wc, int fr, int fq) const {
        const int row0 = u.pm * BM + wr * 64 + fr, col0 = (u.pn & 3) * HALF + wc * 32 + 8 * fq; const float si = 0.001953125f, so = 4.0f * 0.001953125f;
#pragma unroll
        for (int ai = 0; ai < 2; ++ai)
#pragma unroll
            for (int m = 0; m < 4; ++m) { unsigned char* rowp = H + (size_t)(row0 + ai * HALF + m * 16) * 512 + col0;
                const f32x4 g0 = acc[ai][0][m][0] * si, g1 = acc[ai][0][m][1] * si, u0 = acc[ai][1][m][0] * so, u1 = acc[ai][1][m][1] * so;
                u32x2 w; w.x = pk4_fp8(silu_f(g0[0]) * u0[0], silu_f(g0[1]) * u0[1], silu_f(g0[2]) * u0[2], silu_f(g0[3]) * u0[3]);
                w.y = pk4_fp8(silu_f(g1[0]) * u1[0], silu_f(g1[1]) * u1[1], silu_f(g1[2]) * u1[2], silu_f(g1[3]) * u1[3]);
                __hip_atomic_store((unsigned long long*)rowp, (unsigned long long)w.x | ((unsigned long long)w.y << 32), __ATOMIC_RELAXED, __HIP_MEMORY_SCOPE_AGENT); }
    }
};
struct EpiSwiglu {
    static constexpr bool PERM = true, AFTER_DRAIN = false;
    bf16_t* H;
    __device__ __forceinline__ void operator()(const f32x4 (&acc)[2][2][4][2], const Unit& u, int wr, int wc, int fr, int fq) const {
        const int row0 = u.pm * BM + wr * 64 + fr, col0 = (u.pn & 3) * HALF + wc * 32 + 8 * fq;
#pragma unroll
        for (int ai = 0; ai < 2; ++ai)
#pragma unroll
            for (int m = 0; m < 4; ++m) { bf16_t* rowp = H + (size_t)(row0 + ai * HALF + m * 16) * 512 + col0;
                const f32x4 g0 = acc[ai][0][m][0], g1 = acc[ai][0][m][1], u0 = acc[ai][1][m][0], u1 = acc[ai][1][m][1];
                u32x4 w; w.x = cvt_pk_bf16(silu_f(g0[0]) * u0[0], silu_f(g0[1]) * u0[1]); w.y = cvt_pk_bf16(silu_f(g0[2]) * u0[2], silu_f(g0[3]) * u0[3]);
                w.z = cvt_pk_bf16(silu_f(g1[0]) * u1[0], silu_f(g1[1]) * u1[1]); w.w = cvt_pk_bf16(silu_f(g1[2]) * u1[2], silu_f(g1[3]) * u1[3]);
                *(u32x4*)rowp = w; }
    }
};
struct EpiDown {
    static constexpr bool PERM = true, AFTER_DRAIN = false;
    bf16_t* Y; const float* gate; float oscale;
    __device__ __forceinline__ void operator()(const f32x4 (&acc)[2][2][4][2], const Unit& u, int wr, int wc, int fr, int fq) const {
        const int row0 = u.pm * BM + wr * 64 + fr, col0 = (u.pn & 3) * BM + wc * 32 + 8 * fq;
#pragma unroll
        for (int ai = 0; ai < 2; ++ai)
#pragma unroll
            for (int m = 0; m < 4; ++m) { const int row = row0 + ai * HALF + m * 16; const float gt = gate[row] * oscale; bf16_t* rowp = Y + (size_t)row * 1024 + col0;
#pragma unroll
                for (int bj = 0; bj < 2; ++bj) { const f32x4 v0 = acc[ai][bj][m][0] * gt, v1 = acc[ai][bj][m][1] * gt;
                    u32x4 w; w.x = cvt_pk_bf16(v0[0], v0[1]); w.y = cvt_pk_bf16(v0[2], v0[3]); w.z = cvt_pk_bf16(v1[0], v1[1]); w.w = cvt_pk_bf16(v1[2], v1[3]);
                    *(u32x4*)(rowp + bj * HALF) = w; } }
    }
};
struct EpiDown8 {
    static constexpr bool PERM = true, AFTER_DRAIN = false;
    unsigned char* Y; const float* gate; float oscale;
    __device__ __forceinline__ void operator()(const f32x4 (&acc)[2][2][4][2], const Unit& u, int wr, int wc, int fr, int fq) const {
        const int row0 = u.pm * BM + wr * 64 + fr, col0 = (u.pn & 3) * BM + wc * 32 + 8 * fq;
        float gts[2][4];
#pragma unroll
        for (int ai = 0; ai < 2; ++ai)
#pragma unroll
            for (int m = 0; m < 4; ++m) gts[ai][m] = gate[row0 + ai * HALF + m * 16];
#pragma unroll
        for (int ai = 0; ai < 2; ++ai)
#pragma unroll
            for (int m = 0; m < 4; ++m) { const int row = row0 + ai * HALF + m * 16; const float gt = gts[ai][m] * oscale * 64.0f; unsigned char* rowp = Y + (size_t)row * 1024 + col0;
#pragma unroll
                for (int bj = 0; bj < 2; ++bj) { const f32x4 v0 = acc[ai][bj][m][0] * gt, v1 = acc[ai][bj][m][1] * gt;
                    u32x2 w; w.x = pk4_fp8(v0[0], v0[1], v0[2], v0[3]); w.y = pk4_fp8(v1[0], v1[1], v1[2], v1[3]);
                    *(u32x2*)(rowp + bj * HALF) = w; } }
    }
};
struct MoeOrder {
    const int* blk_expert; int b0, nu, j, nj;
    __device__ __forceinline__ void init(const int* be, int G, int c) {
        blk_expert = be; const int x = c & 7; nj = G >> 3; j = c >> 3;
        if ((G & 7) == 0) { b0 = be[289 + 4 * x]; nu = 4 * (be[289 + 4 * x + 4] - b0); }
        else { b0 = 0; nu = 4 * be[288]; nj = G; j = c; }
    }
    __device__ __forceinline__ bool next(int i, Unit& u) const {
        const int L = i * nj + j; if (L >= nu) return false;
        const int blk = b0 + (L >> 2); u.pm = blk; u.pn = blk_expert[blk] * 4 + (L & 3); return true;
    }
    unsigned* ready = nullptr; int mode = 0;
    __device__ __forceinline__ void a_ready(const Unit& u) const {
        if (mode == 2) {
            if (threadIdx.x < 64) { unsigned sp = 0;
                while ((unsigned)__builtin_amdgcn_readfirstlane((int)__hip_atomic_load(ready + 64 * u.pm, __ATOMIC_RELAXED, __HIP_MEMORY_SCOPE_AGENT)) < 32u) { __builtin_amdgcn_s_sleep(2); if (++sp > (1u << 22)) break; }
                __builtin_amdgcn_fence(__ATOMIC_ACQUIRE, "agent"); asm volatile("s_waitcnt vmcnt(0)" ::: "memory"); }
            asm volatile("" ::: "memory"); __builtin_amdgcn_s_barrier(); asm volatile("" ::: "memory");
        }
    }
    __device__ __forceinline__ void done(const Unit& u) const {
        if (mode == 1) { asm volatile("s_waitcnt vmcnt(0)" ::: "memory"); if ((threadIdx.x & 63) == 0) __hip_atomic_fetch_add(ready + 64 * u.pm, 1u, __ATOMIC_RELAXED, __HIP_MEMORY_SCOPE_AGENT); }
    }
};
typedef int i32x8 __attribute__((ext_vector_type(8)));
__device__ __forceinline__ i32x8 cat16(bf16x8 a, bf16x8 b) { const u32x4 x = __builtin_bit_cast(u32x4, a), y = __builtin_bit_cast(u32x4, b); return (i32x8){(int)x.x, (int)x.y, (int)x.z, (int)x.w, (int)y.x, (int)y.y, (int)y.z, (int)y.w}; }
template <class Epi, class Sched, bool ALIGN_EPI = false, bool SP2 = false, bool FP8 = false>
__device__ __forceinline__ void gemm_phase(PG8_LAS unsigned char* lds, const Gemm g, const Sched& S, const Epi& E) {
    int tid_o_ = threadIdx.x; asm volatile("" : "+v"(tid_o_)); const int tid = tid_o_, wid = __builtin_amdgcn_readfirstlane(tid >> 6), lane = tid & 63, wr = wid >> 2, wc = wid & 3, fr = lane & 15, fq = lane >> 4;
    const int K = g.K, nt = K / BK;
    unsigned voffA[2], voffB[2];
#pragma unroll
    for (int i = 0; i < 2; ++i) { int R, C; stage_rc(tid * 16 + i * 8192, R, C); const int Rb = Epi::PERM ? ((R & ~31) + perm32(R & 31)) : R;
        voffA[i] = (unsigned)(R * K + C) * 2u; voffB[i] = (unsigned)(Rb * K + C) * 2u; }
    const size_t kstep = (size_t)(BK * 2);
    const size_t hstep = (size_t)HALF * K * 2;
    const size_t tstep = 2 * hstep;
    const unsigned ldsw = (unsigned)wid * 1024u;
    const int aoff = lds_byte(wr * 64 + fr, fq * 8), boff = lds_byte(wc * 32 + fr, fq * 8);
#define PG8_SA(b, h) (((b) * 2 + (h)) * HTB)
#define PG8_SB(b, h) ((4 + (b) * 2 + (h)) * HTB)
#define PG8_STAGE(bufoff, gbase, voff) do { _Pragma("unroll") for (int _i = 0; _i < 2; ++_i) \
        __builtin_amdgcn_global_load_lds((const unsigned*)((const char*)(gbase) + (voff)[_i]), (PG8_LAS unsigned*)(lds + (bufoff) + ldsw + _i * 8192), 16, 0, 0); } while (0)
#define PG8_LDA(dst, b, h) do { if constexpr (FP8) { _Pragma("unroll") for (int m = 0; m < 4; ++m) dst##_8[m] = cat16(*(const PG8_LAS bf16x8*)(lds + PG8_SA(b, h) + aoff + m * 2048), *(const PG8_LAS bf16x8*)(lds + PG8_SA(b, h) + aoff + m * 2048 + 1024)); } \
        else { _Pragma("unroll") for (int m = 0; m < 4; ++m) _Pragma("unroll") for (int k = 0; k < 2; ++k) dst[m][k] = *(const PG8_LAS bf16x8*)(lds + PG8_SA(b, h) + aoff + m * 2048 + k * 1024); } } while (0)
#define PG8_LDB(dst, b, h) do { if constexpr (FP8) { _Pragma("unroll") for (int n = 0; n < 2; ++n) dst##_8[n] = cat16(*(const PG8_LAS bf16x8*)(lds + PG8_SB(b, h) + boff + n * 2048), *(const PG8_LAS bf16x8*)(lds + PG8_SB(b, h) + boff + n * 2048 + 1024)); } \
        else { _Pragma("unroll") for (int n = 0; n < 2; ++n) _Pragma("unroll") for (int k = 0; k < 2; ++k) dst[n][k] = *(const PG8_LAS bf16x8*)(lds + PG8_SB(b, h) + boff + n * 2048 + k * 1024); } } while (0)
#define PG8_MMA(ai, bj, At, Bt) do { __builtin_amdgcn_s_setprio(1); \
        if constexpr (FP8) { _Pragma("unroll") for (int m = 0; m < 4; ++m) _Pragma("unroll") for (int n = 0; n < 2; ++n) \
            asm volatile("s_nop 1\n\tv_mfma_scale_f32_16x16x128_f8f6f4 %0, %1, %2, %0, %3, %3 op_sel_hi:[0,0,0]" : "+v"(acc[ai][bj][m][n]) : "v"(Bt##_8[n]), "v"(At##_8[m]), "v"(sc1_)); } \
        else { _Pragma("unroll") for (int m = 0; m < 4; ++m) _Pragma("unroll") for (int n = 0; n < 2; ++n) _Pragma("unroll") for (int k = 0; k < 2; ++k) \
            acc[ai][bj][m][n] = __builtin_amdgcn_mfma_f32_16x16x32_bf16(Bt[n][k], At[m][k], acc[ai][bj][m][n], 0, 0, 0); } \
        __builtin_amdgcn_s_setprio(0); } while (0)
#define PG8_WAIT_V(n) asm volatile("s_waitcnt vmcnt(" #n ")" ::: "memory")
#define PG8_WAIT_L(n) asm volatile("s_waitcnt lgkmcnt(" #n ")" ::: "memory")
#define PG8_BAR __builtin_amdgcn_s_barrier()
#define PG8_SCHED __builtin_amdgcn_sched_barrier(0)
    Unit cur, nxt; int ui = 0;
    if (!S.next(0, cur)) return;
    f32x4 acc[2][2][4][2];
#pragma unroll
    for (int a = 0; a < 2; ++a)
#pragma unroll
        for (int b = 0; b < 2; ++b)
#pragma unroll
            for (int m = 0; m < 4; ++m)
#pragma unroll
                for (int n = 0; n < 2; ++n) acc[a][b][m][n] = (f32x4){0.f, 0.f, 0.f, 0.f};
    bf16x8 At[4][2], B0[2][2], B1[2][2]; i32x8 At_8[4], B0_8[2], B1_8[2]; int sc1_ = 0x7f7f7f7f; asm volatile("" : "+v"(sc1_));
    const char* cA = (const char*)g.A + (size_t)cur.pm * tstep; const char* cB = (const char*)g.Bt + (size_t)cur.pn * tstep;
    S.a_ready(cur);
    if constexpr (SP2) {
        PG8_STAGE(PG8_SB(0, 0), cB, voffB); PG8_STAGE(PG8_SB(0, 1), cB + hstep, voffB); PG8_STAGE(PG8_SA(0, 0), cA, voffA); PG8_STAGE(PG8_SA(0, 1), cA + hstep, voffA);
        if (wr == 1) PG8_BAR;
        PG8_WAIT_V(2); PG8_BAR;
        PG8_STAGE(PG8_SB(1, 0), cB + kstep, voffB); PG8_STAGE(PG8_SA(1, 0), cA + kstep, voffA); PG8_STAGE(PG8_SB(1, 1), cB + hstep + kstep, voffB);
        PG8_WAIT_V(6); PG8_BAR;
    } else {
        PG8_STAGE(PG8_SB(0, 0), cB, voffB); PG8_STAGE(PG8_SA(0, 0), cA, voffA); PG8_STAGE(PG8_SB(0, 1), cB + hstep, voffB); PG8_STAGE(PG8_SA(0, 1), cA + hstep, voffA);
        if (wr == 1) PG8_BAR;
        PG8_WAIT_V(4); PG8_BAR;
        PG8_STAGE(PG8_SB(1, 0), cB + kstep, voffB); PG8_STAGE(PG8_SA(1, 0), cA + kstep, voffA); PG8_STAGE(PG8_SB(1, 1), cB + hstep + kstep, voffB);
        PG8_WAIT_V(6); PG8_BAR;
    }
    for (;;) {
        const bool has_next = S.next(ui + 1, nxt);
        const char* nA = has_next ? (const char*)g.A + (size_t)nxt.pm * tstep : cA; const char* nB = has_next ? (const char*)g.Bt + (size_t)nxt.pn * tstep : cB;
        for (int t = 0; t < nt; t += 2) {
            const bool last = (t == nt - 2);
            const char* a1 = cA + (size_t)(t + 1) * kstep;
            const char* a2 = last ? nA : cA + (size_t)(t + 2) * kstep; const char* b2 = last ? nB : cB + (size_t)(t + 2) * kstep;
            const char* a3 = a2 + kstep; const char* b3 = b2 + kstep;
            if (last && has_next) S.a_ready(nxt);
            if constexpr (SP2) {
            PG8_LDB(B0, 0, 0); PG8_LDB(B1, 0, 1); PG8_SCHED; PG8_LDA(At, 0, 0); PG8_STAGE(PG8_SA(1, 1), a1 + hstep, voffA);
            PG8_WAIT_V(8); PG8_WAIT_L(0); PG8_BAR; PG8_MMA(0, 0, At, B0); PG8_MMA(0, 1, At, B1); PG8_BAR; PG8_SCHED;
            PG8_LDA(At, 0, 1); PG8_STAGE(PG8_SB(0, 0), b2, voffB); PG8_STAGE(PG8_SB(0, 1), b2 + hstep, voffB); PG8_STAGE(PG8_SA(0, 0), a2, voffA);
            PG8_WAIT_V(8); PG8_WAIT_L(0); PG8_BAR; PG8_MMA(1, 0, At, B0); PG8_MMA(1, 1, At, B1); PG8_BAR; PG8_SCHED;
            PG8_LDB(B0, 1, 0); PG8_LDB(B1, 1, 1); PG8_SCHED; PG8_LDA(At, 1, 0); PG8_STAGE(PG8_SA(0, 1), a2 + hstep, voffA);
            PG8_WAIT_V(8); PG8_WAIT_L(0); PG8_BAR; PG8_MMA(0, 0, At, B0); PG8_MMA(0, 1, At, B1); PG8_BAR; PG8_SCHED;
            PG8_LDA(At, 1, 1); PG8_STAGE(PG8_SB(1, 0), b3, voffB); PG8_STAGE(PG8_SB(1, 1), b3 + hstep, voffB); PG8_STAGE(PG8_SA(1, 0), a3, voffA);
            PG8_WAIT_V(8); PG8_WAIT_L(0); PG8_BAR; PG8_MMA(1, 0, At, B0); PG8_MMA(1, 1, At, B1); PG8_BAR; PG8_SCHED;
            } else {
            PG8_LDB(B0, 0, 0); PG8_SCHED; PG8_LDA(At, 0, 0); PG8_STAGE(PG8_SA(1, 1), a1 + hstep, voffA);
            PG8_WAIT_L(8); PG8_BAR; PG8_WAIT_L(0); PG8_MMA(0, 0, At, B0); PG8_BAR; PG8_SCHED;
            PG8_LDB(B1, 0, 1); PG8_STAGE(PG8_SB(0, 0), b2, voffB);
            PG8_BAR; PG8_WAIT_L(0); PG8_MMA(0, 1, At, B1); PG8_BAR;
            PG8_LDA(At, 0, 1); PG8_STAGE(PG8_SA(0, 0), a2, voffA);
            PG8_BAR; PG8_WAIT_L(0); PG8_MMA(1, 0, At, B0); PG8_BAR; PG8_SCHED;
            PG8_STAGE(PG8_SB(0, 1), b2 + hstep, voffB);
            PG8_WAIT_V(6); PG8_BAR; PG8_MMA(1, 1, At, B1); PG8_BAR;
            PG8_LDB(B0, 1, 0); PG8_SCHED; PG8_LDA(At, 1, 0); PG8_STAGE(PG8_SA(0, 1), a2 + hstep, voffA);
            PG8_WAIT_L(8); PG8_BAR; PG8_WAIT_L(0); PG8_MMA(0, 0, At, B0); PG8_BAR; PG8_SCHED;
            PG8_LDB(B1, 1, 1); PG8_STAGE(PG8_SB(1, 0), b3, voffB);
            PG8_BAR; PG8_WAIT_L(0); PG8_MMA(0, 1, At, B1); PG8_BAR;
            PG8_LDA(At, 1, 1); PG8_STAGE(PG8_SA(1, 0), a3, voffA);
            PG8_BAR; PG8_WAIT_L(0); PG8_MMA(1, 0, At, B0); PG8_BAR; PG8_SCHED;
            PG8_STAGE(PG8_SB(1, 1), b3 + hstep, voffB);
            PG8_WAIT_V(6); PG8_BAR; PG8_MMA(1, 1, At, B1); PG8_BAR;
            }
        }
        if constexpr (FP8) asm volatile("s_nop 15\n\ts_nop 15" ::: "memory");
        if constexpr (ALIGN_EPI) { if (wr == 0) PG8_BAR; }
        if constexpr (!Epi::AFTER_DRAIN) { E(acc, cur, wr, wc, fr, fq); S.done(cur); }
        if (!has_next) break;
#pragma unroll
        for (int a = 0; a < 2; ++a)
#pragma unroll
            for (int b = 0; b < 2; ++b)
#pragma unroll
                for (int m = 0; m < 4; ++m)
#pragma unroll
                    for (int n = 0; n < 2; ++n) acc[a][b][m][n] = (f32x4){0.f, 0.f, 0.f, 0.f};
        cur = nxt; cA = nA; cB = nB; ++ui;
        if constexpr (ALIGN_EPI) { if (wr == 1) PG8_BAR; }
    }
    PG8_WAIT_V(0);
    if constexpr (!ALIGN_EPI) { if (wr == 0) PG8_BAR; }
    PG8_BAR;
    if constexpr (Epi::AFTER_DRAIN) { E.fused(acc, cur, wr, wc, fr, fq, lds, wid, lane); S.done(cur); }
}
template <class Epi, class Sched, bool FP8 = false>
__device__ __forceinline__ void gemm_phase_gather(PG8_LAS unsigned char* lds, const Gemm g, const int* slot_tok, const Sched& S, const Epi& E) {
    constexpr bool ALIGN_EPI = true, SP2 = true;
    int tid_o_ = threadIdx.x; asm volatile("" : "+v"(tid_o_)); const int tid = tid_o_, wid = __builtin_amdgcn_readfirstlane(tid >> 6), lane = tid & 63, wr = wid >> 2, wc = wid & 3, fr = lane & 15, fq = lane >> 4;
    const int K = g.K, nt = K / BK;
    unsigned voffB[2]; unsigned vC[2][2];
#pragma unroll
    for (int i = 0; i < 2; ++i) { int R, C; stage_rc(tid * 16 + i * 8192, R, C); const int Rb = Epi::PERM ? ((R & ~31) + perm32(R & 31)) : R;
        voffB[i] = (unsigned)(Rb * K + C) * 2u; }
    const size_t kstep = (size_t)(BK * 2);
    const size_t hstep = (size_t)HALF * K * 2;
    const size_t tstep = 2 * hstep;
    const unsigned ldsw = (unsigned)wid * 1024u;
    const int aoff = lds_byte(wr * 64 + fr, fq * 8), boff = lds_byte(wc * 32 + fr, fq * 8);
    Unit cur, nxt; int ui = 0;
    if (!S.next(0, cur)) return;
    f32x4 acc[2][2][4][2];
#pragma unroll
    for (int a = 0; a < 2; ++a)
#pragma unroll
        for (int b = 0; b < 2; ++b)
#pragma unroll
            for (int m = 0; m < 4; ++m)
#pragma unroll
                for (int n = 0; n < 2; ++n) acc[a][b][m][n] = (f32x4){0.f, 0.f, 0.f, 0.f};
    bf16x8 At[4][2], B0[2][2], B1[2][2]; i32x8 At_8[4], B0_8[2], B1_8[2]; int sc1_ = 0x7f7f7f7f; asm volatile("" : "+v"(sc1_));
    const char* XA = (const char*)g.A; const char* cB = (const char*)g.Bt + (size_t)cur.pn * tstep;
#pragma unroll
    for (int h = 0; h < 2; ++h)
#pragma unroll
        for (int i = 0; i < 2; ++i) { int R_, C_; stage_rc(tid * 16 + i * 8192, R_, C_); vC[h][i] = (unsigned)slot_tok[cur.pm * BM + h * HALF + R_] * (unsigned)(K * 2) + (unsigned)C_ * 2u; }
    S.a_ready(cur);
    if constexpr (SP2) {
        PG8_STAGE(PG8_SB(0, 0), cB, voffB); PG8_STAGE(PG8_SB(0, 1), cB + hstep, voffB); PG8_STAGE(PG8_SA(0, 0), XA, vC[0]); PG8_STAGE(PG8_SA(0, 1), XA, vC[1]);
        if (wr == 1) PG8_BAR;
        PG8_WAIT_V(2); PG8_BAR;
        PG8_STAGE(PG8_SB(1, 0), cB + kstep, voffB); PG8_STAGE(PG8_SA(1, 0), XA + kstep, vC[0]); PG8_STAGE(PG8_SB(1, 1), cB + hstep + kstep, voffB);
        PG8_WAIT_V(6); PG8_BAR;
    }
    for (;;) {
        const bool has_next = S.next(ui + 1, nxt);
        const char* nB = has_next ? (const char*)g.Bt + (size_t)nxt.pn * tstep : cB;
        PG8_LAS unsigned char* tab = lds + STAGE_BYTES + ((ui + 1) & 1) * 1024;
        if (has_next && wid == 0) __builtin_amdgcn_global_load_lds((const unsigned*)(slot_tok + (size_t)nxt.pm * BM + lane * 4), (PG8_LAS unsigned*)tab, 16, 0, 0);
        for (int t = 0; t < nt; t += 2) {
            const bool last = (t == nt - 2);
            const char* a1 = XA + (size_t)(t + 1) * kstep;
            const char* a2 = last ? XA : XA + (size_t)(t + 2) * kstep; const char* b2 = last ? nB : cB + (size_t)(t + 2) * kstep;
            const char* a3 = a2 + kstep; const char* b3 = b2 + kstep;
            unsigned vN[2][2];
            if (last && has_next) {
#pragma unroll
                for (int h = 0; h < 2; ++h)
#pragma unroll
                    for (int i = 0; i < 2; ++i) { int R_, C_; stage_rc(tid * 16 + i * 8192, R_, C_); vN[h][i] = *(const PG8_LAS unsigned*)(tab + (h * HALF + R_) * 4) * (unsigned)(K * 2) + (unsigned)C_ * 2u; }
            } else {
#pragma unroll
                for (int h = 0; h < 2; ++h)
#pragma unroll
                    for (int i = 0; i < 2; ++i) vN[h][i] = vC[h][i];
            }
            const unsigned vS0[2] = {vN[0][0], vN[0][1]}, vS1[2] = {vN[1][0], vN[1][1]};
            if (last && has_next) S.a_ready(nxt);
            if constexpr (SP2) {
            PG8_LDB(B0, 0, 0); PG8_LDB(B1, 0, 1); PG8_SCHED; PG8_LDA(At, 0, 0); PG8_STAGE(PG8_SA(1, 1), a1, vC[1]);
            PG8_WAIT_V(8); PG8_WAIT_L(0); PG8_BAR; PG8_MMA(0, 0, At, B0); PG8_MMA(0, 1, At, B1); PG8_BAR; PG8_SCHED;
            PG8_LDA(At, 0, 1); PG8_STAGE(PG8_SB(0, 0), b2, voffB); PG8_STAGE(PG8_SB(0, 1), b2 + hstep, voffB); PG8_STAGE(PG8_SA(0, 0), a2, vS0);
            PG8_WAIT_V(8); PG8_WAIT_L(0); PG8_BAR; PG8_MMA(1, 0, At, B0); PG8_MMA(1, 1, At, B1); PG8_BAR; PG8_SCHED;
            PG8_LDB(B0, 1, 0); PG8_LDB(B1, 1, 1); PG8_SCHED; PG8_LDA(At, 1, 0); PG8_STAGE(PG8_SA(0, 1), a2, vS1);
            PG8_WAIT_V(8); PG8_WAIT_L(0); PG8_BAR; PG8_MMA(0, 0, At, B0); PG8_MMA(0, 1, At, B1); PG8_BAR; PG8_SCHED;
            PG8_LDA(At, 1, 1); PG8_STAGE(PG8_SB(1, 0), b3, voffB); PG8_STAGE(PG8_SB(1, 1), b3 + hstep, voffB); PG8_STAGE(PG8_SA(1, 0), a3, vS0);
            PG8_WAIT_V(8); PG8_WAIT_L(0); PG8_BAR; PG8_MMA(1, 0, At, B0); PG8_MMA(1, 1, At, B1); PG8_BAR; PG8_SCHED;
            }
        }
        if constexpr (FP8) asm volatile("s_nop 15\n\ts_nop 15" ::: "memory");
        if constexpr (ALIGN_EPI) { if (wr == 0) PG8_BAR; }
        if constexpr (!Epi::AFTER_DRAIN) { E(acc, cur, wr, wc, fr, fq); S.done(cur); }
        if (!has_next) break;
#pragma unroll
        for (int a = 0; a < 2; ++a)
#pragma unroll
            for (int b = 0; b < 2; ++b)
#pragma unroll
                for (int m = 0; m < 4; ++m)
#pragma unroll
                    for (int n = 0; n < 2; ++n) acc[a][b][m][n] = (f32x4){0.f, 0.f, 0.f, 0.f};
        cur = nxt; cB = nB; ++ui;
        { const PG8_LAS unsigned char* tabc = lds + STAGE_BYTES + (ui & 1) * 1024;
#pragma unroll
          for (int h = 0; h < 2; ++h)
#pragma unroll
              for (int i = 0; i < 2; ++i) { int R_, C_; stage_rc(tid * 16 + i * 8192, R_, C_); vC[h][i] = *(const PG8_LAS unsigned*)(tabc + (h * HALF + R_) * 4) * (unsigned)(K * 2) + (unsigned)C_ * 2u; } }
        if constexpr (ALIGN_EPI) { if (wr == 1) PG8_BAR; }
    }
    PG8_WAIT_V(0);
    if constexpr (!ALIGN_EPI) { if (wr == 0) PG8_BAR; }
    PG8_BAR;
    if constexpr (Epi::AFTER_DRAIN) { E.fused(acc, cur, wr, wc, fr, fq, lds, wid, lane); S.done(cur); }
}
#undef PG8_SA
#undef PG8_SB
#undef PG8_STAGE
#undef PG8_LDA
#undef PG8_LDB
#undef PG8_MMA
#undef PG8_WAIT_V
#undef PG8_WAIT_L
#undef PG8_BAR
#undef PG8_SCHED
}
#define LAS __attribute__((address_space(3)))
typedef unsigned short bf16;
typedef short bf16x8 __attribute__((ext_vector_type(8)));
typedef short v4i16 __attribute__((ext_vector_type(4)));
typedef float f32x4 __attribute__((ext_vector_type(4)));
typedef float f32x16 __attribute__((ext_vector_type(16)));
typedef unsigned u32x4 __attribute__((ext_vector_type(4)));
typedef unsigned u32x2 __attribute__((ext_vector_type(2)));
typedef float f32x2 __attribute__((ext_vector_type(2)));

constexpr int NB = 16, SEQ = 2048, T = NB * SEQ, D = 1024, DEPTH = 2;
constexpr int PIN = 3348;
constexpr int PP = 3584;
constexpr int NEXP = 32, DEXP = 512;
constexpr int NBLK_MAX = 288, NSLOT_MAX = NBLK_MAX * 256;
constexpr int NWAVES = 8, NTHREADS = 512;
constexpr float ALPHA = 1.41421356237f;
constexpr float LN_EPS = 1e-5f, RMS_EPS = 1e-6f;

constexpr int C_CU = 0, C_CGB = 256, C_CGC = 512, C_GQ = 768, C_GK = 896, C_GV = 1024, C_GG = 1280, C_SZ = 1536, C_SX = 1792, C_SB = 2048, C_SC = 2304,
              C_DQ = 2560, C_DK = 2816, C_DV = 3072, C_GLR = 3328, C_SDT = 3344;
__host__ __device__ __forceinline__ int orig_col(int c) {
    if (c < 1536) return c;
    if (c < 2560) return 1552 + (c - 1536);
    if (c < 3328) return 2580 + (c - 2560);
    if (c < 3344) return 1536 + (c - 3328);
    if (c < 3348) return 2576 + (c - 3344);
    return -1;
}

enum { I_X = 0, I_WIN, I_CONVW, I_GLA_WLR, I_GLA_BLR, I_GLA_NG, I_SSD_CW, I_SSD_CB, I_SSD_ALOG, I_SSD_D, I_SSD_DTB, I_SSD_NG, I_LQ1, I_LK1, I_LQ2, I_LK2, I_DIFF_NG,
       I_WO, I_LN1G, I_LN1B, I_RG, I_RE, I_WG, I_WU, I_WD, I_LN2G, I_LN2B, N_IN };

constexpr size_t MiB = 1u << 20;
constexpr size_t WS_WGCNT = 0;
constexpr size_t WS_BLKEXP = 64 * 1024;
constexpr size_t WS_SLOTGATE = 128 * 1024;
constexpr size_t WS_SLOTOF = 512 * 1024;
constexpr size_t WS_LNSTAT = 768 * 1024;
constexpr size_t WS_WRT = 1024 * 1024, WRT_LAYER = 128 * 1024;
constexpr size_t WS_RCS = WS_WRT + 98304;
constexpr size_t WS_LAM = 1700 * 1024;
constexpr size_t WS_SLOTTOK = 2560 * 1024;
constexpr size_t WS_SSDDEC = 1792 * 1024;
constexpr size_t WS_GLACL = 2048 * 1024;
constexpr size_t WS_BAR = 3 * MiB;
constexpr size_t WS_RDY = WS_BAR + 16384;
constexpr size_t WS_W = 4 * MiB;
constexpr size_t W_WIN = WS_W, W_WO = W_WIN + (size_t)PP * 1024 * 2, W_WGU = W_WO + (size_t)1024 * 1024 * 2, W_WD = W_WGU + (size_t)NEXP * 1024 * 1024 * 2,
                 W_END = W_WD + (size_t)NEXP * 1024 * 512 * 2;
constexpr size_t WS_A = 112 * MiB;
static_assert(W_END <= WS_A, "weights region");
constexpr size_t A_XB = WS_A, A_PROJ = WS_A + 64 * MiB, A_MIX = A_PROJ + 224 * MiB, A_ST = A_MIX + 64 * MiB, A_DST = A_ST + 32 * MiB, A_SP = A_DST + 16 * MiB, A_GP = A_SP + 16 * MiB, A_END = A_GP + 8 * MiB;
constexpr size_t A_V = WS_A + 64 * MiB;
constexpr size_t A_X1 = WS_A + 128 * MiB;
constexpr size_t A_XS = WS_A + 192 * MiB;
constexpr size_t A_X8 = A_X1;
constexpr size_t A_Y = A_XS;
constexpr size_t A_H = WS_A;
static_assert(A_XS + (size_t)NSLOT_MAX * 1024 * 2 <= A_ST, "Xs/Y overlay");
static_assert(A_H + (size_t)NSLOT_MAX * 512 * 2 <= A_X1, "h overlay");
static_assert((size_t)T * PP * 2 == 224 * MiB, "proj size");
constexpr size_t WS_NEED = A_END;
static_assert(WS_NEED <= 572000000ull, "workspace budget");

constexpr int LDS_BYTES = 163840;

__device__ __forceinline__ float bf2f(unsigned short b) { return __uint_as_float((unsigned)b << 16); }
__device__ __forceinline__ float bflo(unsigned w) { return __uint_as_float(w << 16); }
__device__ __forceinline__ float bfhi(unsigned w) { return __uint_as_float(w & 0xffff0000u); }
__device__ __forceinline__ unsigned pk2(float lo, float hi) { return pg8::cvt_pk_bf16(lo, hi); }
__device__ __forceinline__ unsigned short f2bf(float f) { return (unsigned short)(pk2(f, 0.f) & 0xffffu); }
__device__ __forceinline__ float siluf(float x) { return x * __builtin_amdgcn_rcpf(1.0f + __builtin_amdgcn_exp2f(-1.4426950408889634f * x)); }
__device__ __forceinline__ float softplusf(float x) { return fmaxf(x, 0.f) + __logf(1.0f + __expf(-fabsf(x))); }
__device__ __forceinline__ float logsigmoidf(float x) { return fminf(x, 0.f) - __logf(1.0f + __expf(-fabsf(x))); }
__device__ __forceinline__ int crow(int i, int h) { return (i & 3) + 8 * (i >> 2) + 4 * h; }
__device__ __forceinline__ float shflx(float v, int mask, int lane) { return __int_as_float(__builtin_amdgcn_ds_bpermute((lane ^ mask) << 2, __float_as_int(v))); }
__device__ __forceinline__ float shfl_from(float v, int src, int lane) { (void)lane; return __int_as_float(__builtin_amdgcn_ds_bpermute(src << 2, __float_as_int(v))); }
__device__ __forceinline__ float xor32_add(float v) { auto rr = __builtin_amdgcn_permlane32_swap(__float_as_uint(v), __float_as_uint(v), false, false); return __uint_as_float(rr[0]) + __uint_as_float(rr[1]); }
__device__ __forceinline__ float wave_sum(float v, int lane) {
#pragma unroll
    for (int o = 1; o < 32; o <<= 1) v += shflx(v, o, lane);
    return xor32_add(v);
}
__device__ __forceinline__ bf16x8 fragN(const LAS unsigned char* X, int stride, int r0, int k0, int lane) {
    return *(const LAS bf16x8*)(X + (r0 + (lane & 31)) * stride + (k0 + 8 * (lane >> 5)) * 2);
}
__device__ __forceinline__ bf16x8 fragT(const LAS unsigned char* X, int stride, int k0, int c0, int lane) {
    const int g = lane >> 4, i = lane & 15, q = i >> 2, pp = i & 3, h = g >> 1;
    const LAS unsigned char* p = X + (k0 + 8 * h + q) * stride + (c0 + 16 * (g & 1) + 4 * pp) * 2;
    const v4i16 a = __builtin_amdgcn_ds_read_tr16_b64_v4i16((LAS v4i16*)p);
    const v4i16 b = __builtin_amdgcn_ds_read_tr16_b64_v4i16((LAS v4i16*)(p + 4 * stride));
    return (bf16x8){a[0], a[1], a[2], a[3], b[0], b[1], b[2], b[3]};
}
#define MFMA32(a, b, c) __builtin_amdgcn_mfma_f32_32x32x16_bf16((a), (b), (c), 0, 0, 0)
#define ZERO16 ((f32x16){0.f,0.f,0.f,0.f,0.f,0.f,0.f,0.f,0.f,0.f,0.f,0.f,0.f,0.f,0.f,0.f})

struct Ctx {
    const float* in[N_IN]; float* out; unsigned char* ws;
};
struct Args { const float* in[N_IN]; float* out; unsigned char* ws; };

struct CvtItem { const float* cp; unsigned char* dst; int ld, K, n0, k0; float sc; bool f8; };
__device__ __forceinline__ void cvt_load(const CvtItem& d, f32x4 (&v)[8], int lane) {
#pragma unroll
    for (int i = 0; i < 8; ++i) { const int kk = 8 * i + (lane >> 3); v[i] = *(const f32x4*)(d.cp + (size_t)(d.k0 + kk) * d.ld); }
}
__device__ __forceinline__ void cvt_finish(const CvtItem& d, const f32x4 (&v)[8], LAS float* scr, int lane) {
#pragma unroll
    for (int i = 0; i < 8; ++i) { const int kk = 8 * i + (lane >> 3); LAS float* p = scr + kk * 33 + 4 * (lane & 7); p[0] = v[i][0] * d.sc; p[1] = v[i][1] * d.sc; p[2] = v[i][2] * d.sc; p[3] = v[i][3] * d.sc; }
    const int c = lane & 7;
#pragma unroll
    for (int j = 0; j < 4; ++j) { const int n = (lane >> 3) + 8 * j; const LAS float* s = scr + (8 * c) * 33 + n;
        if (d.f8) { u32x2 o; o.x = pg8::pk4_fp8(s[0 * 33], s[1 * 33], s[2 * 33], s[3 * 33]); o.y = pg8::pk4_fp8(s[4 * 33], s[5 * 33], s[6 * 33], s[7 * 33]);
            *(u32x2*)(d.dst + (size_t)(d.n0 + n) * d.K + d.k0 + 8 * c) = o; }
        else { u32x4 o; o.x = pk2(s[0 * 33], s[1 * 33]); o.y = pk2(s[2 * 33], s[3 * 33]); o.z = pk2(s[4 * 33], s[5 * 33]); o.w = pk2(s[6 * 33], s[7 * 33]);
            *(u32x4*)(d.dst + ((size_t)(d.n0 + n) * d.K + d.k0 + 8 * c) * 2) = o; } }
}
#ifndef MOE_FP8
#define MOE_FP8 1
#endif
__device__ __forceinline__ unsigned char* wbuf(const Args& A, int l) { return (l & 1) ? (unsigned char*)A.out : A.ws + WS_W; }
#ifndef CVT_NP
#define CVT_NP 4
#endif
constexpr int CV_IT_IN = 16 * (PP / 32), CV_NIT = CV_IT_IN + 16 * 32 + 16 * (NEXP * 1024 / 32) + 8 * (NEXP * 1024 / 32);
__device__ __forceinline__ void convert_weights(const Args& A, int l, LAS unsigned char* lds, int gw, int ngw, int wave, int lane, int it0, int it1, bool tables) {
    LAS float* scr = (LAS float*)(lds + wave * 8704);
    unsigned char* ws = A.ws; unsigned char* wb = wbuf(A, l) - WS_W;
    const float* w_in = A.in[I_WIN] + (size_t)l * 1024 * PIN;
    const float* w_o = A.in[I_WO] + (size_t)l * 1024 * 1024;
    const float* w_g = A.in[I_WG] + (size_t)l * NEXP * 1024 * 512;
    const float* w_u = A.in[I_WU] + (size_t)l * NEXP * 1024 * 512;
    const float* w_d = A.in[I_WD] + (size_t)l * NEXP * 512 * 1024;
    constexpr int IT_IN = 16 * (PP / 32), IT_O = 16 * 32, IT_GU = 16 * (NEXP * 1024 / 32), IT_D = 8 * (NEXP * 1024 / 32);
    constexpr int NIT = IT_IN + IT_O + IT_GU + IT_D;
    const int nl = 4 * (lane & 7);
    auto desc = [&](int it) -> CvtItem {
        CvtItem d; int r = it; d.sc = 1.0f; d.f8 = false;
        if (r < IT_IN) { const int kb = r / (PP / 32), nb = r % (PP / 32); const int oc = orig_col(nb * 32 + nl);
            d.cp = w_in + (oc >= 0 ? oc : 0); d.sc = oc >= 0 ? 1.0f : 0.0f; d.ld = PIN; d.dst = wb + W_WIN; d.K = 1024; d.n0 = nb * 32; d.k0 = kb * 64; return d; }
        r -= IT_IN;
        if (r < IT_O) { const int kb = r / 32, nb = r % 32; d.cp = w_o + nb * 32 + nl; d.ld = 1024; d.dst = wb + W_WO; d.K = 1024; d.n0 = nb * 32; d.k0 = kb * 64; return d; }
        r -= IT_O;
        if (r < IT_GU) { const int kb = r / 1024, nb = r % 1024; const int n = nb * 32 + nl, e = n >> 10, np = n & 1023, pnl = np >> 8, half = (np >> 7) & 1, j = np & 127;
            d.cp = (half ? w_u : w_g) + (size_t)e * 1024 * 512 + pnl * 128 + j; d.ld = 512; d.dst = wb + W_WGU; d.K = 1024; d.n0 = nb * 32; d.k0 = kb * 64; d.f8 = MOE_FP8 != 0; d.sc = MOE_FP8 ? 64.0f : 1.0f; return d; }
        r -= IT_GU;
        { const int kb = r / 1024, nb = r % 1024; const int n = nb * 32 + nl, e = n >> 10, np = n & 1023;
            d.cp = w_d + (size_t)e * 512 * 1024 + np; d.ld = 1024; d.dst = wb + W_WD; d.K = 512; d.n0 = nb * 32; d.k0 = kb * 64; d.f8 = MOE_FP8 != 0; d.sc = MOE_FP8 ? 64.0f : 1.0f; return d; }
    };
    static_assert(NIT == CV_NIT && IT_IN == CV_IT_IN, "item counts");
    {
        CvtItem d[CVT_NP]; f32x4 v[CVT_NP][8];
#pragma unroll
        for (int j = 0; j < CVT_NP; ++j) { const int itj = it0 + gw + j * ngw; d[j] = desc(itj < it1 ? itj : it1 - 1); cvt_load(d[j], v[j], lane); }
        for (int it = it0 + gw; it < it1; it += CVT_NP * ngw) {
#pragma unroll
            for (int j = 0; j < CVT_NP; ++j) { const int itj = it + j * ngw;
                if (itj < it1) cvt_finish(d[j], v[j], scr, lane);
                const int itn = itj + CVT_NP * ngw; d[j] = desc(itn < it1 ? itn : it1 - 1); cvt_load(d[j], v[j], lane); }
        }
    }
    if (!tables) return;
    bf16* wrt = (bf16*)(ws + WS_WRT + l * WRT_LAYER); float* rcs = (float*)(ws + WS_RCS + l * WRT_LAYER);
    const float* rg = A.in[I_RG] + (size_t)l * 1024 * 4; const float* re = A.in[I_RE] + (size_t)l * 1024 * 32;
    const float* g1 = A.in[I_LN1G] + l * 1024; const float* b1 = A.in[I_LN1B] + l * 1024;
    for (int j = gw; j < 48; j += ngw) {
        float cs = 0.f, cb = 0.f;
        for (int k = lane; k < 1024; k += 64) {
            const float w = j < 4 ? rg[k * 4 + j] : (j < 36 ? re[k * 32 + (j - 4)] : 0.f);
            const unsigned short wb = f2bf(g1[k] * w); wrt[j * 1024 + k] = wb; cs += bf2f(wb); cb += b1[k] * w;
        }
        cs = wave_sum(cs, lane); cb = wave_sum(cb, lane);
        if (lane == 0) { rcs[j] = cs; rcs[48 + j] = cb; }
    }
    if (l == 0 && gw == 48) {
        for (int ll = 0; ll < DEPTH; ++ll) {
            float s1 = (lane < 32) ? A.in[I_LQ1][ll * 32 + (lane & 31)] * A.in[I_LK1][ll * 32 + (lane & 31)] : 0.f, s2 = (lane < 32) ? A.in[I_LQ2][ll * 32 + (lane & 31)] * A.in[I_LK2][ll * 32 + (lane & 31)] : 0.f;
            s1 = wave_sum(s1, lane); s2 = wave_sum(s2, lane);
            const float lam_init = 0.8f - 0.6f * __expf(-0.3f * (float)ll);
            if (lane == 0) ((float*)(ws + WS_LAM))[ll] = __expf(s1) - __expf(s2) + lam_init; }
    }
}
__device__ __forceinline__ void convert_x(const Args& A, int gtid, int gthreads) {
    const f32x4* x = (const f32x4*)A.in[I_X]; u32x4* xb = (u32x4*)(A.ws + A_XB);
    constexpr size_t NCH = (size_t)T * D / 8;
    for (size_t i = gtid; i < NCH; i += (size_t)gthreads * 4) {
        f32x4 a[4], b[4];
#pragma unroll
        for (int u = 0; u < 4; ++u) { const size_t j = i + (size_t)u * gthreads; if (j < NCH) { a[u] = x[2 * j]; b[u] = x[2 * j + 1]; } }
#pragma unroll
        for (int u = 0; u < 4; ++u) { const size_t j = i + (size_t)u * gthreads; if (j < NCH) { u32x4 o; o.x = pk2(a[u][0], a[u][1]); o.y = pk2(a[u][2], a[u][3]); o.z = pk2(b[u][0], b[u][1]); o.w = pk2(b[u][2], b[u][3]); xb[j] = o; } }
    }
}
__device__ __forceinline__ int opaque_tid() { int t = threadIdx.x; asm volatile("" : "+v"(t)); return t; }
#define XB_TMO      128
#define XB_XCNT(j)  (256  + 64 * (j))
#define XB_XSUB(j)  (1280 + 64 * (j))
#define XB_XGEN(j)  (2304 + 64 * (j))
#define XB_TOP      3328
#define XB_TOPGEN   3392
#define XCD_BAR_WORDS 3456
#define XB_SPIN_CAP (1u << 18)

__device__ __forceinline__ unsigned xb_ld(unsigned* p)              { return __hip_atomic_load(p, __ATOMIC_RELAXED, __HIP_MEMORY_SCOPE_AGENT); }
__device__ __forceinline__ unsigned xb_add(unsigned* p, unsigned v) { return __hip_atomic_fetch_add(p, v, __ATOMIC_RELAXED, __HIP_MEMORY_SCOPE_AGENT); }
__device__ __forceinline__ unsigned xb_xcc_id() { return (unsigned)__builtin_amdgcn_s_getreg((3 << 11) | 20) & 0xFu; }
#define XB_SPIN(cond, bar) do { unsigned _sp = 0; while (cond) { __builtin_amdgcn_s_sleep(1); \
    if ((++_sp & 255u) == 0u) { if (xb_ld(&(bar)[XB_TMO])) break; if (_sp > XB_SPIN_CAP) { atomicAdd(&(bar)[XB_TMO], 1u); break; } } } } while (0)

struct XcdBarrier {
    unsigned* bar; unsigned x;
    volatile LAS unsigned* st;
};

__device__ __forceinline__ XcdBarrier xcd_barrier_post(unsigned* bar, volatile LAS unsigned* st) {
    XcdBarrier b; b.bar = bar; b.x = xb_xcc_id(); b.st = st;
    if (threadIdx.x == 0) (void)xb_add(&bar[XB_XCNT(b.x)], 1u);
    return b;
}
__device__ __forceinline__ void xcd_barrier_complete(unsigned* bar, unsigned x, unsigned& nloc, unsigned& nx) {
    const unsigned G = gridDim.x * gridDim.y * gridDim.z;
    unsigned sum, cnt, mine, sp = 0u;
    for (;;) {
        sum = 0u; cnt = 0u; mine = 0u;
#pragma unroll
        for (unsigned j = 0; j < 16; ++j) { const unsigned c = xb_ld(&bar[XB_XCNT(j)]); sum += c; cnt += (c > 0u) ? 1u : 0u; mine = (j == x) ? c : mine; }
        if (sum == G) break;
        __builtin_amdgcn_s_sleep(1);
        if ((++sp & 255u) == 0u) { if (xb_ld(&bar[XB_TMO])) break; if (sp > XB_SPIN_CAP) { atomicAdd(&bar[XB_TMO], 1u); break; } }
    }
    nloc = mine > 0u ? mine : 1u; nx = cnt > 0u ? cnt : 1u;
}

__device__ __forceinline__ void xcd_barrier(const XcdBarrier& b) {
    asm volatile("s_waitcnt vmcnt(0)" ::: "memory");
    __syncthreads();
    if (threadIdx.x == 0) {
        unsigned* bar = b.bar; unsigned bx_ = (unsigned)__builtin_amdgcn_readfirstlane((int)b.x); asm volatile("" : "+s"(bx_));
        __builtin_amdgcn_s_waitcnt(0);
        unsigned nloc = b.st[0], nx = b.st[1];
        if (nloc == 0u) { xcd_barrier_complete(bar, bx_, nloc, nx); b.st[0] = nloc; b.st[1] = nx; }
        const unsigned old = xb_add(&bar[XB_XSUB(bx_)], 1u);
        const unsigned gen = old / nloc;
        if (old + 1u == (gen + 1u) * nloc) {
            __builtin_amdgcn_fence(__ATOMIC_RELEASE, "agent");
            asm volatile("s_waitcnt vmcnt(0)" ::: "memory");
            const unsigned og = xb_add(&bar[XB_TOP], 1u);
            const unsigned tg = og / nx;
            if (og + 1u == (tg + 1u) * nx) xb_add(&bar[XB_TOPGEN], 1u);
            else XB_SPIN(xb_ld(&bar[XB_TOPGEN]) == tg, bar);
            __builtin_amdgcn_fence(__ATOMIC_ACQUIRE, "agent");
            xb_add(&bar[XB_XGEN(bx_)], 1u);
            asm volatile("s_waitcnt vmcnt(0)" ::: "memory");
        } else {
            XB_SPIN(xb_ld(&bar[XB_XGEN(bx_)]) == gen, bar);
            __builtin_amdgcn_fence(__ATOMIC_ACQUIRE, "agent");
            asm volatile("s_waitcnt vmcnt(0)" ::: "memory");
        }
    }
    __syncthreads();
}
constexpr int AT_Q = 0, AT_RING = 18432, AT_NSLOT = 6, AT_SLOT = 16384, AT_CMB = AT_RING + AT_NSLOT * AT_SLOT;
static_assert(AT_CMB + 32768 <= LDS_BYTES - 64, "attention LDS map");
#define EX2(x) __builtin_amdgcn_exp2f(x)
__device__ __forceinline__ void attn_mask(f32x16& s0, f32x16& s1, int kb0, int qrel, int hh) {
#pragma unroll
    for (int i = 0; i < 16; ++i) { const int kv = kb0 + crow(i, hh); if (kv > qrel) s0[i] = -INFINITY; if (kv + 32 > qrel) s1[i] = -INFINITY; }
}
__device__ __forceinline__ float xhalf_max(float v) { auto rr = __builtin_amdgcn_permlane32_swap(__float_as_uint(v), __float_as_uint(v), false, false); return fmaxf(__uint_as_float(rr[0]), __uint_as_float(rr[1])); }
__device__ __forceinline__ bf16x8 pack8(const f32x16& c, int b) {
    u32x4 w; w.x = pk2(c[b], c[b + 1]); w.y = pk2(c[b + 2], c[b + 3]); w.z = pk2(c[b + 4], c[b + 5]); w.w = pk2(c[b + 6], c[b + 7]); return __builtin_bit_cast(bf16x8, w);
}
__device__ __forceinline__ bf16x8 tr2(const LAS unsigned char* p) {
    const v4i16 a = __builtin_amdgcn_ds_read_tr16_b64_v4i16((LAS v4i16*)p), b = __builtin_amdgcn_ds_read_tr16_b64_v4i16((LAS v4i16*)(p + 1024));
    return (bf16x8){a[0], a[1], a[2], a[3], b[0], b[1], b[2], b[3]};
}
__device__ __forceinline__ void glds16(const void* gsrc, unsigned lds_dst) { unsigned keep;
    asm volatile("s_mov_b32 %0, m0\n\ts_mov_b32 m0, %2\n\ts_nop 0\n\tglobal_load_lds_dwordx4 %1, off\n\ts_mov_b32 m0, %0" : "=&s"(keep) : "v"(gsrc), "s"(lds_dst) : "memory"); }
__device__ __forceinline__ void attn_unit(LAS unsigned char* lds, const bf16* proj, bf16* mix, int b, int h, int qb, float lam, const float* normg, float oscale, bool first, int nb, int nh, int nqb, u32x4 (&qn)[2]) {
    const int tid = opaque_tid(), lane = tid & 63, wid = __builtin_amdgcn_readfirstlane(tid >> 6), ws = wid & 3, comp = wid >> 2, r32 = lane & 31, hh = lane >> 5;
    const size_t tb = (size_t)b * SEQ;
    LAS unsigned char* Qs = lds + AT_Q; LAS unsigned char* ring = lds + AT_RING; const unsigned ring0 = (unsigned)(uintptr_t)ring;
    const bf16* qsrc = proj + (tb + qb * 128) * PP + C_DQ + h * 64;
    const int NT = 2 * qb + 2, qrel = ws * 32 + r32;
    const bf16* kdma = proj + (tb + 8 * wid + (lane >> 3)) * PP + C_DK + h * 64 + (((lane & 7) ^ (lane >> 3)) << 3);
    const bf16* vdma = kdma + (C_DV - C_DK);
#define DMA_TILE_P(kp, nt, tile, slot) do { const int tl_ = (tile) < (nt) ? (tile) : (nt) - 1; \
        glds16((kp) + (size_t)tl_ * 64 * PP, (unsigned)__builtin_amdgcn_readfirstlane((int)(ring0 + (slot) * AT_SLOT + wid * 1024))); \
        glds16((kp) + (C_DV - C_DK) + (size_t)tl_ * 64 * PP, (unsigned)__builtin_amdgcn_readfirstlane((int)(ring0 + (slot) * AT_SLOT + 8192 + wid * 1024))); } while (0)
    if (first) { DMA_TILE_P(kdma, NT, 0, 0); DMA_TILE_P(kdma, NT, 1, 1); DMA_TILE_P(kdma, NT, 2, 2); DMA_TILE_P(kdma, NT, 3, 3);
#pragma unroll
        for (int i = 0; i < 2; ++i) { const int id = tid + 512 * i; qn[i] = *(const u32x4*)(qsrc + (size_t)(id >> 3) * PP + (id & 7) * 8); } }
    const float c2 = 0.25503486f;
#pragma unroll
    for (int i = 0; i < 2; ++i) { const int id = tid + 512 * i, row = id >> 3, ch = id & 7; const u32x4 q = qn[i];
        u32x4 o; o.x = pk2(bflo(q.x) * c2, bfhi(q.x) * c2); o.y = pk2(bflo(q.y) * c2, bfhi(q.y) * c2); o.z = pk2(bflo(q.z) * c2, bfhi(q.z) * c2); o.w = pk2(bflo(q.w) * c2, bfhi(q.w) * c2);
        *(LAS u32x4*)(Qs + row * 144 + ch * 16) = o; }
    asm volatile("s_waitcnt vmcnt(0) lgkmcnt(0)" ::: "memory"); __builtin_amdgcn_s_barrier(); asm volatile("" ::: "memory");
    bf16x8 qf[2];
    qf[0] = fragN(Qs, 144, ws * 32, comp * 32, lane); qf[1] = fragN(Qs, 144, ws * 32, comp * 32 + 16, lane);
    const int kx = r32 & 7;
    const int koff0 = r32 * 128 + (((comp * 4 + hh) ^ kx) << 4), koff1 = r32 * 128 + (((comp * 4 + 2 + hh) ^ kx) << 4);
    const int g_ = lane >> 4, i_ = lane & 15, q_ = i_ >> 2, pp_ = i_ & 3, vrow = 4 * (g_ >> 1) + q_, vch = 2 * (g_ & 1) + (pp_ >> 1);
    const int voff0 = 8192 + vrow * 128 + (((vch) ^ vrow) << 4) + 8 * (pp_ & 1), voff1 = 8192 + vrow * 128 + (((vch + 4) ^ vrow) << 4) + 8 * (pp_ & 1);
    float l = 0.f;
    f32x16 o0 = ZERO16, o1 = ZERO16, negm = ZERO16; float m = 0.f;
    f32x16 sA0, sA1, sB0, sB1;
    bf16x8 pA[4], pB[4];
#pragma unroll
    for (int i = 0; i < 4; ++i) pA[i] = (bf16x8){0, 0, 0, 0, 0, 0, 0, 0};
#define QK4(N0, N1, k00, k10, k01, k11) do { \
        asm volatile("s_nop 1\n\tv_mfma_f32_32x32x16_bf16 %0, %1, %2, %3" : "=&v"(N0) : "v"(k00), "v"(qf[0]), "v"(negm)); \
        asm volatile("v_mfma_f32_32x32x16_bf16 %0, %1, %2, %3" : "=&v"(N1) : "v"(k10), "v"(qf[0]), "v"(negm)); \
        asm volatile("v_mfma_f32_32x32x16_bf16 %0, %1, %2, %0" : "+v"(N0) : "v"(k01), "v"(qf[1])); \
        asm volatile("v_mfma_f32_32x32x16_bf16 %0, %1, %2, %0\n\ts_nop 15\n\ts_nop 3" : "+v"(N1) : "v"(k11), "v"(qf[1])); } while (0)
#define KFR(Kb) const bf16x8 k00 = *(const LAS bf16x8*)((Kb) + koff0), k10 = *(const LAS bf16x8*)((Kb) + 4096 + koff0), k01 = *(const LAS bf16x8*)((Kb) + koff1), k11 = *(const LAS bf16x8*)((Kb) + 4096 + koff1)
    { KFR(ring); QK4(sA0, sA1, k00, k10, k01, k11); }
    if (qb == 0) attn_mask(sA0, sA1, 0, qrel, hh);
#define SB() __builtin_amdgcn_sched_barrier(0)
#define E4(X, B) do { X[B] = EX2(X[B]); X[B + 1] = EX2(X[B + 1]); X[B + 2] = EX2(X[B + 2]); X[B + 3] = EX2(X[B + 3]); l += X[B]; l += X[B + 1]; l += X[B + 2]; l += X[B + 3]; } while (0)
#define ATT_STEP(C0, C1, N0, N1, PP_, PN_, tt, SV, SK, SD) do { \
        const bool nx = (tt) + 1 < NT; \
        { const int tl_ = (tt) + 4 < NT ? (tt) + 4 : NT - 1; \
          glds16(kdma + (size_t)tl_ * 64 * PP, (unsigned)__builtin_amdgcn_readfirstlane((int)(ring0 + (SD) * AT_SLOT + wid * 1024))); \
          glds16(vdma + (size_t)tl_ * 64 * PP, (unsigned)__builtin_amdgcn_readfirstlane((int)(ring0 + (SD) * AT_SLOT + 8192 + wid * 1024))); } \
        const LAS unsigned char* Vb = ring + (SV) * AT_SLOT; const LAS unsigned char* Kb = ring + (SK) * AT_SLOT; \
        bf16x8 va0 = tr2(Vb + voff0), vb0 = tr2(Vb + voff1), va1 = tr2(Vb + 2048 + voff0), vb1 = tr2(Vb + 2048 + voff1); \
        float mx = fmaxf(C0[0], C1[0]); \
        _Pragma("unroll") for (int i = 1; i < 16; ++i) mx = fmaxf(fmaxf(mx, C0[i]), C1[i]); \
        mx = xhalf_max(mx); \
        if ((tt) == 0 || __any(mx > 8.0f)) { const float d = ((tt) == 0) ? mx : fmaxf(mx, 0.f), al = EX2(-d); m += d; \
            _Pragma("unroll") for (int i = 0; i < 16; ++i) { o0[i] *= al; o1[i] *= al; C0[i] -= d; C1[i] -= d; negm[i] = -m; } l *= al; \
            _Pragma("unroll") for (int i = 0; i < 4; ++i) { u32x4 w = __builtin_bit_cast(u32x4, PP_[i]); \
                w.x = pk2(bflo(w.x) * al, bfhi(w.x) * al); w.y = pk2(bflo(w.y) * al, bfhi(w.y) * al); w.z = pk2(bflo(w.z) * al, bfhi(w.z) * al); w.w = pk2(bflo(w.w) * al, bfhi(w.w) * al); PP_[i] = __builtin_bit_cast(bf16x8, w); } } \
        SB(); \
        o0 = MFMA32(va0, PP_[0], o0); E4(C0, 0); SB(); \
        o1 = MFMA32(vb0, PP_[0], o1); E4(C0, 4); SB(); \
        const bf16x8 va2 = tr2(Vb + 4096 + voff0), vb2 = tr2(Vb + 4096 + voff1), va3 = tr2(Vb + 6144 + voff0), vb3 = tr2(Vb + 6144 + voff1); \
        o0 = MFMA32(va1, PP_[1], o0); E4(C0, 8); SB(); \
        o1 = MFMA32(vb1, PP_[1], o1); E4(C0, 12); SB(); \
        o0 = MFMA32(va2, PP_[2], o0); PN_[0] = pack8(C0, 0); PN_[1] = pack8(C0, 8); SB(); \
        o1 = MFMA32(vb2, PP_[2], o1); E4(C1, 0); SB(); \
        KFR(Kb); \
        o0 = MFMA32(va3, PP_[3], o0); E4(C1, 4); SB(); \
        o1 = MFMA32(vb3, PP_[3], o1); E4(C1, 8); SB(); \
        E4(C1, 12); PN_[2] = pack8(C1, 0); PN_[3] = pack8(C1, 8); SB(); \
        QK4(N0, N1, k00, k10, k01, k11); \
        if (nx && (tt) + 1 >= 2 * qb) attn_mask(N0, N1, ((tt) + 1 - 2 * qb) * 64, qrel, hh); \
        asm volatile("s_waitcnt vmcnt(4)" ::: "memory"); asm volatile("s_waitcnt lgkmcnt(0)" ::: "memory"); __builtin_amdgcn_s_barrier(); asm volatile("" ::: "memory"); \
    } while (0)
    int t = 0;
    for (; t + 6 <= NT; t += 6) {
        ATT_STEP(sA0, sA1, sB0, sB1, pA, pB, t, (t == 0 ? 0 : 5), 1, 4);
        ATT_STEP(sB0, sB1, sA0, sA1, pB, pA, t + 1, 0, 2, 5);
        ATT_STEP(sA0, sA1, sB0, sB1, pA, pB, t + 2, 1, 3, 0);
        ATT_STEP(sB0, sB1, sA0, sA1, pB, pA, t + 3, 2, 4, 1);
        ATT_STEP(sA0, sA1, sB0, sB1, pA, pB, t + 4, 3, 5, 2);
        ATT_STEP(sB0, sB1, sA0, sA1, pB, pA, t + 5, 4, 0, 3);
    }
    if (t < NT) {
        ATT_STEP(sA0, sA1, sB0, sB1, pA, pB, t, (t == 0 ? 0 : 5), 1, 4);
        ATT_STEP(sB0, sB1, sA0, sA1, pB, pA, t + 1, 0, 2, 5);
        if (t + 2 < NT) {
            ATT_STEP(sA0, sA1, sB0, sB1, pA, pB, t + 2, 1, 3, 0);
            ATT_STEP(sB0, sB1, sA0, sA1, pB, pA, t + 3, 2, 4, 1);
        }
    }
#undef ATT_STEP
#undef QK4
#undef KFR
    { const LAS unsigned char* Vb = ring + ((NT - 1) % AT_NSLOT) * AT_SLOT;
#pragma unroll
      for (int kk = 0; kk < 4; ++kk) { o0 = MFMA32(tr2(Vb + kk * 2048 + voff0), pA[kk], o0); o1 = MFMA32(tr2(Vb + kk * 2048 + voff1), pA[kk], o1); } }
#undef E4
#undef SB
    l = xor32_add(l);
    const float inv = 1.0f / l;
    LAS float* cmb = (LAS float*)(lds + AT_CMB) + ws * 2048;
    if (comp == 1) {
#pragma unroll
        for (int i = 0; i < 16; ++i) { cmb[i * 64 + lane] = o0[i] * inv; cmb[(16 + i) * 64 + lane] = o1[i] * inv; }
    }
    asm volatile("s_waitcnt vmcnt(0) lgkmcnt(0)" ::: "memory"); __builtin_amdgcn_s_barrier(); asm volatile("" ::: "memory");
    {
        const bool hn = nqb >= 0; const int nqb_ = hn ? nqb : 0;
        if (hn) { const bf16* nk = proj + ((size_t)nb * SEQ + 8 * wid + (lane >> 3)) * PP + C_DK + nh * 64 + (((lane & 7) ^ (lane >> 3)) << 3); const int nnt = 2 * nqb + 2;
            DMA_TILE_P(nk, nnt, 0, 0); DMA_TILE_P(nk, nnt, 1, 1); DMA_TILE_P(nk, nnt, 2, 2); DMA_TILE_P(nk, nnt, 3, 3); }
        const bf16* nq = proj + ((size_t)nb * SEQ + nqb_ * 128) * PP + C_DQ + nh * 64;
#pragma unroll
        for (int i = 0; i < 2; ++i) { const int id = tid + 512 * i; qn[i] = *(const u32x4*)(nq + (size_t)(id >> 3) * PP + (id & 7) * 8); } }
#undef DMA_TILE_P
    if (comp == 0) {
        float ss = 0.f;
#pragma unroll
        for (int i = 0; i < 16; ++i) { o0[i] = o0[i] * inv - lam * cmb[i * 64 + lane]; o1[i] = o1[i] * inv - lam * cmb[(16 + i) * 64 + lane]; ss += o0[i] * o0[i] + o1[i] * o1[i]; }
        ss = xor32_add(ss);
        const float rn = rsqrtf(ss * (1.0f / 64.0f) + RMS_EPS) * oscale;
        bf16* orow = mix + (tb + qb * 128 + ws * 32 + r32) * 1024 + 768 + h * 64;
#pragma unroll
        for (int g4 = 0; g4 < 4; ++g4) { const int e0 = 8 * g4 + 4 * hh;
            const f32x4 n0 = *(const f32x4*)(normg + e0), n1 = *(const f32x4*)(normg + 32 + e0);
            u32x2 w0, w1; w0.x = pk2(o0[4 * g4] * rn * n0[0], o0[4 * g4 + 1] * rn * n0[1]); w0.y = pk2(o0[4 * g4 + 2] * rn * n0[2], o0[4 * g4 + 3] * rn * n0[3]);
            w1.x = pk2(o1[4 * g4] * rn * n1[0], o1[4 * g4 + 1] * rn * n1[1]); w1.y = pk2(o1[4 * g4 + 2] * rn * n1[2], o1[4 * g4 + 3] * rn * n1[3]);
            *(u32x2*)(orow + e0) = w0; *(u32x2*)(orow + 32 + e0) = w1; }
    }
    __syncthreads();
}

__device__ __forceinline__ void conv_unit(const bf16* proj, bf16* mix, const float* cw, int t0) {
    const int tid = opaque_tid();
    const int c = 8 * (tid & 31), tg = tid >> 5;
    float w0[8], w1[8], w2[8];
#pragma unroll
    for (int i = 0; i < 8; ++i) { w0[i] = cw[c + i]; w1[i] = cw[256 + c + i]; w2[i] = cw[512 + c + i]; }
#pragma unroll
    for (int pass = 0; pass < 2; ++pass) {
        const int ts = t0 + pass * 64 + tg * 4, spos = ts & (SEQ - 1);
        float z[6][8];
#pragma unroll
        for (int r = 0; r < 6; ++r) {
            if (spos - 2 + r >= 0) { const bf16* p = proj + (size_t)(ts - 2 + r) * PP; const u32x4 u = *(const u32x4*)(p + C_CU + c), g = *(const u32x4*)(p + C_CGC + c);
                z[r][0] = bflo(u.x) * bflo(g.x); z[r][1] = bfhi(u.x) * bfhi(g.x); z[r][2] = bflo(u.y) * bflo(g.y); z[r][3] = bfhi(u.y) * bfhi(g.y);
                z[r][4] = bflo(u.z) * bflo(g.z); z[r][5] = bfhi(u.z) * bfhi(g.z); z[r][6] = bflo(u.w) * bflo(g.w); z[r][7] = bfhi(u.w) * bfhi(g.w); }
            else {
#pragma unroll
                for (int i = 0; i < 8; ++i) z[r][i] = 0.f; } }
#pragma unroll
        for (int r = 0; r < 4; ++r) { const u32x4 bb = *(const u32x4*)(proj + (size_t)(ts + r) * PP + C_CGB + c);
            const float g8[8] = {bflo(bb.x), bfhi(bb.x), bflo(bb.y), bfhi(bb.y), bflo(bb.z), bfhi(bb.z), bflo(bb.w), bfhi(bb.w)};
            float y[8];
#pragma unroll
            for (int i = 0; i < 8; ++i) y[i] = g8[i] * (w0[i] * z[r][i] + w1[i] * z[r + 1][i] + w2[i] * z[r + 2][i]);
            u32x4 o; o.x = pk2(y[0], y[1]); o.y = pk2(y[2], y[3]); o.z = pk2(y[4], y[5]); o.w = pk2(y[6], y[7]);
            *(u32x4*)(mix + (size_t)(ts + r) * 1024 + c) = o; }
    }
}

__device__ __forceinline__ void scan128(float& v0, float& v1, int lane) {
    float s = v0 + v1, inc = s;
#pragma unroll
    for (int o = 1; o < 64; o <<= 1) { const float t = shfl_from(inc, lane >= o ? lane - o : lane, lane); if (lane >= o) inc += t; }
    const float ex = inc - s; v0 = ex + v0; v1 = v0 + v1;
}

template <int ROWS, int NCOLS> struct TileRegs { static constexpr int CPR = NCOLS / 8, N = ROWS * CPR, IT = (N + NTHREADS - 1) / NTHREADS; u32x4 v[IT]; };
template <int ROWS, int NCOLS> __device__ __forceinline__ void tile_fetch(TileRegs<ROWS, NCOLS>& r, const bf16* src, int pitch, int tid) {
    typedef TileRegs<ROWS, NCOLS> TR;
#pragma unroll
    for (int i = 0; i < TR::IT; ++i) { int id = tid + NTHREADS * i; if (TR::N % NTHREADS != 0) id = id < TR::N ? id : TR::N - 1; const int row = id / TR::CPR, ch = id % TR::CPR; r.v[i] = *(const u32x4*)(src + (size_t)row * pitch + ch * 8); }
}
template <int NCOLS> __device__ __forceinline__ void conv_fetch(TileRegs<131, NCOLS>& r, const bf16* proj, int col, int t0, int tid) {
    typedef TileRegs<131, NCOLS> TR; const bool first = (t0 & (SEQ - 1)) == 0;
#pragma unroll
    for (int i = 0; i < TR::IT; ++i) { int id = tid + NTHREADS * i; id = id < TR::N ? id : TR::N - 1; const int row = id / TR::CPR, ch = id % TR::CPR; const bool z = first && row < 3;
        const u32x4 v = *(const u32x4*)(proj + (size_t)(t0 - 3 + (z ? 3 : row)) * PP + col + ch * 8); r.v[i] = z ? (u32x4){0u, 0u, 0u, 0u} : v; }
}
template <int ROWS, int NCOLS> __device__ __forceinline__ void tile_commit(const TileRegs<ROWS, NCOLS>& r, LAS unsigned char* dst, int dstride, int tid) {
    typedef TileRegs<ROWS, NCOLS> TR;
#pragma unroll
    for (int i = 0; i < TR::IT; ++i) { const int id = tid + NTHREADS * i; if (TR::N % NTHREADS == 0 || id < TR::N) { const int row = id / TR::CPR, ch = id % TR::CPR; *(LAS u32x4*)(dst + row * dstride + ch * 16) = r.v[i]; } }
}
struct ConvWin { float h0a, h0b, h1a, h1b, h2a, h2b; };
__device__ __forceinline__ void conv_win_init(ConvWin& w, const LAS unsigned char* tile, int stride, int col, int j0) {
    const unsigned u0 = *(const LAS unsigned*)(tile + j0 * stride + col * 2), u1 = *(const LAS unsigned*)(tile + (j0 + 1) * stride + col * 2), u2 = *(const LAS unsigned*)(tile + (j0 + 2) * stride + col * 2);
    w.h0a = bflo(u0); w.h0b = bfhi(u0); w.h1a = bflo(u1); w.h1b = bfhi(u1); w.h2a = bflo(u2); w.h2b = bfhi(u2);
}
__device__ __forceinline__ void conv_run(ConvWin& w, LAS unsigned char* tile, int stride, int col, int j0, int nj, const float* cw, const float* cb, int xc, const LAS float* sc, int scs) {
    const float w0a = cw[xc], w0b = cw[xc + 1], w1a = cw[768 + xc], w1b = cw[769 + xc], w2a = cw[1536 + xc], w2b = cw[1537 + xc], w3a = cw[2304 + xc], w3b = cw[2305 + xc];
    const float ba = cb[xc], bb = cb[xc + 1];
    unsigned raw[16];
#pragma unroll
    for (int i = 0; i < 16; ++i) raw[i] = *(const LAS unsigned*)(tile + (j0 + i + 3) * stride + col * 2);
#pragma unroll
    for (int i = 0; i < 16; ++i) { const int j = j0 + i;
        const unsigned u = raw[i]; const float xa = bflo(u), xb = bfhi(u);
        float ya = siluf(w0a * w.h0a + w1a * w.h1a + w2a * w.h2a + w3a * xa + ba), yb = siluf(w0b * w.h0b + w1b * w.h1b + w2b * w.h2b + w3b * xb + bb);
        if (sc) { const float f = sc[j * scs]; ya *= f; yb *= f; }
        *(LAS unsigned*)(tile + (j + 3) * stride + col * 2) = pk2(ya, yb);
        w.h0a = w.h1a; w.h0b = w.h1b; w.h1a = w.h2a; w.h1b = w.h2b; w.h2a = xa; w.h2b = xb; }
    (void)nj;
}

constexpr int SA_X = 0, SA_B = 69632, SA_DT = 139264, SA_SC = 141312, SA_OFF = 3 * 528;
__device__ __forceinline__ void ssd_a_unit(LAS unsigned char* lds, const Args& A, int l, const bf16* proj, int b, int ch) {
    const int tid = opaque_tid(), lane = tid & 63, wid = __builtin_amdgcn_readfirstlane(tid >> 6), r32 = lane & 31, hh = lane >> 5;
    const int t0 = b * SEQ + ch * 128;
    LAS float* dts = (LAS float*)(lds + SA_DT); LAS float* scs = (LAS float*)(lds + SA_SC);
    const float* alog = A.in[I_SSD_ALOG] + l * 4; const float* dtb = A.in[I_SSD_DTB] + l * 4;
    { TileRegs<131, 256> rx, rb; conv_fetch<256>(rx, proj, C_SX, t0, tid); conv_fetch<256>(rb, proj, C_SB, t0, tid);
      const unsigned short dt_raw = proj[(size_t)(t0 + (tid >> 2)) * PP + C_SDT + (tid & 3)];
      tile_commit<131, 256>(rx, lds + SA_X, 528, tid); tile_commit<131, 256>(rb, lds + SA_B, 528, tid);
      dts[(tid >> 2) * 4 + (tid & 3)] = softplusf(bf2f(dt_raw) + dtb[tid & 3]); }
    __syncthreads();
    ConvWin cwn[4];
#pragma unroll
    for (int k = 0; k < 4; ++k) { const int id = tid + NTHREADS * k, cp = id & 255, rg = id >> 8, xc = 2 * cp; conv_win_init(cwn[k], lds + (xc < 256 ? SA_X : SA_B), 528, xc & 255, rg * 16); }
    if (wid < 4) { const int hd = wid; const float a = -__expf(alog[hd]); const float d0 = dts[(2 * lane) * 4 + hd], d1 = dts[(2 * lane + 1) * 4 + hd];
        float c0 = d0 * a, c1 = d1 * a; scan128(c0, c1, lane);
        const float cl = shfl_from(c1, 63, lane);
        scs[(2 * lane) * 4 + hd] = d0 * __expf(cl - c0); scs[(2 * lane + 1) * 4 + hd] = d1 * __expf(cl - c1);
        if (lane == 0) ((float*)(A.ws + WS_SSDDEC))[(b * 16 + ch) * 4 + hd] = __expf(cl); }
    __syncthreads();
#pragma unroll
    for (int k = 0; k < 4; ++k) { const int id = tid + NTHREADS * k, cp = id & 255, rg = id >> 8, xc = 2 * cp;
        conv_run(cwn[k], lds + (xc < 256 ? SA_X : SA_B), 528, xc & 255, rg * 16, 16, A.in[I_SSD_CW] + l * 4 * 768, A.in[I_SSD_CB] + l * 768, xc, xc < 256 ? scs + (xc >> 6) : nullptr, 4); }
    __syncthreads();
    { const int hd = wid >> 1, tp = wid & 1, g = hd >> 1;
      const LAS unsigned char* Xd = lds + SA_X + SA_OFF; const LAS unsigned char* Bd = lds + SA_B + SA_OFF;
      f32x16 acc[4] = {ZERO16, ZERO16, ZERO16, ZERO16};
#pragma unroll 2
      for (int ks = 0; ks < 8; ++ks) { const bf16x8 a = fragT(Xd, 528, ks * 16, hd * 64 + tp * 32, lane);
#pragma unroll
          for (int tn = 0; tn < 4; ++tn) acc[tn] = MFMA32(a, fragT(Bd, 528, ks * 16, g * 128 + tn * 32, lane), acc[tn]); }
      float* st = (float*)(A.ws + A_ST) + ((size_t)((b * 16 + ch) * 4 + hd)) * 8192;
#pragma unroll
      for (int tn = 0; tn < 4; ++tn)
#pragma unroll
          for (int i = 0; i < 16; ++i) st[(tp * 32 + crow(i, hh)) * 128 + tn * 32 + r32] = acc[tn][i]; }
    __syncthreads();
}

__device__ __forceinline__ void gla_cum(const LAS unsigned char* lrs, LAS float* cum, const float* wlr, const float* blr, int tid) {
    LAS float* tot = cum + 64 * 128;
    const int col = tid & 127, seg = tid >> 7;
    float c16[16];
    { float w[16];
#pragma unroll
      for (int r = 0; r < 16; ++r) w[r] = wlr[r * 128 + col];
      const float bias = blr[col]; float run = 0.f;
#pragma unroll
      for (int i = 0; i < 16; ++i) { const int j = seg * 16 + i; const u32x4 a = *(const LAS u32x4*)(lrs + j * 48), c = *(const LAS u32x4*)(lrs + j * 48 + 16);
          float d = bias;
          d += bflo(a.x) * w[0] + bfhi(a.x) * w[1] + bflo(a.y) * w[2] + bfhi(a.y) * w[3] + bflo(a.z) * w[4] + bfhi(a.z) * w[5] + bflo(a.w) * w[6] + bfhi(a.w) * w[7];
          d += bflo(c.x) * w[8] + bfhi(c.x) * w[9] + bflo(c.y) * w[10] + bfhi(c.y) * w[11] + bflo(c.z) * w[12] + bfhi(c.z) * w[13] + bflo(c.w) * w[14] + bfhi(c.w) * w[15];
          run += logsigmoidf(d) * (1.0f / 16.0f); c16[i] = run; }
      tot[seg * 128 + col] = run; }
    __syncthreads();
    { float off = 0.f;
#pragma unroll
      for (int q = 0; q < 3; ++q) off += (q < seg) ? tot[q * 128 + col] : 0.f;
#pragma unroll
      for (int i = 0; i < 16; ++i) cum[(seg * 16 + i) * 128 + col] = c16[i] + off; }
    __syncthreads();
}
constexpr int GA_LR = 0, GA_K = 3072, GA_V = 20480, GA_CUM = 54272;
__device__ __forceinline__ void gla_a_unit(LAS unsigned char* lds, const Args& A, int l, const bf16* proj, int b, int ch) {
    const int tid = opaque_tid(), lane = tid & 63, wid = __builtin_amdgcn_readfirstlane(tid >> 6), r32 = lane & 31, hh = lane >> 5;
    const size_t t0 = (size_t)b * SEQ + ch * 64;
    LAS float* cum = (LAS float*)(lds + GA_CUM);
    { TileRegs<64, 16> rl; TileRegs<64, 128> rk; TileRegs<64, 256> rv;
      tile_fetch<64, 16>(rl, proj + t0 * PP + C_GLR, PP, tid); tile_fetch<64, 128>(rk, proj + t0 * PP + C_GK, PP, tid); tile_fetch<64, 256>(rv, proj + t0 * PP + C_GV, PP, tid);
      tile_commit<64, 16>(rl, lds + GA_LR, 48, tid); tile_commit<64, 128>(rk, lds + GA_K, 272, tid); tile_commit<64, 256>(rv, lds + GA_V, 528, tid); }
    __syncthreads();
    gla_cum(lds + GA_LR, cum, A.in[I_GLA_WLR] + l * 16 * 128, A.in[I_GLA_BLR] + l * 128, tid);
    if (tid < 128) ((float*)(A.ws + WS_GLACL))[(b * 32 + ch) * 128 + tid] = cum[63 * 128 + tid];
    for (int id = tid; id < 64 * 64; id += NTHREADS) { const int j = id >> 6, c = (id & 63) * 2;
        LAS unsigned* p = (LAS unsigned*)(lds + GA_K + j * 272 + c * 2); const unsigned u = *p;
        *p = pk2(bflo(u) * __expf(cum[63 * 128 + c] - cum[j * 128 + c]), bfhi(u) * __expf(cum[63 * 128 + c + 1] - cum[j * 128 + c + 1])); }
    __syncthreads();
    { const int h = wid >> 1, te = wid & 1; f32x16 acc = ZERO16;
#pragma unroll
      for (int ks = 0; ks < 4; ++ks) acc = MFMA32(fragT(lds + GA_K, 272, ks * 16, h * 32, lane), fragT(lds + GA_V, 528, ks * 16, h * 64 + te * 32, lane), acc);
      float* ds = (float*)(A.ws + A_DST) + ((size_t)((b * 32 + ch) * 4 + h)) * 2048;
#pragma unroll
      for (int i = 0; i < 16; ++i) ds[crow(i, hh) * 64 + te * 32 + r32] = acc[i]; }
    __syncthreads();
}
constexpr int SM_X = 816, SM_B = 35840 + 816, SM_C = 71680 + 816, SM_S = 107520, SM_DT = 142336, SM_CUM = 143360, SM_RED = 144384;
__device__ __forceinline__ void ssd_main_unit(LAS unsigned char* lds, const Args& A, int l, const bf16* proj, bf16* mix, int b, int ch, int g) {
    const int tid = opaque_tid(), lane = tid & 63, wid = __builtin_amdgcn_readfirstlane(tid >> 6), r32 = lane & 31, hh = lane >> 5;
    const int t0 = b * SEQ + ch * 128;
    LAS float* dts = (LAS float*)(lds + SM_DT); LAS float* cums = (LAS float*)(lds + SM_CUM); LAS float* red = (LAS float*)(lds + SM_RED);
    TileRegs<128, 128> rz;
    const unsigned short dt_raw = proj[(size_t)(t0 + ((tid & 255) >> 1)) * PP + C_SDT + 2 * g + (tid & 1)];
    { const bf16* sp = (const bf16*)(A.ws + A_SP) + ((size_t)((b * 16 + ch) * 4 + 2 * g)) * 8192;
      TileRegs<128, 128> rs; TileRegs<131, 128> rx, rb, rc;
      tile_fetch<128, 128>(rs, sp, 128, tid);
      conv_fetch<128>(rx, proj, C_SX + g * 128, t0, tid); conv_fetch<128>(rb, proj, C_SB + g * 128, t0, tid); conv_fetch<128>(rc, proj, C_SC + g * 128, t0, tid);
      tile_fetch<128, 128>(rz, proj + (size_t)t0 * PP + C_SZ + g * 128, PP, tid);
      tile_commit<128, 128>(rs, lds + SM_S, 272, tid);
      tile_commit<131, 128>(rx, lds + SM_X - 816, 272, tid); tile_commit<131, 128>(rb, lds + SM_B - 816, 272, tid); tile_commit<131, 128>(rc, lds + SM_C - 816, 272, tid); }
    if (tid < 256) { const int j = tid >> 1, r = tid & 1; dts[j * 2 + r] = softplusf(bf2f(dt_raw) + A.in[I_SSD_DTB][l * 4 + 2 * g + r]); }
    __syncthreads();
    if (wid < 2) { const int r = wid; const float a = -__expf(A.in[I_SSD_ALOG][l * 4 + 2 * g + r]); float c0 = dts[(2 * lane) * 2 + r] * a, c1 = dts[(2 * lane + 1) * 2 + r] * a; scan128(c0, c1, lane);
        cums[(2 * lane) * 2 + r] = c0; cums[(2 * lane + 1) * 2 + r] = c1; }
    { ConvWin cwn[3];
#pragma unroll
      for (int k = 0; k < 3; ++k) { const int id = tid + NTHREADS * k, cp = id % 192, rg = id / 192, c2 = 2 * cp, sel = c2 >> 7, cc = c2 & 127;
          conv_win_init(cwn[k], lds + (sel == 0 ? SM_X : sel == 1 ? SM_B : SM_C) - 816, 272, cc, rg * 16); }
      __syncthreads();
#pragma unroll
      for (int k = 0; k < 3; ++k) { const int id = tid + NTHREADS * k, cp = id % 192, rg = id / 192, c2 = 2 * cp, sel = c2 >> 7, cc = c2 & 127;
          conv_run(cwn[k], lds + (sel == 0 ? SM_X : sel == 1 ? SM_B : SM_C) - 816, 272, cc, rg * 16, 16, A.in[I_SSD_CW] + l * 4 * 768, A.in[I_SSD_CB] + l * 768, sel * 256 + g * 128 + cc, nullptr, 0); } }
    __syncthreads();
    const int ti = wid & 3, tp = wid >> 2;
    f32x16 cb0 = ZERO16, cb1 = ZERO16, of0 = ZERO16, of1 = ZERO16;
#pragma unroll 2
    for (int ks = 0; ks < 8; ++ks) { const bf16x8 cf = fragN(lds + SM_C, 272, ti * 32, ks * 16, lane);
        cb0 = MFMA32(fragN(lds + SM_B, 272, (2 * tp) * 32, ks * 16, lane), cf, cb0); cb1 = MFMA32(fragN(lds + SM_B, 272, (2 * tp + 1) * 32, ks * 16, lane), cf, cb1);
        of0 = MFMA32(fragN(lds + SM_S, 272, tp * 32, ks * 16, lane), cf, of0); of1 = MFMA32(fragN(lds + SM_S + 17408, 272, tp * 32, ks * 16, lane), cf, of1); }
    __syncthreads();
    const int irow = ti * 32 + r32;
    f32x16 dg[2] = {ZERO16, ZERO16};
#pragma unroll
    for (int r = 0; r < 2; ++r) {
        const float ci = cums[irow * 2 + r];
#pragma unroll
        for (int s = 0; s < 2; ++s) { const f32x16& cbv = s ? cb1 : cb0; const int jb = (2 * tp + s) * 32;
#pragma unroll
            for (int g4 = 0; g4 < 4; ++g4) { float w[4];
#pragma unroll
                for (int e = 0; e < 4; ++e) { const int j = jb + 8 * g4 + 4 * hh + e; w[e] = (j <= irow) ? cbv[4 * g4 + e] * __expf(ci - cums[j * 2 + r]) * dts[j * 2 + r] : 0.f; }
                u32x2 o; o.x = pk2(w[0], w[1]); o.y = pk2(w[2], w[3]); *(LAS u32x2*)(lds + SM_B + irow * 272 + (jb + 8 * g4 + 4 * hh) * 2) = o; } }
        __syncthreads();
#pragma unroll 2
        for (int ks = 0; ks < 8; ++ks) dg[r] = MFMA32(fragT(lds + SM_X, 272, ks * 16, r * 64 + tp * 32, lane), fragN(lds + SM_B, 272, ti * 32, ks * 16, lane), dg[r]);
        __syncthreads();
    }
    tile_commit<128, 128>(rz, lds + SM_B, 272, tid);
    __syncthreads();
    float ss = 0.f;
#pragma unroll
    for (int r = 0; r < 2; ++r) { const float ec = __expf(cums[irow * 2 + r]), dsk = A.in[I_SSD_D][l * 4 + 2 * g + r]; const f32x16& ofv = r ? of1 : of0;
#pragma unroll
        for (int g4 = 0; g4 < 4; ++g4) { const int col = r * 64 + tp * 32 + 8 * g4 + 4 * hh;
            const u32x2 xu = *(const LAS u32x2*)(lds + SM_X + irow * 272 + col * 2), zu = *(const LAS u32x2*)(lds + SM_B + irow * 272 + col * 2);
            const float xv[4] = {bflo(xu.x), bfhi(xu.x), bflo(xu.y), bfhi(xu.y)}, zv[4] = {bflo(zu.x), bfhi(zu.x), bflo(zu.y), bfhi(zu.y)};
#pragma unroll
            for (int e = 0; e < 4; ++e) { const int i = 4 * g4 + e; const float y = (dg[r][i] + ec * ofv[i] + dsk * xv[e]) * siluf(zv[e]); dg[r][i] = y; ss += y * y; } } }
    ss = xor32_add(ss);
    if (hh == 0) red[tp * 128 + irow] = ss;
    __syncthreads();
    const float rn = rsqrtf((red[irow] + red[128 + irow]) * (1.0f / 128.0f) + RMS_EPS);
    const float* ng = A.in[I_SSD_NG] + l * 256 + g * 128;
    bf16* orow = mix + (size_t)(t0 + irow) * 1024 + 512 + g * 128;
#pragma unroll
    for (int r = 0; r < 2; ++r)
#pragma unroll
        for (int g4 = 0; g4 < 4; ++g4) { const int c0 = r * 64 + tp * 32 + 8 * g4 + 4 * hh; const f32x4 nv = *(const f32x4*)(ng + c0);
            u32x2 o; o.x = pk2(dg[r][4 * g4] * rn * nv[0], dg[r][4 * g4 + 1] * rn * nv[1]); o.y = pk2(dg[r][4 * g4 + 2] * rn * nv[2], dg[r][4 * g4 + 3] * rn * nv[3]);
            *(u32x2*)(orow + c0) = o; }
    __syncthreads();
}

constexpr int GM_LR = 0, GM_Q = 3072, GM_K = 20480, GM_V = 37888, GM_E = 71680, GM_S = 108544;
__device__ __forceinline__ void gla_main_unit(LAS unsigned char* lds, const Args& A, int l, const bf16* proj, bf16* mix, int b, int ch) {
    const int tid = opaque_tid(), lane = tid & 63, wid = __builtin_amdgcn_readfirstlane(tid >> 6), r32 = lane & 31, hh = lane >> 5;
    const size_t t0 = (size_t)b * SEQ + ch * 64;
    LAS float* cum = (LAS float*)(lds + GM_E);
    TileRegs<64, 256> rg;
    { TileRegs<64, 16> rl; TileRegs<64, 128> rq, rk; TileRegs<64, 256> rv; TileRegs<128, 64> rs;
      tile_fetch<64, 16>(rl, proj + t0 * PP + C_GLR, PP, tid); tile_fetch<64, 128>(rq, proj + t0 * PP + C_GQ, PP, tid); tile_fetch<64, 128>(rk, proj + t0 * PP + C_GK, PP, tid);
      tile_fetch<64, 256>(rv, proj + t0 * PP + C_GV, PP, tid);
      tile_fetch<128, 64>(rs, (const bf16*)(A.ws + A_GP) + ((size_t)(b * 32 + ch) * 4) * 2048, 64, tid);
      tile_fetch<64, 256>(rg, proj + t0 * PP + C_GG, PP, tid);
      tile_commit<64, 16>(rl, lds + GM_LR, 48, tid); tile_commit<64, 128>(rq, lds + GM_Q, 272, tid); tile_commit<64, 128>(rk, lds + GM_K, 272, tid);
      tile_commit<64, 256>(rv, lds + GM_V, 528, tid); tile_commit<128, 64>(rs, lds + GM_S, 144, tid); }
    __syncthreads();
    gla_cum(lds + GM_LR, cum, A.in[I_GLA_WLR] + l * 16 * 128, A.in[I_GLA_BLR] + l * 128, tid);
    for (int id = tid; id < 64 * 64; id += NTHREADS) { const int j = id >> 6, c = (id & 63) * 2; const float c0 = cum[j * 128 + c], c1 = cum[j * 128 + c + 1];
        LAS unsigned* qp = (LAS unsigned*)(lds + GM_Q + j * 272 + c * 2); LAS unsigned* kp = (LAS unsigned*)(lds + GM_K + j * 272 + c * 2); const unsigned qu = *qp, ku = *kp;
        *qp = pk2(bflo(qu) * 0.17677669529663687f * __expf(c0), bfhi(qu) * 0.17677669529663687f * __expf(c1));
        *kp = pk2(bflo(ku) * __expf(-c0), bfhi(ku) * __expf(-c1)); }
    __syncthreads();
    const int h = wid >> 1, ti = wid & 1, irow = ti * 32 + r32;
    { f32x16 a0 = ZERO16, a1 = ZERO16;
#pragma unroll
      for (int ks = 0; ks < 2; ++ks) { const bf16x8 qf = fragN(lds + GM_Q, 272, ti * 32, h * 32 + ks * 16, lane);
          a0 = MFMA32(fragN(lds + GM_K, 272, 0, h * 32 + ks * 16, lane), qf, a0); a1 = MFMA32(fragN(lds + GM_K, 272, 32, h * 32 + ks * 16, lane), qf, a1); }
      LAS unsigned char* ar = lds + GM_E + h * 9216 + irow * 144;
#pragma unroll
      for (int g4 = 0; g4 < 4; ++g4) { float w0[4], w1[4];
#pragma unroll
          for (int e = 0; e < 4; ++e) { const int j = 8 * g4 + 4 * hh + e; w0[e] = (j <= irow) ? a0[4 * g4 + e] : 0.f; w1[e] = (j + 32 <= irow) ? a1[4 * g4 + e] : 0.f; }
          u32x2 o0, o1; o0.x = pk2(w0[0], w0[1]); o0.y = pk2(w0[2], w0[3]); o1.x = pk2(w1[0], w1[1]); o1.y = pk2(w1[2], w1[3]);
          *(LAS u32x2*)(ar + (8 * g4 + 4 * hh) * 2) = o0; *(LAS u32x2*)(ar + (32 + 8 * g4 + 4 * hh) * 2) = o1; } }
    __syncthreads();
    f32x16 o[2] = {ZERO16, ZERO16};
#pragma unroll
    for (int te = 0; te < 2; ++te) {
#pragma unroll
        for (int ks = 0; ks < 4; ++ks) o[te] = MFMA32(fragT(lds + GM_V, 528, ks * 16, h * 64 + te * 32, lane), fragN(lds + GM_E + h * 9216, 144, ti * 32, ks * 16, lane), o[te]);
#pragma unroll
        for (int ks = 0; ks < 2; ++ks) o[te] = MFMA32(fragT(lds + GM_S + h * 4608, 144, ks * 16, te * 32, lane), fragN(lds + GM_Q, 272, ti * 32, h * 32 + ks * 16, lane), o[te]); }
    __syncthreads();
    tile_commit<64, 256>(rg, lds + GM_V, 528, tid);
    __syncthreads();
    { float ss = 0.f;
#pragma unroll
      for (int i = 0; i < 16; ++i) ss += o[0][i] * o[0][i] + o[1][i] * o[1][i];
      ss = xor32_add(ss);
      const float rn = rsqrtf(ss * (1.0f / 64.0f) + RMS_EPS);
      const float* ng = A.in[I_GLA_NG] + l * 64;
      bf16* orow = mix + (t0 + irow) * 1024 + 256 + h * 64;
#pragma unroll
      for (int te = 0; te < 2; ++te)
#pragma unroll
          for (int g4 = 0; g4 < 4; ++g4) { const int e0 = te * 32 + 8 * g4 + 4 * hh; const f32x4 nv = *(const f32x4*)(ng + e0);
              const u32x2 gz = *(const LAS u32x2*)(lds + GM_V + irow * 528 + (h * 64 + e0) * 2);
              u32x2 w; w.x = pk2(o[te][4 * g4] * rn * nv[0] * siluf(bflo(gz.x)), o[te][4 * g4 + 1] * rn * nv[1] * siluf(bfhi(gz.x)));
              w.y = pk2(o[te][4 * g4 + 2] * rn * nv[2] * siluf(bflo(gz.y)), o[te][4 * g4 + 3] * rn * nv[3] * siluf(bfhi(gz.y)));
              *(u32x2*)(orow + e0) = w; } }
    __syncthreads();
}

__device__ __forceinline__ void scan_phase(const Args& A, int gtid, int gthreads) {
    for (int gi = gtid; gi < NB * 4 * 2048; gi += gthreads) {
        const int bh = gi >> 11, b = bh >> 2, h = bh & 3, i4 = (gi & 2047) * 4;
        const float* st = (const float*)(A.ws + A_ST) + ((size_t)(b * 16) * 4 + h) * 8192 + i4;
        const float* dec = (const float*)(A.ws + WS_SSDDEC) + (b * 16) * 4 + h;
        bf16* sp = (bf16*)(A.ws + A_SP) + ((size_t)(b * 16) * 4 + h) * 8192 + i4;
        f32x4 v[16];
#pragma unroll
        for (int c = 0; c < 16; ++c) v[c] = *(const f32x4*)(st + (size_t)c * 4 * 8192);
        f32x4 s = {0.f, 0.f, 0.f, 0.f};
#pragma unroll
        for (int c = 0; c < 16; ++c) { u32x2 o; o.x = pk2(s[0], s[1]); o.y = pk2(s[2], s[3]); *(u32x2*)(sp + (size_t)c * 4 * 8192) = o; s = s * dec[c * 4] + v[c]; }
    }
    for (int gi = gtid; gi < NB * 4 * 2048; gi += gthreads) {
        const int bh = gi >> 11, b = bh >> 2, h = bh & 3, idx = gi & 2047, d = idx >> 6;
        const float* ds = (const float*)(A.ws + A_DST) + ((size_t)(b * 32) * 4 + h) * 2048 + idx;
        const float* cl = (const float*)(A.ws + WS_GLACL) + (size_t)(b * 32) * 128 + h * 32 + d;
        bf16* gp = (bf16*)(A.ws + A_GP) + ((size_t)(b * 32) * 4 + h) * 2048 + idx;
        float v[32], dc[32];
#pragma unroll
        for (int c = 0; c < 32; ++c) { v[c] = ds[(size_t)c * 4 * 2048]; dc[c] = cl[c * 128]; }
        float s = 0.f;
#pragma unroll
        for (int c = 0; c < 32; ++c) { gp[(size_t)c * 4 * 2048] = f2bf(s); s = s * __expf(dc[c]) + v[c]; }
    }
}
constexpr int R4_W = 0, R4_WS = 99072, R4_G = 124672, R4_B = 128768, R4_HIST = 132864, R4_CS = 132992, R4_ASG = 133376;
__device__ __forceinline__ void p4_route(LAS unsigned char* lds, const Args& A, int l, int blk) {
    const int tid = opaque_tid(), lane = tid & 63, wid = __builtin_amdgcn_readfirstlane(tid >> 6);
    const bf16* v = (const bf16*)(A.ws + A_V); bf16* x1 = (bf16*)(A.ws + A_X1);
    { const bf16* wrt = (const bf16*)(A.ws + WS_WRT + l * WRT_LAYER);
      { TileRegs<48, 1024> rt; tile_fetch<48, 1024>(rt, wrt, 1024, tid); tile_commit<48, 1024>(rt, lds + R4_W, 2064, tid); }
      LAS float* gs = (LAS float*)(lds + R4_G); LAS float* bs = (LAS float*)(lds + R4_B);
      for (int k = tid; k < 1024; k += NTHREADS) { gs[k] = A.in[I_LN1G][l * 1024 + k]; bs[k] = A.in[I_LN1B][l * 1024 + k]; }
      if (tid < 32) ((LAS int*)(lds + R4_HIST))[tid] = 0;
      if (tid < 96) ((LAS float*)(lds + R4_CS))[tid] = ((const float*)(A.ws + WS_RCS + l * WRT_LAYER))[tid]; }
    __syncthreads();
    const int tok0 = blk * 128 + wid * 16, fr = lane & 15, fq = lane >> 4;
    LAS float* stat = (LAS float*)(lds + R4_WS + wid * 3200); LAS float* lg = stat + 32;
    const LAS float* cs = (const LAS float*)(lds + R4_CS);
    pg8::f32x4 acc[3] = {{0.f, 0.f, 0.f, 0.f}, {0.f, 0.f, 0.f, 0.f}, {0.f, 0.f, 0.f, 0.f}};
    float s1 = 0.f, s2 = 0.f;
    const bf16* vrow = v + (size_t)(tok0 + fr) * 1024 + 8 * fq;
#pragma unroll 8
    for (int s = 0; s < 32; ++s) {
        const u32x4 au = *(const u32x4*)(vrow + 32 * s); const bf16x8 a = __builtin_bit_cast(bf16x8, au);
#pragma unroll
        for (int bk = 0; bk < 3; ++bk) { const bf16x8 bfr = *(const LAS bf16x8*)(lds + R4_W + (bk * 16 + fr) * 2064 + (32 * s + 8 * fq) * 2);
            acc[bk] = __builtin_amdgcn_mfma_f32_16x16x32_bf16(a, bfr, acc[bk], 0, 0, 0); }
        const float e0 = bflo(au.x), e1 = bfhi(au.x), e2 = bflo(au.y), e3 = bfhi(au.y), e4 = bflo(au.z), e5 = bfhi(au.z), e6 = bflo(au.w), e7 = bfhi(au.w);
        s1 += ((e0 + e1) + (e2 + e3)) + ((e4 + e5) + (e6 + e7));
        s2 += ((e0 * e0 + e1 * e1) + (e2 * e2 + e3 * e3)) + ((e4 * e4 + e5 * e5) + (e6 * e6 + e7 * e7));
    }
    s1 += shflx(s1, 16, lane); s1 = xor32_add(s1); s2 += shflx(s2, 16, lane); s2 = xor32_add(s2);
    { const float mean = s1 * (1.0f / 1024.0f), var = fmaxf(s2 * (1.0f / 1024.0f) - mean * mean, 0.f), rstd = rsqrtf(var + LN_EPS);
      if (lane < 16) { stat[2 * lane] = mean; stat[2 * lane + 1] = rstd; f32x2 mr; mr.x = mean; mr.y = rstd; ((f32x2*)(A.ws + WS_LNSTAT))[tok0 + lane] = mr; } }
#pragma unroll
    for (int r = 0; r < 4; ++r) { const int tk = 4 * fq + r; const float mean = stat[2 * tk], rstd = stat[2 * tk + 1];
#pragma unroll
        for (int bk = 0; bk < 3; ++bk) { const int j = bk * 16 + fr; lg[tk * 48 + j] = rstd * (acc[bk][r] - mean * cs[j]) + cs[48 + j]; } }
    if (lane < 16) {
        const LAS float* q = lg + lane * 48;
        int grp = 0; float gm = q[0];
#pragma unroll
        for (int i = 1; i < 4; ++i) if (q[i] > gm) { gm = q[i]; grp = i; }
        float gsum = 0.f;
#pragma unroll
        for (int i = 0; i < 4; ++i) gsum += __expf(q[i] - gm);
        const float pg = 1.0f / gsum;
        float el[8];
#pragma unroll
        for (int i = 0; i < 8; ++i) el[i] = q[4 + grp * 8 + i];
        int i1 = 0; float m1 = el[0];
#pragma unroll
        for (int i = 1; i < 8; ++i) if (el[i] > m1) { m1 = el[i]; i1 = i; }
        int i2 = -1; float m2 = -INFINITY;
#pragma unroll
        for (int i = 0; i < 8; ++i) if (i != i1 && el[i] > m2) { m2 = el[i]; i2 = i; }
        const float p2 = __expf(m2 - m1), den = 1.0f / (1.0f + p2);
        const int tokn = tok0 + lane, ex1 = grp * 8 + i1, ex2 = grp * 8 + i2;
        LAS int* hist = (LAS int*)(lds + R4_HIST);
        const int r1 = atomicAdd((int*)(hist + ex1), 1), r2 = atomicAdd((int*)(hist + ex2), 1);
        LAS int* ae = (LAS int*)(lds + R4_ASG); LAS float* ag = (LAS float*)(lds + R4_ASG + 1024); LAS int* ar = (LAS int*)(lds + R4_ASG + 2048); const int lt = wid * 16 + lane; (void)tokn;
        ae[2 * lt] = ex1; ae[2 * lt + 1] = ex2; ag[2 * lt] = pg * den; ag[2 * lt + 1] = pg * p2 * den; ar[2 * lt] = r1; ar[2 * lt + 1] = r2;
    }
    __syncthreads();
    if (tid < NSLOT_MAX / 256) ((int*)(A.ws + WS_SLOTTOK))[blk * (NSLOT_MAX / 256) + tid] = 0;
    if (tid < 32) ((int*)(A.ws + WS_WGCNT))[blk * 32 + tid] = ((LAS int*)(lds + R4_HIST))[tid];
    asm volatile("s_waitcnt vmcnt(0)" ::: "memory"); __syncthreads();
    unsigned* pubcnt = (unsigned*)(A.ws + WS_BAR + 14336) + l * 64;
    if (tid == 0) { __builtin_amdgcn_fence(__ATOMIC_RELEASE, "agent"); asm volatile("s_waitcnt vmcnt(0)" ::: "memory"); __hip_atomic_fetch_add(pubcnt, 1u, __ATOMIC_RELAXED, __HIP_MEMORY_SCOPE_AGENT); }
    { const LAS float* gs = (const LAS float*)(lds + R4_G); const LAS float* bs = (const LAS float*)(lds + R4_B); unsigned char* x8 = A.ws + A_X8;
      for (int tk0 = 0; tk0 < 16; tk0 += 8) {
          u32x4 uu[8][2];
#pragma unroll
          for (int q = 0; q < 8; ++q)
#pragma unroll
              for (int i = 0; i < 2; ++i) uu[q][i] = *(const u32x4*)(v + (size_t)(tok0 + tk0 + q) * 1024 + (lane + 64 * i) * 8);
#pragma unroll
          for (int q = 0; q < 8; ++q) { const int tk = tk0 + q; const float mean = stat[2 * tk], rstd = stat[2 * tk + 1];
#pragma unroll
              for (int i = 0; i < 2; ++i) { const int k0 = (lane + 64 * i) * 8; const u32x4 u = uu[q][i];
                  const f32x4 ga = *(const LAS f32x4*)(gs + k0), gb = *(const LAS f32x4*)(gs + k0 + 4), ba = *(const LAS f32x4*)(bs + k0), bb = *(const LAS f32x4*)(bs + k0 + 4);
                  const float y0 = (bflo(u.x) - mean) * rstd * ga[0] + ba[0], y1 = (bfhi(u.x) - mean) * rstd * ga[1] + ba[1], y2 = (bflo(u.y) - mean) * rstd * ga[2] + ba[2], y3 = (bfhi(u.y) - mean) * rstd * ga[3] + ba[3];
                  const float y4 = (bflo(u.z) - mean) * rstd * gb[0] + bb[0], y5 = (bfhi(u.z) - mean) * rstd * gb[1] + bb[1], y6 = (bflo(u.w) - mean) * rstd * gb[2] + bb[2], y7 = (bfhi(u.w) - mean) * rstd * gb[3] + bb[3];
                  u32x4 o; o.x = pk2(y0, y1); o.y = pk2(y2, y3); o.z = pk2(y4, y5); o.w = pk2(y6, y7);
                  if (!MOE_FP8) *(u32x4*)(x1 + (size_t)(tok0 + tk) * 1024 + k0) = o;
                  if (MOE_FP8) { u32x2 qv; qv.x = pg8::pk4_fp8(8.f * y0, 8.f * y1, 8.f * y2, 8.f * y3); qv.y = pg8::pk4_fp8(8.f * y4, 8.f * y5, 8.f * y6, 8.f * y7); *(u32x2*)(x8 + (size_t)(tok0 + tk) * 1024 + k0) = qv; } } } } }
    if (tid == 0) { unsigned sp = 0; while (__hip_atomic_load(pubcnt, __ATOMIC_RELAXED, __HIP_MEMORY_SCOPE_AGENT) < (unsigned)gridDim.x) { __builtin_amdgcn_s_sleep(2); if (++sp > (1u << 22)) break; }
        __builtin_amdgcn_fence(__ATOMIC_ACQUIRE, "agent"); asm volatile("s_waitcnt vmcnt(0)" ::: "memory"); }
    __syncthreads();
    LAS int* base = (LAS int*)lds;
    const int* wgc = (const int*)(A.ws + WS_WGCNT);
    LAS int* part_tot = base + 128; LAS int* part_bef = part_tot + 512;
    { const int e = tid & 31, part = tid >> 5; int tot = 0, before = 0;
#pragma unroll
      for (int i = 0; i < 16; ++i) { const int w = part * 16 + i; const int c = __hip_atomic_load(wgc + w * 32 + e, __ATOMIC_RELAXED, __HIP_MEMORY_SCOPE_AGENT); tot += c; before += (w < blk) ? c : 0; }
      part_tot[part * 32 + e] = tot; part_bef[part * 32 + e] = before; }
    __syncthreads();
    if (tid < 32) {
        int tot = 0, before = 0;
#pragma unroll
        for (int p = 0; p < 16; ++p) { tot += part_tot[p * 32 + tid]; before += part_bef[p * 32 + tid]; }
        const int padded = (tot + 255) & ~255;
        int inc = padded;
#pragma unroll
        for (int o = 1; o < 32; o <<= 1) { const int t = __builtin_amdgcn_ds_bpermute((lane >= o ? lane - o : lane) << 2, inc); if (lane >= o) inc += t; }
        const int start = inc - padded;
        base[tid] = start + before;
        if (blk == 0) { int* be = (int*)(A.ws + WS_BLKEXP); for (int k = 0; k < (padded >> 8); ++k) be[(start >> 8) + k] = tid; be[NBLK_MAX + 1 + tid] = start >> 8; if (tid == 31) { be[NBLK_MAX] = inc >> 8; be[NBLK_MAX + 33] = inc >> 8; } }
    }
    __syncthreads();
    if (tid < 256) { const LAS int* ae = (const LAS int*)(lds + R4_ASG); const LAS float* ag = (const LAS float*)(lds + R4_ASG + 1024); const LAS int* ar = (const LAS int*)(lds + R4_ASG + 2048);
        const int a = blk * 256 + tid; const int slot = base[ae[tid]] + ar[tid]; ((int*)(A.ws + WS_SLOTOF))[a] = slot; ((float*)(A.ws + WS_SLOTGATE))[slot] = ag[tid]; ((int*)(A.ws + WS_SLOTTOK))[slot] = blk * 128 + (tid >> 1); }
    __syncthreads();
}

#ifndef P8_NT
#define P8_NT 4
#endif
__device__ __forceinline__ void p8_ln2(const Args& A, int l, bool last, int gw, int ngw, int lane) {
    const bf16* x1 = (const bf16*)(A.ws + A_X1); const bf16* Y = (const bf16*)(A.ws + A_Y); const int* so = (const int*)(A.ws + WS_SLOTOF);
    bf16* xb = (bf16*)(A.ws + A_XB);
    const float* g2 = A.in[I_LN2G] + l * 1024; const float* b2 = A.in[I_LN2B] + l * 1024;
    f32x4 gv[4], bv[4];
#pragma unroll
    for (int i = 0; i < 2; ++i) { const int k0 = (lane + 64 * i) * 8; gv[2 * i] = *(const f32x4*)(g2 + k0); gv[2 * i + 1] = *(const f32x4*)(g2 + k0 + 4); bv[2 * i] = *(const f32x4*)(b2 + k0); bv[2 * i + 1] = *(const f32x4*)(b2 + k0 + 4); }
    const bf16* v = (const bf16*)(A.ws + A_V); const f32x2* lnst = (const f32x2*)(A.ws + WS_LNSTAT);
    f32x4 g1v[4], b1v[4];
#pragma unroll
    for (int i = 0; i < 2; ++i) { const int k0 = (lane + 64 * i) * 8; const float* g1 = A.in[I_LN1G] + l * 1024; const float* b1 = A.in[I_LN1B] + l * 1024;
        g1v[2 * i] = *(const f32x4*)(g1 + k0) * ALPHA; g1v[2 * i + 1] = *(const f32x4*)(g1 + k0 + 4) * ALPHA; b1v[2 * i] = *(const f32x4*)(b1 + k0) * ALPHA; b1v[2 * i + 1] = *(const f32x4*)(b1 + k0 + 4) * ALPHA; }
    static_assert(MOE_FP8, "p8_ln2 reads the fp8 expert outputs"); (void)x1;
    constexpr int NT = P8_NT;
    for (int tb = gw; tb < T; tb += NT * ngw) {
        int s0[NT], s1[NT]; f32x2 mr[NT]; u32x4 av[NT][2]; u32x2 ya[NT][2], yc[NT][2];
#pragma unroll
        for (int n = 0; n < NT; ++n) { const int t = min(tb + n * ngw, T - 1); s0[n] = so[2 * t]; s1[n] = so[2 * t + 1]; mr[n] = lnst[t];
#pragma unroll
            for (int i = 0; i < 2; ++i) av[n][i] = *(const u32x4*)(v + (size_t)t * 1024 + (lane + 64 * i) * 8); }
#pragma unroll
        for (int n = 0; n < NT; ++n)
#pragma unroll
            for (int i = 0; i < 2; ++i) { const int k0 = (lane + 64 * i) * 8; const unsigned char* Y8 = (const unsigned char*)Y; ya[n][i] = *(const u32x2*)(Y8 + (size_t)s0[n] * 1024 + k0); yc[n][i] = *(const u32x2*)(Y8 + (size_t)s1[n] * 1024 + k0); }
#pragma unroll
        for (int n = 0; n < NT; ++n) { const int t = tb + n * ngw; if (t < T) {
        float x[16]; float sum = 0.f;
#pragma unroll
        for (int i = 0; i < 2; ++i) { const u32x4 a = av[n][i]; const u32x2 y0 = ya[n][i], y1 = yc[n][i];
                typedef float f32x2_ __attribute__((ext_vector_type(2)));
                const f32x2_ a0 = __builtin_amdgcn_cvt_pk_f32_fp8(y0.x, false), a1 = __builtin_amdgcn_cvt_pk_f32_fp8(y0.x, true), a2 = __builtin_amdgcn_cvt_pk_f32_fp8(y0.y, false), a3 = __builtin_amdgcn_cvt_pk_f32_fp8(y0.y, true);
                const f32x2_ b0 = __builtin_amdgcn_cvt_pk_f32_fp8(y1.x, false), b1 = __builtin_amdgcn_cvt_pk_f32_fp8(y1.x, true), b2 = __builtin_amdgcn_cvt_pk_f32_fp8(y1.y, false), b3 = __builtin_amdgcn_cvt_pk_f32_fp8(y1.y, true);
                const float ys = 1.0f / 64.0f;
                const float mean = mr[n].x, rstd = mr[n].y; const f32x4 ga = g1v[2 * i], gb = g1v[2 * i + 1], ba = b1v[2 * i], bb = b1v[2 * i + 1];
                x[8 * i + 0] = ((bflo(a.x) - mean) * rstd * ga[0] + ba[0]) + (a0[0] + b0[0]) * ys; x[8 * i + 1] = ((bfhi(a.x) - mean) * rstd * ga[1] + ba[1]) + (a0[1] + b0[1]) * ys;
                x[8 * i + 2] = ((bflo(a.y) - mean) * rstd * ga[2] + ba[2]) + (a1[0] + b1[0]) * ys; x[8 * i + 3] = ((bfhi(a.y) - mean) * rstd * ga[3] + ba[3]) + (a1[1] + b1[1]) * ys;
                x[8 * i + 4] = ((bflo(a.z) - mean) * rstd * gb[0] + bb[0]) + (a2[0] + b2[0]) * ys; x[8 * i + 5] = ((bfhi(a.z) - mean) * rstd * gb[1] + bb[1]) + (a2[1] + b2[1]) * ys;
                x[8 * i + 6] = ((bflo(a.w) - mean) * rstd * gb[2] + bb[2]) + (a3[0] + b3[0]) * ys; x[8 * i + 7] = ((bfhi(a.w) - mean) * rstd * gb[3] + bb[3]) + (a3[1] + b3[1]) * ys; }
#pragma unroll
        for (int u = 0; u < 16; ++u) sum += x[u];
        const float mean = wave_sum(sum, lane) * (1.0f / 1024.0f); float sq = 0.f;
#pragma unroll
        for (int u = 0; u < 16; ++u) { x[u] -= mean; sq += x[u] * x[u]; }
        const float rstd = rsqrtf(wave_sum(sq, lane) * (1.0f / 1024.0f) + LN_EPS);
#pragma unroll
        for (int i = 0; i < 2; ++i) { const int k0 = (lane + 64 * i) * 8;
            float o[8];
#pragma unroll
            for (int u = 0; u < 4; ++u) { o[u] = x[8 * i + u] * rstd * gv[2 * i][u] + bv[2 * i][u]; o[4 + u] = x[8 * i + 4 + u] * rstd * gv[2 * i + 1][u] + bv[2 * i + 1][u]; }
            if (last) { float* op = A.out + (size_t)t * 1024 + k0; *(f32x4*)op = (f32x4){o[0], o[1], o[2], o[3]}; *(f32x4*)(op + 4) = (f32x4){o[4], o[5], o[6], o[7]}; }
            else { u32x4 w; w.x = pk2(o[0], o[1]); w.y = pk2(o[2], o[3]); w.z = pk2(o[4], o[5]); w.w = pk2(o[6], o[7]); *(u32x4*)(xb + (size_t)t * 1024 + k0) = w; } }
        } }
    }
}
constexpr int LDS_ST = LDS_BYTES - 64;
#ifndef USE_CG_SYNC
#define SYNC() xcd_barrier(xbar)
#else
#define SYNC() grid.sync()
#endif
#ifndef SKIP_MASK
#define SKIP_MASK 0
#endif
#define ON(k) (!((SKIP_MASK) & (1 << (k))))
#ifndef DUP_PHASE
#define DUP_PHASE -1
#endif
#ifndef DUP_SUB
#define DUP_SUB -1
#endif
#define REPS(k) for (int reps_ = 0; reps_ < ((DUP_SUB) == (k) ? 2 : 1); ++reps_)
#define REP(k) for (int rep_ = 0; rep_ < ((DUP_PHASE) == (k) ? 2 : 1); ++rep_)
__global__ void __launch_bounds__(NTHREADS, 2) fwd_kernel(Args A) {
    extern __shared__ __attribute__((aligned(16))) unsigned char lds_raw[];
    LAS unsigned char* lds = (LAS unsigned char*)lds_raw;
#ifdef USE_CG_SYNC
    cg::grid_group grid = cg::this_grid();
#endif
    const int G = gridDim.x, bx = blockIdx.x, vcu = (G % 8 == 0) ? (bx % 8) * (G / 8) + bx / 8 : bx;
    const int ngw = G * NWAVES;
#define WAVE_IDS() const int tid = opaque_tid(), lane = tid & 63, wave = __builtin_amdgcn_readfirstlane(tid >> 6), gw = bx * NWAVES + wave; (void)tid; (void)lane; (void)gw
    unsigned char* ws = A.ws;
    if (threadIdx.x < 16) ((LAS unsigned*)(lds + LDS_ST))[threadIdx.x] = 0u;
    __syncthreads();
    XcdBarrier xbar = xcd_barrier_post((unsigned*)(ws + WS_BAR), (volatile LAS unsigned*)(lds + LDS_ST));
    bf16* xb = (bf16*)(ws + A_XB); bf16* proj = (bf16*)(ws + A_PROJ); bf16* mix = (bf16*)(ws + A_MIX); bf16* vbuf = (bf16*)(ws + A_V);
    bf16* hb = (bf16*)(ws + A_H); bf16* yb = (bf16*)(ws + A_Y);

    REP(0) if (ON(10)) { WAVE_IDS(); convert_weights(A, 0, lds, gw, ngw, wave, lane, 0, CV_IT_IN, true);
      convert_x(A, bx * NTHREADS + tid, G * NTHREADS); }
    SYNC();

    static_assert(DEPTH == 2 && W_END - WS_W <= (size_t)T * D * 4, "layer 1's weights live in the output buffer");
    for (int l = 0; l < DEPTH; ++l) {
        REP(1) { pg8::Gemm g{xb, (const bf16*)(wbuf(A, l) + (W_WIN - WS_W)), T, PP, 1024}; pg8::StaticOrder S; S.init(T, PP, G, bx); pg8::EpiStore E{proj, PP};
          const int kx = (l == 0) ? ((bx >> 3) & 7) : 0;
          for (int part = 0; part < 2; ++part) {
              if (part == 0) { S.i0 = 0; S.ni = kx; } else { S.i0 = kx; S.ni = 1 << 30; }
              pg8::gemm_phase<pg8::EpiStore, pg8::StaticOrder, true, true>(lds, g, S, E);
              if (part == 0 && l == 0) { WAVE_IDS(); __syncthreads(); convert_weights(A, 0, lds, gw, ngw, wave, lane, CV_IT_IN, CV_NIT, false); convert_weights(A, 1, lds, gw, ngw, wave, lane, 0, CV_NIT, true); __syncthreads(); } } }
        SYNC();
        REP(2) { const float lam_init = (l == 0) ? 0.2f : 0.35550907f, lam = ((const float*)(ws + WS_LAM))[l];
          const bool attn_first = ((bx >> 3) & 1) != 0;
          for (int ps = 0; ps < 2; ++ps) {
          if ((ps == 1) == attn_first) {
          REPS(0) if (ON(0)) for (int u = vcu; u < 256; u += G) ssd_a_unit(lds, A, l, proj, u >> 4, u & 15);
          REPS(1) if (ON(1)) for (int u = vcu; u < 512; u += G) gla_a_unit(lds, A, l, proj, u >> 5, u & 31);
          REPS(2) if (ON(2)) for (int u = vcu; u < 256; u += G) conv_unit(proj, mix, A.in[I_CONVW] + l * 768, u * 128);
          } else {
          REPS(3) if (ON(3)) { u32x4 qn[2] = {{0u, 0u, 0u, 0u}, {0u, 0u, 0u, 0u}}; bool first = true;
              for (int p = vcu; p < 512; p += G) { const int bh = p >> 3, s = p & 7; const bool more = p + G < 512; const int nbh = (p + G) >> 3, ns = (p + G) & 7;
                  attn_unit(lds, proj, mix, bh >> 2, bh & 3, 15 - s, lam, A.in[I_DIFF_NG] + l * 64, 1.0f - lam_init, first, bh >> 2, bh & 3, s, qn); first = false;
                  attn_unit(lds, proj, mix, bh >> 2, bh & 3, s, lam, A.in[I_DIFF_NG] + l * 64, 1.0f - lam_init, false, more ? nbh >> 2 : bh >> 2, more ? nbh & 3 : bh & 3, more ? 15 - ns : -1, qn); } }
          } } }
        SYNC();
        REP(11) if (ON(6)) { const int tid = opaque_tid(); scan_phase(A, bx * NTHREADS + tid, G * NTHREADS); }
        SYNC();
        REP(3) { const bool gla_first = ((bx >> 3) & 1) != 0;
          for (int ps = 0; ps < 2; ++ps) {
            if ((ps == 1) == gla_first) { REPS(4) if (ON(4)) for (int u = vcu; u < 512; u += G) ssd_main_unit(lds, A, l, proj, mix, u >> 5, (u >> 1) & 15, u & 1); }
            else { REPS(5) if (ON(5)) for (int u = vcu; u < 512; u += G) gla_main_unit(lds, A, l, proj, mix, u >> 5, u & 31); } } }
        SYNC();
        REP(4) { pg8::Gemm g{mix, (const bf16*)(wbuf(A, l) + (W_WO - WS_W)), T, 1024, 1024}; pg8::StaticOrder S; S.init(T, 1024, G, bx); pg8::EpiRes E{vbuf, xb, 1024, ALPHA};
          pg8::gemm_phase<pg8::EpiRes, pg8::StaticOrder, true, true>(lds, g, S, E); }
        SYNC();
        REP(5) if (ON(7)) for (int blk = bx; blk < 256; blk += G) p4_route(lds, A, l, blk);
        SYNC();
        const int nblk = ((const int*)(ws + WS_BLKEXP))[NBLK_MAX];
        REP(7) { if (MOE_FP8) { pg8::Gemm g{(const bf16*)(ws + A_X8), (const bf16*)(wbuf(A, l) + (W_WGU - WS_W)), NSLOT_MAX, NEXP * 1024, 512}; pg8::MoeOrder S; S.init((const int*)(ws + WS_BLKEXP), G, bx); S.ready = (unsigned*)(ws + WS_RDY) + (size_t)l * NBLK_MAX * 64; S.mode = 1; pg8::EpiSwiglu8 E{(unsigned char*)hb};
            pg8::gemm_phase_gather<pg8::EpiSwiglu8, pg8::MoeOrder, true>(lds, g, (const int*)(ws + WS_SLOTTOK), S, E); }
          else { pg8::Gemm g{(const bf16*)(ws + A_X1), (const bf16*)(wbuf(A, l) + (W_WGU - WS_W)), NSLOT_MAX, NEXP * 1024, 1024}; pg8::MoeOrder S; S.init((const int*)(ws + WS_BLKEXP), G, bx); pg8::EpiSwiglu E{hb};
            pg8::gemm_phase_gather<pg8::EpiSwiglu, pg8::MoeOrder, false>(lds, g, (const int*)(ws + WS_SLOTTOK), S, E); } }
        if (!MOE_FP8) SYNC();
        REP(8) { pg8::Gemm g{hb, (const bf16*)(wbuf(A, l) + (W_WD - WS_W)), NSLOT_MAX, NEXP * 1024, MOE_FP8 ? 256 : 512}; pg8::MoeOrder S; S.init((const int*)(ws + WS_BLKEXP), G, bx);
          if (MOE_FP8) { S.ready = (unsigned*)(ws + WS_RDY) + (size_t)l * NBLK_MAX * 64; S.mode = 2; pg8::EpiDown8 E{(unsigned char*)yb, (const float*)(ws + WS_SLOTGATE), 0.00390625f}; pg8::gemm_phase<pg8::EpiDown8, pg8::MoeOrder, true, true, true>(lds, g, S, E); }
          else { pg8::EpiDown E{yb, (const float*)(ws + WS_SLOTGATE), 1.0f}; pg8::gemm_phase<pg8::EpiDown, pg8::MoeOrder, true, true, false>(lds, g, S, E); } }
        SYNC();
        REP(9) if (ON(9)) { WAVE_IDS(); p8_ln2(A, l, l == DEPTH - 1, gw, ngw, lane); }
        if (l + 1 < DEPTH) SYNC();
    }
}

extern "C" void kernel_launch(void* const* d_in, const int* in_sizes, int n_in, void* d_out, int out_size, void* d_ws, size_t ws_size, hipStream_t stream) {
    static int grid = 0;
    if (grid == 0) {
        if (n_in != N_IN || in_sizes[0] != T * D || out_size != T * D || ws_size < WS_NEED) { fprintf(stderr, "kernel_launch: unexpected shapes (n_in %d, ws %zu < %zu)\n", n_in, ws_size, (size_t)WS_NEED); grid = -1; return; }
        int dev = 0, cus = 0, per_cu = 0;
        (void)hipGetDevice(&dev); (void)hipDeviceGetAttribute(&cus, hipDeviceAttributeMultiprocessorCount, dev);
        if (hipFuncSetAttribute((const void*)fwd_kernel, hipFuncAttributeMaxDynamicSharedMemorySize, LDS_BYTES) != hipSuccess) { fprintf(stderr, "kernel_launch: hipFuncSetAttribute failed\n"); }
        (void)hipOccupancyMaxActiveBlocksPerMultiprocessor(&per_cu, (const void*)fwd_kernel, NTHREADS, LDS_BYTES);
        (void)hipGetLastError();
        grid = (cus >= 256 && per_cu >= 1) ? 256 : -1;
        if (grid < 0) { fprintf(stderr, "kernel_launch: needs 256 CUs with one resident workgroup each (CUs %d, blocks per CU %d)\n", cus, per_cu); return; }
    }
    if (grid < 0) return;
    if (hipMemsetAsync((char*)d_ws + WS_BAR, 0, 16384 + (size_t)DEPTH * NBLK_MAX * 256, stream) != hipSuccess) { fprintf(stderr, "kernel_launch: memset failed\n"); return; }
    Args a{};
    for (int i = 0; i < N_IN; ++i) a.in[i] = (const float*)d_in[i];
    a.out = (float*)d_out; a.ws = (unsigned char*)d_ws;
    void* args[] = {&a};
    const hipError_t e = hipLaunchCooperativeKernel((const void*)fwd_kernel, dim3(grid), dim3(NTHREADS), args, LDS_BYTES, stream);
    if (e != hipSuccess) fprintf(stderr, "kernel_launch: cooperative launch failed: %s (grid %d)\n", hipGetErrorString(e), grid);
}
```

```cpp
#include <hip/hip_runtime.h>
#include <hip/hip_cooperative_groups.h>
#include <cstdio>
#include <cstdint>
namespace cg = cooperative_groups;
namespace pg8 {
#define PG8_LAS __attribute__((address_space(3)))
typedef unsigned short bf16_t;
typedef short bf16x8 __attribute__((ext_vector_type(8)));
typedef float f32x4 __attribute__((ext_vector_type(4)));
typedef unsigned u32x4 __attribute__((ext_vector_type(4)));
constexpr int BM = 256, BK = 64, HALF = 128, HTB = HALF * BK * 2  , STAGE_BYTES = 8 * HTB, NXCD = 8, WGM = 8;

__host__ __device__ __forceinline__ int lds_byte(int r, int c) { const int st = (r >> 4) * 2 + (c >> 5), rr = r & 15, cc = c & 31, ob = rr * 64 + cc * 2; return st * 1024 + (ob ^ (((ob >> 9) & 1) << 5)); }
__host__ __device__ __forceinline__ void stage_rc(int b, int& R, int& C) { const int st = b / 1024, sb = b % 1024, swz = sb ^ (((sb >> 9) & 1) << 5); R = (st >> 1) * 16 + swz / 64; C = (st & 1) * 32 + (swz % 64) / 2; }
__host__ __device__ __forceinline__ int perm32(int rho) { const int n = rho >> 4, i = rho & 15; return 8 * (i >> 2) + 4 * n + (i & 3); }

struct Unit { int pm, pn; };
struct Gemm { const bf16_t* A; const bf16_t* Bt; int M, N, K; };
__device__ __forceinline__ unsigned cvt_pk_bf16(float lo, float hi) { unsigned r; asm volatile("v_cvt_pk_bf16_f32 %0, %1, %2" : "=v"(r) : "v"(lo), "v"(hi)); return r; }
struct StaticOrder {
    int nM, nN, nwg, G, c; int i0 = 0, ni = 1 << 30;
    __host__ __device__ void init(int M, int N, int G_, int c_) { nM = M / BM; nN = N / BM; nwg = nM * nN; G = G_; c = c_; }
    __host__ __device__ bool next(int i, Unit& u) const {
        const long L = (long)(i + i0) * G + c; if (i >= ni || L >= nwg) return false;
        int wgid = (int)L; { const int q = nwg / NXCD, r = nwg % NXCD, xcd = wgid % NXCD, off = wgid / NXCD; wgid = (xcd < r ? xcd * (q + 1) : r * (q + 1) + (xcd - r) * q) + off; }
        const int nig = WGM * nN, gid = wgid / nig, fm = gid * WGM, gsz = (nM - fm) < WGM ? (nM - fm) : WGM;
        u.pm = fm + ((wgid % nig) % gsz); u.pn = (wgid % nig) / gsz; return true;
    }
    __device__ __forceinline__ void a_ready(const Unit&) const {}
    __device__ __forceinline__ void done(const Unit&) const {}
};
typedef unsigned u32x2 __attribute__((ext_vector_type(2)));
__device__ __forceinline__ float bf_lo(unsigned w) { return __uint_as_float(w << 16); }
__device__ __forceinline__ float bf_hi(unsigned w) { return __uint_as_float(w & 0xffff0000u); }
__device__ __forceinline__ float silu_f(float x) { return x * __builtin_amdgcn_rcpf(1.0f + __builtin_amdgcn_exp2f(-1.4426950408889634f * x)); }

struct EpiStore {
    static constexpr bool PERM = true, AFTER_DRAIN = false;
    bf16_t* O; int ldc;
    __device__ __forceinline__ void operator()(const f32x4 (&acc)[2][2][4][2], const Unit& u, int wr, int wc, int fr, int fq) const {
        const int row0 = u.pm * BM + wr * 64 + fr, col0 = u.pn * BM + wc * 32 + 8 * fq;
#pragma unroll
        for (int ai = 0; ai < 2; ++ai)
#pragma unroll
            for (int m = 0; m < 4; ++m) { bf16_t* rowp = O + (size_t)(row0 + ai * HALF + m * 16) * ldc + col0;
#pragma unroll
                for (int bj = 0; bj < 2; ++bj) { const f32x4 v0 = acc[ai][bj][m][0], v1 = acc[ai][bj][m][1];
                    u32x4 w; w.x = cvt_pk_bf16(v0[0], v0[1]); w.y = cvt_pk_bf16(v0[2], v0[3]); w.z = cvt_pk_bf16(v1[0], v1[1]); w.w = cvt_pk_bf16(v1[2], v1[3]);
                    *(u32x4*)(rowp + bj * HALF) = w; } }
    }
};
struct EpiRes {
    static constexpr bool PERM = true, AFTER_DRAIN = false;
    bf16_t* O; const bf16_t* R; int ldc; float alpha;
    __device__ __forceinline__ void operator()(const f32x4 (&acc)[2][2][4][2], const Unit& u, int wr, int wc, int fr, int fq) const {
        const int row0 = u.pm * BM + wr * 64 + fr, col0 = u.pn * BM + wc * 32 + 8 * fq;
        u32x4 rr[2][4][2];
#pragma unroll
        for (int ai = 0; ai < 2; ++ai)
#pragma unroll
            for (int m = 0; m < 4; ++m)
#pragma unroll
                for (int bj = 0; bj < 2; ++bj) rr[ai][m][bj] = *(const u32x4*)(R + (size_t)(row0 + ai * HALF + m * 16) * ldc + col0 + bj * HALF);
#pragma unroll
        for (int ai = 0; ai < 2; ++ai)
#pragma unroll
            for (int m = 0; m < 4; ++m) { const size_t off = (size_t)(row0 + ai * HALF + m * 16) * ldc + col0;
#pragma unroll
                for (int bj = 0; bj < 2; ++bj) { const f32x4 v0 = acc[ai][bj][m][0], v1 = acc[ai][bj][m][1];
                    const u32x4 r = rr[ai][m][bj];
                    u32x4 w; w.x = cvt_pk_bf16(alpha * bf_lo(r.x) + v0[0], alpha * bf_hi(r.x) + v0[1]); w.y = cvt_pk_bf16(alpha * bf_lo(r.y) + v0[2], alpha * bf_hi(r.y) + v0[3]);
                    w.z = cvt_pk_bf16(alpha * bf_lo(r.z) + v1[0], alpha * bf_hi(r.z) + v1[1]); w.w = cvt_pk_bf16(alpha * bf_lo(r.w) + v1[2], alpha * bf_hi(r.w) + v1[3]);
                    *(u32x4*)(O + off + bj * HALF) = w; } }
    }
};
__device__ __forceinline__ float clamp448(float x) { return __builtin_fminf(__builtin_fmaxf(x, -448.f), 448.f); }
__device__ __forceinline__ unsigned pk4_fp8(float a, float b, float c, float d) { unsigned w = 0; w = __builtin_amdgcn_cvt_pk_fp8_f32(clamp448(a), clamp448(b), w, false); w = __builtin_amdgcn_cvt_pk_fp8_f32(clamp448(c), clamp448(d), w, true); return w; }
struct EpiSwiglu8 {
    static constexpr bool PERM = true, AFTER_DRAIN = false;
    unsigned char* H; bool local;
    __device__ __forceinline__ void operator()(const f32x4 (&acc)[2][2][4][2], const Unit& u, int wr, int wc, int fr, int fq) const {
        const int row0 = u.pm * BM + wr * 64 + fr, col0 = (u.pn & 3) * HALF + wc * 32 + 8 * fq, odd = fq & 1; const float si = 0.001953125f, so = 4.0f * 0.001953125f;
#pragma unroll
        for (int ai = 0; ai < 2; ++ai)
#pragma unroll
            for (int mp = 0; mp < 4; mp += 2) { u32x2 w[2];
#pragma unroll
                for (int q = 0; q < 2; ++q) { const int m = mp + q;
                    const f32x4 g0 = acc[ai][0][m][0] * si, g1 = acc[ai][0][m][1] * si, u0 = acc[ai][1][m][0] * so, u1 = acc[ai][1][m][1] * so;
                    w[q].x = pk4_fp8(silu_f(g0[0]) * u0[0], silu_f(g0[1]) * u0[1], silu_f(g0[2]) * u0[2], silu_f(g0[3]) * u0[3]);
                    w[q].y = pk4_fp8(silu_f(g1[0]) * u1[0], silu_f(g1[1]) * u1[1], silu_f(g1[2]) * u1[2], silu_f(g1[3]) * u1[3]); }
                const auto sx = __builtin_amdgcn_permlane16_swap(w[0].x, w[1].x, false, false), sy = __builtin_amdgcn_permlane16_swap(w[0].y, w[1].y, false, false);
                u32x4 o; o.x = sx[0]; o.y = sy[0]; o.z = sx[1]; o.w = sy[1];
                const unsigned char* p = H + (size_t)(row0 + ai * HALF + (mp + odd) * 16) * 512 + col0 - 8 * odd;
                if (local) asm volatile("global_store_dwordx4 %0, %1, off\n\ts_nop 3" :: "v"(p), "v"(o) : "memory"); else asm volatile("global_store_dwordx4 %0, %1, off sc1\n\ts_nop 3" :: "v"(p), "v"(o) : "memory"); }
    }
};
struct EpiSwiglu {
    static constexpr bool PERM = true, AFTER_DRAIN = false;
    bf16_t* H;
    __device__ __forceinline__ void operator()(const f32x4 (&acc)[2][2][4][2], const Unit& u, int wr, int wc, int fr, int fq) const {
        const int row0 = u.pm * BM + wr * 64 + fr, col0 = (u.pn & 3) * HALF + wc * 32 + 8 * fq;
#pragma unroll
        for (int ai = 0; ai < 2; ++ai)
#pragma unroll
            for (int m = 0; m < 4; ++m) { bf16_t* rowp = H + (size_t)(row0 + ai * HALF + m * 16) * 512 + col0;
                const f32x4 g0 = acc[ai][0][m][0], g1 = acc[ai][0][m][1], u0 = acc[ai][1][m][0], u1 = acc[ai][1][m][1];
                u32x4 w; w.x = cvt_pk_bf16(silu_f(g0[0]) * u0[0], silu_f(g0[1]) * u0[1]); w.y = cvt_pk_bf16(silu_f(g0[2]) * u0[2], silu_f(g0[3]) * u0[3]);
                w.z = cvt_pk_bf16(silu_f(g1[0]) * u1[0], silu_f(g1[1]) * u1[1]); w.w = cvt_pk_bf16(silu_f(g1[2]) * u1[2], silu_f(g1[3]) * u1[3]);
                *(u32x4*)rowp = w; }
    }
};
struct EpiDown {
    static constexpr bool PERM = true, AFTER_DRAIN = false;
    bf16_t* Y; const float* gate; float oscale;
    __device__ __forceinline__ void operator()(const f32x4 (&acc)[2][2][4][2], const Unit& u, int wr, int wc, int fr, int fq) const {
        const int row0 = u.pm * BM + wr * 64 + fr, col0 = (u.pn & 3) * BM + wc * 32 + 8 * fq;
#pragma unroll
        for (int ai = 0; ai < 2; ++ai)
#pragma unroll
            for (int m = 0; m < 4; ++m) { const int row = row0 + ai * HALF + m * 16; const float gt = gate[row] * oscale; bf16_t* rowp = Y + (size_t)row * 1024 + col0;
#pragma unroll
                for (int bj = 0; bj < 2; ++bj) { const f32x4 v0 = acc[ai][bj][m][0] * gt, v1 = acc[ai][bj][m][1] * gt;
                    u32x4 w; w.x = cvt_pk_bf16(v0[0], v0[1]); w.y = cvt_pk_bf16(v0[2], v0[3]); w.z = cvt_pk_bf16(v1[0], v1[1]); w.w = cvt_pk_bf16(v1[2], v1[3]);
                    *(u32x4*)(rowp + bj * HALF) = w; } }
    }
};
struct EpiDown8 {
    static constexpr bool PERM = true, AFTER_DRAIN = false;
    unsigned char* Y; const float* gate; float oscale;
    __device__ __forceinline__ void operator()(const f32x4 (&acc)[2][2][4][2], const Unit& u, int wr, int wc, int fr, int fq) const {
        const int row0 = u.pm * BM + wr * 64 + fr, col0 = (u.pn & 3) * BM + wc * 32 + 8 * fq;
        float gts[2][4];
#pragma unroll
        for (int ai = 0; ai < 2; ++ai)
#pragma unroll
            for (int m = 0; m < 4; ++m) gts[ai][m] = gate[row0 + ai * HALF + m * 16];
        const int odd = fq & 1;
#pragma unroll
        for (int ai = 0; ai < 2; ++ai)
#pragma unroll
            for (int mp = 0; mp < 4; mp += 2)
#pragma unroll
                for (int bj = 0; bj < 2; ++bj) { u32x2 w[2];
#pragma unroll
                    for (int q = 0; q < 2; ++q) { const float gt = gts[ai][mp + q] * oscale * 64.0f; const f32x4 v0 = acc[ai][bj][mp + q][0] * gt, v1 = acc[ai][bj][mp + q][1] * gt;
                        w[q].x = pk4_fp8(v0[0], v0[1], v0[2], v0[3]); w[q].y = pk4_fp8(v1[0], v1[1], v1[2], v1[3]); }
                    const auto sx = __builtin_amdgcn_permlane16_swap(w[0].x, w[1].x, false, false), sy = __builtin_amdgcn_permlane16_swap(w[0].y, w[1].y, false, false);
                    u32x4 o; o.x = sx[0]; o.y = sy[0]; o.z = sx[1]; o.w = sy[1];
                    *(u32x4*)(Y + (size_t)(row0 + ai * HALF + (mp + odd) * 16) * 1024 + col0 - 8 * odd + bj * HALF) = o; }
    }
};
struct MoeOrder {
    const int* blk_expert; int b0, nu, j, nj;
    __device__ __forceinline__ void init(const int* be, int G, int c) {
        blk_expert = be; const int x = c & 7; nj = G >> 3; j = c >> 3;
        if ((G & 7) == 0) { const int nb = be[288]; b0 = (x * nb) >> 3; nu = 4 * ((((x + 1) * nb) >> 3) - b0); }
        else { b0 = 0; nu = 4 * be[288]; nj = G; j = c; }
    }
    __device__ __forceinline__ bool next(int i, Unit& u) const {
        const int L = i * nj + j; if (L >= nu) return false;
        const int blk = b0 + (L >> 2); u.pm = blk; u.pn = blk_expert[blk] * 4 + (L & 3); return true;
    }
    unsigned* ready = nullptr; int mode = 0;
    unsigned rmask = 0;
    __device__ __forceinline__ void a_ready(const Unit& u) const {
        if (mode == 2 && !((rmask >> ((((u.pm - b0) << 2) + (u.pn & 3) - j) / nj)) & 1u)) {
            if (threadIdx.x < 64) { unsigned sp = 0;
                while ((unsigned)__builtin_amdgcn_readfirstlane((int)__hip_atomic_load(ready + 64 * u.pm, __ATOMIC_RELAXED, __HIP_MEMORY_SCOPE_AGENT)) < 32u) { __builtin_amdgcn_s_sleep(2); if (++sp > (1u << 22)) break; }
                __builtin_amdgcn_fence(__ATOMIC_ACQUIRE, "agent"); asm volatile("s_waitcnt vmcnt(0)" ::: "memory"); }
            asm volatile("" ::: "memory"); __builtin_amdgcn_s_barrier(); asm volatile("" ::: "memory");
        }
    }
    __device__ __forceinline__ void done(const Unit& u) const {
        if (mode == 1) { asm volatile("s_waitcnt vmcnt(0)" ::: "memory"); if ((threadIdx.x & 63) == 0) __hip_atomic_fetch_add(ready + 64 * u.pm, 1u, __ATOMIC_RELAXED, __HIP_MEMORY_SCOPE_AGENT); }
    }
};
typedef int i32x8 __attribute__((ext_vector_type(8)));
__device__ __forceinline__ i32x8 cat16(bf16x8 a, bf16x8 b) { const u32x4 x = __builtin_bit_cast(u32x4, a), y = __builtin_bit_cast(u32x4, b); return (i32x8){(int)x.x, (int)x.y, (int)x.z, (int)x.w, (int)y.x, (int)y.y, (int)y.z, (int)y.w}; }
template <class Epi, class Sched, bool ALIGN_EPI = false, bool SP2 = false, bool FP8 = false>
__device__ __forceinline__ void gemm_phase(PG8_LAS unsigned char* lds, const Gemm g, const Sched& S, const Epi& E) {
    int tid_o_ = threadIdx.x; asm volatile("" : "+v"(tid_o_)); const int tid = tid_o_, wid = __builtin_amdgcn_readfirstlane(tid >> 6), lane = tid & 63, wr = wid >> 2, wc = wid & 3, fr = lane & 15, fq = lane >> 4;
    const int K = g.K, nt = K / BK;
    unsigned voffA[2], voffB[2];
#pragma unroll
    for (int i = 0; i < 2; ++i) { int R, C; stage_rc(tid * 16 + i * 8192, R, C); const int Rb = Epi::PERM ? ((R & ~31) + perm32(R & 31)) : R;
        voffA[i] = (unsigned)(R * K + C) * 2u; voffB[i] = (unsigned)(Rb * K + C) * 2u; }
    const size_t kstep = (size_t)(BK * 2);
    const size_t hstep = (size_t)HALF * K * 2;
    const size_t tstep = 2 * hstep;
    const unsigned ldsw = (unsigned)wid * 1024u;
    const int aoff = lds_byte(wr * 64 + fr, fq * 8), boff = lds_byte(wc * 32 + fr, fq * 8);
#define PG8_SA(b, h) (((b) * 2 + (h)) * HTB)
#define PG8_SB(b, h) ((4 + (b) * 2 + (h)) * HTB)
#define PG8_STAGE(bufoff, gbase, voff) do { _Pragma("unroll") for (int _i = 0; _i < 2; ++_i) \
        __builtin_amdgcn_global_load_lds((const unsigned*)((const char*)(gbase) + (voff)[_i]), (PG8_LAS unsigned*)(lds + (bufoff) + ldsw + _i * 8192), 16, 0, 0); } while (0)
#define PG8_LDA(dst, b, h) do { if constexpr (FP8) { _Pragma("unroll") for (int m = 0; m < 4; ++m) dst##_8[m] = cat16(*(const PG8_LAS bf16x8*)(lds + PG8_SA(b, h) + aoff + m * 2048), *(const PG8_LAS bf16x8*)(lds + PG8_SA(b, h) + aoff + m * 2048 + 1024)); } \
        else { _Pragma("unroll") for (int m = 0; m < 4; ++m) _Pragma("unroll") for (int k = 0; k < 2; ++k) dst[m][k] = *(const PG8_LAS bf16x8*)(lds + PG8_SA(b, h) + aoff + m * 2048 + k * 1024); } } while (0)
#define PG8_LDB(dst, b, h) do { if constexpr (FP8) { _Pragma("unroll") for (int n = 0; n < 2; ++n) dst##_8[n] = cat16(*(const PG8_LAS bf16x8*)(lds + PG8_SB(b, h) + boff + n * 2048), *(const PG8_LAS bf16x8*)(lds + PG8_SB(b, h) + boff + n * 2048 + 1024)); } \
        else { _Pragma("unroll") for (int n = 0; n < 2; ++n) _Pragma("unroll") for (int k = 0; k < 2; ++k) dst[n][k] = *(const PG8_LAS bf16x8*)(lds + PG8_SB(b, h) + boff + n * 2048 + k * 1024); } } while (0)
#define PG8_MMA(ai, bj, At, Bt) do { __builtin_amdgcn_s_setprio(1); \
        if constexpr (FP8) { _Pragma("unroll") for (int m = 0; m < 4; ++m) _Pragma("unroll") for (int n = 0; n < 2; ++n) \
            asm volatile("s_nop 1\n\tv_mfma_scale_f32_16x16x128_f8f6f4 %0, %1, %2, %0, %3, %3 op_sel_hi:[0,0,0]" : "+v"(acc[ai][bj][m][n]) : "v"(Bt##_8[n]), "v"(At##_8[m]), "v"(sc1_)); } \
        else { _Pragma("unroll") for (int m = 0; m < 4; ++m) _Pragma("unroll") for (int n = 0; n < 2; ++n) _Pragma("unroll") for (int k = 0; k < 2; ++k) \
            acc[ai][bj][m][n] = __builtin_amdgcn_mfma_f32_16x16x32_bf16(Bt[n][k], At[m][k], acc[ai][bj][m][n], 0, 0, 0); } \
        __builtin_amdgcn_s_setprio(0); } while (0)
#define PG8_WAIT_V(n) asm volatile("s_waitcnt vmcnt(" #n ")" ::: "memory")
#define PG8_WAIT_L(n) asm volatile("s_waitcnt lgkmcnt(" #n ")" ::: "memory")
#define PG8_BAR __builtin_amdgcn_s_barrier()
#define PG8_SCHED __builtin_amdgcn_sched_barrier(0)
    Unit cur, nxt; int ui = 0;
    if (!S.next(0, cur)) return;
    f32x4 acc[2][2][4][2];
#pragma unroll
    for (int a = 0; a < 2; ++a)
#pragma unroll
        for (int b = 0; b < 2; ++b)
#pragma unroll
            for (int m = 0; m < 4; ++m)
#pragma unroll
                for (int n = 0; n < 2; ++n) acc[a][b][m][n] = (f32x4){0.f, 0.f, 0.f, 0.f};
    bf16x8 At[4][2], B0[2][2], B1[2][2]; i32x8 At_8[4], B0_8[2], B1_8[2]; int sc1_ = 0x7f7f7f7f; asm volatile("" : "+v"(sc1_));
    const char* cA = (const char*)g.A + (size_t)cur.pm * tstep; const char* cB = (const char*)g.Bt + (size_t)cur.pn * tstep;
    S.a_ready(cur);
    if constexpr (SP2) {
        PG8_STAGE(PG8_SB(0, 0), cB, voffB); PG8_STAGE(PG8_SB(0, 1), cB + hstep, voffB); PG8_STAGE(PG8_SA(0, 0), cA, voffA); PG8_STAGE(PG8_SA(0, 1), cA + hstep, voffA);
        if (wr == 1) PG8_BAR;
        PG8_WAIT_V(2); PG8_BAR;
        PG8_STAGE(PG8_SB(1, 0), cB + kstep, voffB); PG8_STAGE(PG8_SA(1, 0), cA + kstep, voffA); PG8_STAGE(PG8_SB(1, 1), cB + hstep + kstep, voffB);
        PG8_WAIT_V(6); PG8_BAR;
    } else {
        PG8_STAGE(PG8_SB(0, 0), cB, voffB); PG8_STAGE(PG8_SA(0, 0), cA, voffA); PG8_STAGE(PG8_SB(0, 1), cB + hstep, voffB); PG8_STAGE(PG8_SA(0, 1), cA + hstep, voffA);
        if (wr == 1) PG8_BAR;
        PG8_WAIT_V(4); PG8_BAR;
        PG8_STAGE(PG8_SB(1, 0), cB + kstep, voffB); PG8_STAGE(PG8_SA(1, 0), cA + kstep, voffA); PG8_STAGE(PG8_SB(1, 1), cB + hstep + kstep, voffB);
        PG8_WAIT_V(6); PG8_BAR;
    }
    for (;;) {
        const bool has_next = S.next(ui + 1, nxt);
        const char* nA = has_next ? (const char*)g.A + (size_t)nxt.pm * tstep : cA; const char* nB = has_next ? (const char*)g.Bt + (size_t)nxt.pn * tstep : cB;
        for (int t = 0; t < nt; t += 2) {
            const bool last = (t == nt - 2);
            const char* a1 = cA + (size_t)(t + 1) * kstep;
            const char* a2 = last ? nA : cA + (size_t)(t + 2) * kstep; const char* b2 = last ? nB : cB + (size_t)(t + 2) * kstep;
            const char* a3 = a2 + kstep; const char* b3 = b2 + kstep;
            if (last && has_next) S.a_ready(nxt);
            if constexpr (SP2) {
            PG8_LDB(B0, 0, 0); PG8_LDB(B1, 0, 1); PG8_SCHED; PG8_LDA(At, 0, 0); PG8_STAGE(PG8_SA(1, 1), a1 + hstep, voffA);
            PG8_WAIT_V(8); PG8_WAIT_L(0); PG8_BAR; PG8_MMA(0, 0, At, B0); PG8_MMA(0, 1, At, B1); PG8_BAR; PG8_SCHED;
            PG8_LDA(At, 0, 1); PG8_STAGE(PG8_SB(0, 0), b2, voffB); PG8_STAGE(PG8_SB(0, 1), b2 + hstep, voffB); PG8_STAGE(PG8_SA(0, 0), a2, voffA);
            PG8_WAIT_V(8); PG8_WAIT_L(0); PG8_BAR; PG8_MMA(1, 0, At, B0); PG8_MMA(1, 1, At, B1); PG8_BAR; PG8_SCHED;
            PG8_LDB(B0, 1, 0); PG8_LDB(B1, 1, 1); PG8_SCHED; PG8_LDA(At, 1, 0); PG8_STAGE(PG8_SA(0, 1), a2 + hstep, voffA);
            PG8_WAIT_V(8); PG8_WAIT_L(0); PG8_BAR; PG8_MMA(0, 0, At, B0); PG8_MMA(0, 1, At, B1); PG8_BAR; PG8_SCHED;
            PG8_LDA(At, 1, 1); PG8_STAGE(PG8_SB(1, 0), b3, voffB); PG8_STAGE(PG8_SB(1, 1), b3 + hstep, voffB); PG8_STAGE(PG8_SA(1, 0), a3, voffA);
            PG8_WAIT_V(8); PG8_WAIT_L(0); PG8_BAR; PG8_MMA(1, 0, At, B0); PG8_MMA(1, 1, At, B1); PG8_BAR; PG8_SCHED;
            } else {
            PG8_LDB(B0, 0, 0); PG8_SCHED; PG8_LDA(At, 0, 0); PG8_STAGE(PG8_SA(1, 1), a1 + hstep, voffA);
            PG8_WAIT_L(8); PG8_BAR; PG8_WAIT_L(0); PG8_MMA(0, 0, At, B0); PG8_BAR; PG8_SCHED;
            PG8_LDB(B1, 0, 1); PG8_STAGE(PG8_SB(0, 0), b2, voffB);
            PG8_BAR; PG8_WAIT_L(0); PG8_MMA(0, 1, At, B1); PG8_BAR;
            PG8_LDA(At, 0, 1); PG8_STAGE(PG8_SA(0, 0), a2, voffA);
            PG8_BAR; PG8_WAIT_L(0); PG8_MMA(1, 0, At, B0); PG8_BAR; PG8_SCHED;
            PG8_STAGE(PG8_SB(0, 1), b2 + hstep, voffB);
            PG8_WAIT_V(6); PG8_BAR; PG8_MMA(1, 1, At, B1); PG8_BAR;
            PG8_LDB(B0, 1, 0); PG8_SCHED; PG8_LDA(At, 1, 0); PG8_STAGE(PG8_SA(0, 1), a2 + hstep, voffA);
            PG8_WAIT_L(8); PG8_BAR; PG8_WAIT_L(0); PG8_MMA(0, 0, At, B0); PG8_BAR; PG8_SCHED;
            PG8_LDB(B1, 1, 1); PG8_STAGE(PG8_SB(1, 0), b3, voffB);
            PG8_BAR; PG8_WAIT_L(0); PG8_MMA(0, 1, At, B1); PG8_BAR;
            PG8_LDA(At, 1, 1); PG8_STAGE(PG8_SA(1, 0), a3, voffA);
            PG8_BAR; PG8_WAIT_L(0); PG8_MMA(1, 0, At, B0); PG8_BAR; PG8_SCHED;
            PG8_STAGE(PG8_SB(1, 1), b3 + hstep, voffB);
            PG8_WAIT_V(6); PG8_BAR; PG8_MMA(1, 1, At, B1); PG8_BAR;
            }
        }
        if constexpr (FP8) asm volatile("s_nop 15\n\ts_nop 15" ::: "memory");
        if constexpr (ALIGN_EPI) { if (wr == 0) PG8_BAR; }
        if constexpr (!Epi::AFTER_DRAIN) { E(acc, cur, wr, wc, fr, fq); S.done(cur); }
        if (!has_next) break;
#pragma unroll
        for (int a = 0; a < 2; ++a)
#pragma unroll
            for (int b = 0; b < 2; ++b)
#pragma unroll
                for (int m = 0; m < 4; ++m)
#pragma unroll
                    for (int n = 0; n < 2; ++n) acc[a][b][m][n] = (f32x4){0.f, 0.f, 0.f, 0.f};
        cur = nxt; cA = nA; cB = nB; ++ui;
        if constexpr (ALIGN_EPI) { if (wr == 1) PG8_BAR; }
    }
    PG8_WAIT_V(0);
    if constexpr (!ALIGN_EPI) { if (wr == 0) PG8_BAR; }
    PG8_BAR;
    if constexpr (Epi::AFTER_DRAIN) { E.fused(acc, cur, wr, wc, fr, fq, lds, wid, lane); S.done(cur); }
}
template <class Epi, class Sched, bool FP8 = false>
__device__ __forceinline__ void gemm_phase_gather(PG8_LAS unsigned char* lds, const Gemm g, const int* slot_tok, const Sched& S, const Epi& E) {
    constexpr bool ALIGN_EPI = true, SP2 = true;
    int tid_o_ = threadIdx.x; asm volatile("" : "+v"(tid_o_)); const int tid = tid_o_, wid = __builtin_amdgcn_readfirstlane(tid >> 6), lane = tid & 63, wr = wid >> 2, wc = wid & 3, fr = lane & 15, fq = lane >> 4;
    const int K = g.K, nt = K / BK;
    unsigned voffB[2]; unsigned vC[2][2];
#pragma unroll
    for (int i = 0; i < 2; ++i) { int R, C; stage_rc(tid * 16 + i * 8192, R, C); const int Rb = Epi::PERM ? ((R & ~31) + perm32(R & 31)) : R;
        voffB[i] = (unsigned)(Rb * K + C) * 2u; }
    const size_t kstep = (size_t)(BK * 2);
    const size_t hstep = (size_t)HALF * K * 2;
    const size_t tstep = 2 * hstep;
    const unsigned ldsw = (unsigned)wid * 1024u;
    const int aoff = lds_byte(wr * 64 + fr, fq * 8), boff = lds_byte(wc * 32 + fr, fq * 8);
    Unit cur, nxt; int ui = 0;
    if (!S.next(0, cur)) return;
    f32x4 acc[2][2][4][2];
#pragma unroll
    for (int a = 0; a < 2; ++a)
#pragma unroll
        for (int b = 0; b < 2; ++b)
#pragma unroll
            for (int m = 0; m < 4; ++m)
#pragma unroll
                for (int n = 0; n < 2; ++n) acc[a][b][m][n] = (f32x4){0.f, 0.f, 0.f, 0.f};
    bf16x8 At[4][2], B0[2][2], B1[2][2]; i32x8 At_8[4], B0_8[2], B1_8[2]; int sc1_ = 0x7f7f7f7f; asm volatile("" : "+v"(sc1_));
    const char* XA = (const char*)g.A; const char* cB = (const char*)g.Bt + (size_t)cur.pn * tstep;
#pragma unroll
    for (int h = 0; h < 2; ++h)
#pragma unroll
        for (int i = 0; i < 2; ++i) { int R_, C_; stage_rc(tid * 16 + i * 8192, R_, C_); vC[h][i] = (unsigned)slot_tok[cur.pm * BM + h * HALF + R_] * (unsigned)(K * 2) + (unsigned)C_ * 2u; }
    S.a_ready(cur);
    if constexpr (SP2) {
        PG8_STAGE(PG8_SB(0, 0), cB, voffB); PG8_STAGE(PG8_SB(0, 1), cB + hstep, voffB); PG8_STAGE(PG8_SA(0, 0), XA, vC[0]); PG8_STAGE(PG8_SA(0, 1), XA, vC[1]);
        if (wr == 1) PG8_BAR;
        PG8_WAIT_V(2); PG8_BAR;
        PG8_STAGE(PG8_SB(1, 0), cB + kstep, voffB); PG8_STAGE(PG8_SA(1, 0), XA + kstep, vC[0]); PG8_STAGE(PG8_SB(1, 1), cB + hstep + kstep, voffB);
        PG8_WAIT_V(6); PG8_BAR;
    }
    for (;;) {
        const bool has_next = S.next(ui + 1, nxt);
        const char* nB = has_next ? (const char*)g.Bt + (size_t)nxt.pn * tstep : cB;
        PG8_LAS unsigned char* tab = lds + STAGE_BYTES + ((ui + 1) & 1) * 1024;
        if (has_next && wid == 0) { int lo_ = lane * 4; asm volatile("" : "+v"(lo_));
            __builtin_amdgcn_global_load_lds((const unsigned*)(slot_tok + (size_t)nxt.pm * BM + lo_), (PG8_LAS unsigned*)tab, 16, 0, 0); }
        for (int t = 0; t < nt; t += 2) {
            const bool last = (t == nt - 2);
            const char* a1 = XA + (size_t)(t + 1) * kstep;
            const char* a2 = last ? XA : XA + (size_t)(t + 2) * kstep; const char* b2 = last ? nB : cB + (size_t)(t + 2) * kstep;
            const char* a3 = a2 + kstep; const char* b3 = b2 + kstep;
            unsigned vN[2][2];
            if (last && has_next) {
#pragma unroll
                for (int h = 0; h < 2; ++h)
#pragma unroll
                    for (int i = 0; i < 2; ++i) { int R_, C_; stage_rc(tid * 16 + i * 8192, R_, C_); vN[h][i] = *(const PG8_LAS unsigned*)(tab + (h * HALF + R_) * 4) * (unsigned)(K * 2) + (unsigned)C_ * 2u; }
            } else {
#pragma unroll
                for (int h = 0; h < 2; ++h)
#pragma unroll
                    for (int i = 0; i < 2; ++i) vN[h][i] = vC[h][i];
            }
            const unsigned vS0[2] = {vN[0][0], vN[0][1]}, vS1[2] = {vN[1][0], vN[1][1]};
            if (last && has_next) S.a_ready(nxt);
            if constexpr (SP2) {
            PG8_LDB(B0, 0, 0); PG8_LDB(B1, 0, 1); PG8_SCHED; PG8_LDA(At, 0, 0); PG8_STAGE(PG8_SA(1, 1), a1, vC[1]);
            PG8_WAIT_V(8); PG8_WAIT_L(0); PG8_BAR; PG8_MMA(0, 0, At, B0); PG8_MMA(0, 1, At, B1); PG8_BAR; PG8_SCHED;
            PG8_LDA(At, 0, 1); PG8_STAGE(PG8_SB(0, 0), b2, voffB); PG8_STAGE(PG8_SB(0, 1), b2 + hstep, voffB); PG8_STAGE(PG8_SA(0, 0), a2, vS0);
            PG8_WAIT_V(8); PG8_WAIT_L(0); PG8_BAR; PG8_MMA(1, 0, At, B0); PG8_MMA(1, 1, At, B1); PG8_BAR; PG8_SCHED;
            PG8_LDB(B0, 1, 0); PG8_LDB(B1, 1, 1); PG8_SCHED; PG8_LDA(At, 1, 0); PG8_STAGE(PG8_SA(0, 1), a2, vS1);
            PG8_WAIT_V(8); PG8_WAIT_L(0); PG8_BAR; PG8_MMA(0, 0, At, B0); PG8_MMA(0, 1, At, B1); PG8_BAR; PG8_SCHED;
            PG8_LDA(At, 1, 1); PG8_STAGE(PG8_SB(1, 0), b3, voffB); PG8_STAGE(PG8_SB(1, 1), b3 + hstep, voffB); PG8_STAGE(PG8_SA(1, 0), a3, vS0);
            PG8_WAIT_V(8); PG8_WAIT_L(0); PG8_BAR; PG8_MMA(1, 0, At, B0); PG8_MMA(1, 1, At, B1); PG8_BAR; PG8_SCHED;
            }
        }
        if constexpr (FP8) asm volatile("s_nop 15\n\ts_nop 15" ::: "memory");
        if constexpr (ALIGN_EPI) { if (wr == 0) PG8_BAR; }
        if constexpr (!Epi::AFTER_DRAIN) { E(acc, cur, wr, wc, fr, fq); S.done(cur); }
        if (!has_next) break;
#pragma unroll
        for (int a = 0; a < 2; ++a)
#pragma unroll
            for (int b = 0; b < 2; ++b)
#pragma unroll
                for (int m = 0; m < 4; ++m)
#pragma unroll
                    for (int n = 0; n < 2; ++n) acc[a][b][m][n] = (f32x4){0.f, 0.f, 0.f, 0.f};
        cur = nxt; cB = nB; ++ui;
        { const PG8_LAS unsigned char* tabc = lds + STAGE_BYTES + (ui & 1) * 1024;
#pragma unroll
          for (int h = 0; h < 2; ++h)
#pragma unroll
              for (int i = 0; i < 2; ++i) { int R_, C_; stage_rc(tid * 16 + i * 8192, R_, C_); vC[h][i] = *(const PG8_LAS unsigned*)(tabc + (h * HALF + R_) * 4) * (unsigned)(K * 2) + (unsigned)C_ * 2u; } }
        if constexpr (ALIGN_EPI) { if (wr == 1) PG8_BAR; }
    }
    PG8_WAIT_V(0);
    if constexpr (!ALIGN_EPI) { if (wr == 0) PG8_BAR; }
    PG8_BAR;
    if constexpr (Epi::AFTER_DRAIN) { E.fused(acc, cur, wr, wc, fr, fq, lds, wid, lane); S.done(cur); }
}
#undef PG8_SA
#undef PG8_SB
#undef PG8_STAGE
#undef PG8_LDA
#undef PG8_LDB
#undef PG8_MMA
#undef PG8_WAIT_V
#undef PG8_WAIT_L
#undef PG8_BAR
#undef PG8_SCHED
}
#define LAS __attribute__((address_space(3)))
typedef unsigned short bf16;
typedef short bf16x8 __attribute__((ext_vector_type(8)));
typedef short v4i16 __attribute__((ext_vector_type(4)));
typedef float f32x4 __attribute__((ext_vector_type(4)));
typedef float f32x16 __attribute__((ext_vector_type(16)));
typedef unsigned u32x4 __attribute__((ext_vector_type(4)));
typedef unsigned u32x2 __attribute__((ext_vector_type(2)));
typedef float f32x2 __attribute__((ext_vector_type(2)));

constexpr int NB = 16, SEQ = 2048, T = NB * SEQ, D = 1024, DEPTH = 2;
constexpr int PIN = 3348;
constexpr int PP = 3584;
constexpr int NEXP = 32, DEXP = 512;
constexpr int NBLK_MAX = 288, NSLOT_MAX = NBLK_MAX * 256;
constexpr int NWAVES = 8, NTHREADS = 512;
constexpr float ALPHA = 1.41421356237f;
constexpr float LN_EPS = 1e-5f, RMS_EPS = 1e-6f;

constexpr int C_CU = 0, C_CGB = 256, C_CGC = 512, C_GQ = 768, C_GK = 896, C_GV = 1024, C_GG = 1280, C_SZ = 1536, C_SX = 1792, C_SB = 2048, C_SC = 2304,
              C_DQ = 2560, C_DK = 2816, C_DV = 3072, C_GLR = 3328, C_SDT = 3344;
__host__ __device__ __forceinline__ int orig_col(int c) {
    if (c < 1536) return c;
    if (c < 2560) return 1552 + (c - 1536);
    if (c < 3328) return 2580 + (c - 2560);
    if (c < 3344) return 1536 + (c - 3328);
    if (c < 3348) return 2576 + (c - 3344);
    return -1;
}

enum { I_X = 0, I_WIN, I_CONVW, I_GLA_WLR, I_GLA_BLR, I_GLA_NG, I_SSD_CW, I_SSD_CB, I_SSD_ALOG, I_SSD_D, I_SSD_DTB, I_SSD_NG, I_LQ1, I_LK1, I_LQ2, I_LK2, I_DIFF_NG,
       I_WO, I_LN1G, I_LN1B, I_RG, I_RE, I_WG, I_WU, I_WD, I_LN2G, I_LN2B, N_IN };

constexpr size_t MiB = 1u << 20;
constexpr size_t WS_WGCNT = 0;
constexpr size_t WS_BLKEXP = 64 * 1024;
constexpr size_t WS_SLOTGATE = 128 * 1024;
constexpr size_t WS_SLOTOF = 512 * 1024;
constexpr size_t WS_LNSTAT = 768 * 1024;
constexpr size_t WS_WRT = 1024 * 1024, WRT_LAYER = 128 * 1024;
constexpr size_t WS_RCS = WS_WRT + 98304;
constexpr size_t WS_LAM = 1700 * 1024;
constexpr size_t WS_SLOTTOK = 2560 * 1024;
constexpr size_t WS_SSDDEC = 1792 * 1024;
constexpr size_t WS_GLACL = 2048 * 1024;
constexpr size_t WS_BAR = 3 * MiB;
constexpr size_t WS_RDY = WS_BAR + 16384;
constexpr size_t WS_GB = WS_RDY + (size_t)DEPTH * NBLK_MAX * 256;
static_assert(WS_GB + 4096 <= 4 * MiB, "barrier area");
constexpr size_t WS_W = 4 * MiB;
constexpr size_t W_WIN = WS_W, W_WO = W_WIN + (size_t)PP * 1024 * 2, W_WGU = W_WO + (size_t)1024 * 1024 * 2, W_WD = W_WGU + (size_t)NEXP * 1024 * 1024 * 2,
                 W_END = W_WD + (size_t)NEXP * 1024 * 512 * 2;
constexpr size_t WS_A = 112 * MiB;
static_assert(W_END <= WS_A, "weights region");
constexpr size_t A_XB = WS_A, A_PROJ = WS_A + 64 * MiB, A_MIX = A_PROJ + 224 * MiB, A_ST = A_MIX + 64 * MiB, A_DST = A_ST + 32 * MiB, A_SP = A_DST + 16 * MiB, A_GP = A_SP + 16 * MiB, A_END = A_GP + 8 * MiB;
constexpr size_t A_V = A_XB;
constexpr size_t A_X1 = WS_A + 128 * MiB;
constexpr size_t A_XS = WS_A + 192 * MiB;
constexpr size_t A_X8 = A_ST;
constexpr size_t A_Y = A_XS;
constexpr size_t A_H = WS_A + 64 * MiB;
static_assert(A_XS + (size_t)NSLOT_MAX * 1024 * 2 <= A_ST, "Xs/Y overlay");
static_assert(A_H + (size_t)NSLOT_MAX * 512 <= A_X1, "h overlay (fp8 h)");
static_assert((size_t)T * PP * 2 == 224 * MiB, "proj size");
static_assert((size_t)T * 1024 == 32 * MiB && (size_t)NB * 16 * 4 * 8192 * 4 == 32 * MiB, "x8 rows of one XCC == the chunk states of its two batches");
constexpr size_t WS_NEED = A_END;
static_assert(WS_NEED <= 572000000ull, "workspace budget");

constexpr int LDS_BYTES = 163840;

__device__ __forceinline__ float bf2f(unsigned short b) { return __uint_as_float((unsigned)b << 16); }
__device__ __forceinline__ float bflo(unsigned w) { return __uint_as_float(w << 16); }
__device__ __forceinline__ float bfhi(unsigned w) { return __uint_as_float(w & 0xffff0000u); }
__device__ __forceinline__ unsigned pk2(float lo, float hi) { return pg8::cvt_pk_bf16(lo, hi); }
__device__ __forceinline__ unsigned short f2bf(float f) { return (unsigned short)(pk2(f, 0.f) & 0xffffu); }
__device__ __forceinline__ float siluf(float x) { return x * __builtin_amdgcn_rcpf(1.0f + __builtin_amdgcn_exp2f(-1.4426950408889634f * x)); }
__device__ __forceinline__ float softplusf(float x) { return fmaxf(x, 0.f) + __logf(1.0f + __expf(-fabsf(x))); }
__device__ __forceinline__ float logsigmoidf(float x) { return fminf(x, 0.f) - __logf(1.0f + __expf(-fabsf(x))); }
__device__ __forceinline__ int crow(int i, int h) { return (i & 3) + 8 * (i >> 2) + 4 * h; }
__device__ __forceinline__ float shflx(float v, int mask, int lane) { return __int_as_float(__builtin_amdgcn_ds_bpermute((lane ^ mask) << 2, __float_as_int(v))); }
__device__ __forceinline__ float shfl_from(float v, int src, int lane) { (void)lane; return __int_as_float(__builtin_amdgcn_ds_bpermute(src << 2, __float_as_int(v))); }
__device__ __forceinline__ float xor32_add(float v) { auto rr = __builtin_amdgcn_permlane32_swap(__float_as_uint(v), __float_as_uint(v), false, false); return __uint_as_float(rr[0]) + __uint_as_float(rr[1]); }
__device__ __forceinline__ float wave_sum(float v, int lane) {
#pragma unroll
    for (int o = 1; o < 32; o <<= 1) v += shflx(v, o, lane);
    return xor32_add(v);
}
__device__ __forceinline__ bf16x8 fragN(const LAS unsigned char* X, int stride, int r0, int k0, int lane) {
    return *(const LAS bf16x8*)(X + (r0 + (lane & 31)) * stride + (k0 + 8 * (lane >> 5)) * 2);
}
__device__ __forceinline__ bf16x8 fragT(const LAS unsigned char* X, int stride, int k0, int c0, int lane) {
    const int g = lane >> 4, i = lane & 15, q = i >> 2, pp = i & 3, h = g >> 1;
    const LAS unsigned char* p = X + (k0 + 8 * h + q) * stride + (c0 + 16 * (g & 1) + 4 * pp) * 2;
    const v4i16 a = __builtin_amdgcn_ds_read_tr16_b64_v4i16((LAS v4i16*)p);
    const v4i16 b = __builtin_amdgcn_ds_read_tr16_b64_v4i16((LAS v4i16*)(p + 4 * stride));
    return (bf16x8){a[0], a[1], a[2], a[3], b[0], b[1], b[2], b[3]};
}
#define MFMA32(a, b, c) __builtin_amdgcn_mfma_f32_32x32x16_bf16((a), (b), (c), 0, 0, 0)
#define ZERO16 ((f32x16){0.f,0.f,0.f,0.f,0.f,0.f,0.f,0.f,0.f,0.f,0.f,0.f,0.f,0.f,0.f,0.f})

struct Ctx {
    const float* in[N_IN]; float* out; unsigned char* ws;
};
struct Args { const float* in[N_IN]; float* out; unsigned char* ws; };

struct CvtItem { const float* cp; unsigned char* dst; int ld, K, n0, k0; float sc; bool f8; };
__device__ __forceinline__ void cvt_load(const CvtItem& d, f32x4 (&v)[8], int lane) {
#pragma unroll
    for (int i = 0; i < 8; ++i) { const int kk = 8 * (lane >> 3) + i; v[i] = *(const f32x4*)(d.cp + (size_t)(d.k0 + kk) * d.ld); }
}
__device__ __forceinline__ unsigned pk4_fp8_w(float a, float b, float c, float d) {
    unsigned w = 0; w = __builtin_amdgcn_cvt_pk_fp8_f32(__builtin_amdgcn_fmed3f(a, -448.f, 448.f), __builtin_amdgcn_fmed3f(b, -448.f, 448.f), w, false);
    w = __builtin_amdgcn_cvt_pk_fp8_f32(__builtin_amdgcn_fmed3f(c, -448.f, 448.f), __builtin_amdgcn_fmed3f(d, -448.f, 448.f), w, true); return w; }
__device__ __forceinline__ void cvt_finish(const CvtItem& d, const f32x4 (&v)[8], int lane) {
    const int c = lane & 7, g = lane >> 3; const float sc = d.sc;
#pragma unroll
    for (int e = 0; e < 4; ++e) { const size_t off = (size_t)(d.n0 + 4 * c + e) * d.K + d.k0 + 8 * g;
        if (d.f8) { u32x2 o; o.x = pk4_fp8_w(v[0][e] * sc, v[1][e] * sc, v[2][e] * sc, v[3][e] * sc); o.y = pk4_fp8_w(v[4][e] * sc, v[5][e] * sc, v[6][e] * sc, v[7][e] * sc);
            *(u32x2*)(d.dst + off) = o; }
        else { u32x4 o; o.x = pk2(v[0][e] * sc, v[1][e] * sc); o.y = pk2(v[2][e] * sc, v[3][e] * sc); o.z = pk2(v[4][e] * sc, v[5][e] * sc); o.w = pk2(v[6][e] * sc, v[7][e] * sc);
            *(u32x4*)(d.dst + off * 2) = o; } }
}
#ifndef MOE_FP8
#define MOE_FP8 1
#endif
__device__ __forceinline__ unsigned char* wbuf(const Args& A, int l) { return (l & 1) ? (unsigned char*)A.out : A.ws + WS_W; }
#ifndef CVT_NP
#define CVT_NP 4
#endif
constexpr int CV_IT_IN = 16 * (PP / 32), CV_NIT = CV_IT_IN + 16 * 32 + 16 * (NEXP * 1024 / 32) + 8 * (NEXP * 1024 / 32);
__device__ __forceinline__ void convert_weights(const Args& A, int l, LAS unsigned char* lds, int gw, int ngw, int wave, int lane, int it0, int it1, bool tables) {
    (void)lds; (void)wave;
    unsigned char* ws = A.ws; unsigned char* wb = wbuf(A, l) - WS_W;
    const float* w_in = A.in[I_WIN] + (size_t)l * 1024 * PIN;
    const float* w_o = A.in[I_WO] + (size_t)l * 1024 * 1024;
    const float* w_g = A.in[I_WG] + (size_t)l * NEXP * 1024 * 512;
    const float* w_u = A.in[I_WU] + (size_t)l * NEXP * 1024 * 512;
    const float* w_d = A.in[I_WD] + (size_t)l * NEXP * 512 * 1024;
    constexpr int IT_IN = 16 * (PP / 32), IT_O = 16 * 32, IT_GU = 16 * (NEXP * 1024 / 32), IT_D = 8 * (NEXP * 1024 / 32);
    constexpr int NIT = IT_IN + IT_O + IT_GU + IT_D;
    const int nl = 4 * (lane & 7);
    auto desc = [&](int it) -> CvtItem {
        CvtItem d; int r = it; d.sc = 1.0f; d.f8 = false;
        if (r < IT_IN) { const int kb = r / (PP / 32), nb = r % (PP / 32); const int oc = orig_col(nb * 32 + nl);
            d.cp = w_in + (oc >= 0 ? oc : 0); d.sc = oc >= 0 ? 1.0f : 0.0f; d.ld = PIN; d.dst = wb + W_WIN; d.K = 1024; d.n0 = nb * 32; d.k0 = kb * 64; return d; }
        r -= IT_IN;
        if (r < IT_O) { const int kb = r / 32, nb = r % 32; d.cp = w_o + nb * 32 + nl; d.ld = 1024; d.dst = wb + W_WO; d.K = 1024; d.n0 = nb * 32; d.k0 = kb * 64; return d; }
        r -= IT_O;
        if (r < IT_GU) { const int kb = r / 1024, nb = r % 1024; const int n = nb * 32 + nl, e = n >> 10, np = n & 1023, pnl = np >> 8, half = (np >> 7) & 1, j = np & 127;
            d.cp = (half ? w_u : w_g) + (size_t)e * 1024 * 512 + pnl * 128 + j; d.ld = 512; d.dst = wb + W_WGU; d.K = 1024; d.n0 = nb * 32; d.k0 = kb * 64; d.f8 = MOE_FP8 != 0; d.sc = MOE_FP8 ? 64.0f : 1.0f; return d; }
        r -= IT_GU;
        { const int kb = r / 1024, nb = r % 1024; const int n = nb * 32 + nl, e = n >> 10, np = n & 1023;
            d.cp = w_d + (size_t)e * 512 * 1024 + np; d.ld = 1024; d.dst = wb + W_WD; d.K = 512; d.n0 = nb * 32; d.k0 = kb * 64; d.f8 = MOE_FP8 != 0; d.sc = MOE_FP8 ? 64.0f : 1.0f; return d; }
    };
    static_assert(NIT == CV_NIT && IT_IN == CV_IT_IN, "item counts");
    {
        CvtItem d[CVT_NP]; f32x4 v[CVT_NP][8];
#pragma unroll
        for (int j = 0; j < CVT_NP; ++j) { const int itj = it0 + gw + j * ngw; d[j] = desc(itj < it1 ? itj : it1 - 1); cvt_load(d[j], v[j], lane); }
        for (int it = it0 + gw; it < it1; it += CVT_NP * ngw) {
#pragma unroll
            for (int j = 0; j < CVT_NP; ++j) { const int itj = it + j * ngw;
                if (itj < it1) cvt_finish(d[j], v[j], lane);
                const int itn = itj + CVT_NP * ngw; d[j] = desc(itn < it1 ? itn : it1 - 1); cvt_load(d[j], v[j], lane); }
        }
    }
    if (!tables) return;
    bf16* wrt = (bf16*)(ws + WS_WRT + l * WRT_LAYER); float* rcs = (float*)(ws + WS_RCS + l * WRT_LAYER);
    const float* rg = A.in[I_RG] + (size_t)l * 1024 * 4; const float* re = A.in[I_RE] + (size_t)l * 1024 * 32;
    const float* g1 = A.in[I_LN1G] + l * 1024; const float* b1 = A.in[I_LN1B] + l * 1024;
    for (int j = gw; j < 48; j += ngw) {
        float cs = 0.f, cb = 0.f;
        for (int k = lane; k < 1024; k += 64) {
            const float w = j < 4 ? rg[k * 4 + j] : (j < 36 ? re[k * 32 + (j - 4)] : 0.f);
            const unsigned short wb = f2bf(g1[k] * w); wrt[j * 1024 + k] = wb; cs += bf2f(wb); cb += b1[k] * w;
        }
        cs = wave_sum(cs, lane); cb = wave_sum(cb, lane);
        if (lane == 0) { rcs[j] = cs; rcs[48 + j] = cb; }
    }
    if (l == 0 && gw == 48) {
        for (int ll = 0; ll < DEPTH; ++ll) {
            float s1 = (lane < 32) ? A.in[I_LQ1][ll * 32 + (lane & 31)] * A.in[I_LK1][ll * 32 + (lane & 31)] : 0.f, s2 = (lane < 32) ? A.in[I_LQ2][ll * 32 + (lane & 31)] * A.in[I_LK2][ll * 32 + (lane & 31)] : 0.f;
            s1 = wave_sum(s1, lane); s2 = wave_sum(s2, lane);
            const float lam_init = 0.8f - 0.6f * __expf(-0.3f * (float)ll);
            if (lane == 0) ((float*)(ws + WS_LAM))[ll] = __expf(s1) - __expf(s2) + lam_init; }
    }
}
__device__ __forceinline__ void convert_x(const Args& A, int gtid, int gthreads) {
    const f32x4* x = (const f32x4*)A.in[I_X]; u32x4* xb = (u32x4*)(A.ws + A_XB);
    constexpr size_t NCH = (size_t)T * D / 8;
    for (size_t i = gtid; i < NCH; i += (size_t)gthreads * 4) {
        f32x4 a[4], b[4];
#pragma unroll
        for (int u = 0; u < 4; ++u) { const size_t j = i + (size_t)u * gthreads; if (j < NCH) { a[u] = x[2 * j]; b[u] = x[2 * j + 1]; } }
#pragma unroll
        for (int u = 0; u < 4; ++u) { const size_t j = i + (size_t)u * gthreads; if (j < NCH) { u32x4 o; o.x = pk2(a[u][0], a[u][1]); o.y = pk2(a[u][2], a[u][3]); o.z = pk2(b[u][0], b[u][1]); o.w = pk2(b[u][2], b[u][3]); xb[j] = o; } }
    }
}
__device__ __forceinline__ u32x4 pair16(u32x2 a, u32x2 b) {
    const auto x = __builtin_amdgcn_permlane32_swap(a.x, b.x, false, false), y = __builtin_amdgcn_permlane32_swap(a.y, b.y, false, false);
    u32x4 q; q.x = x[0]; q.y = y[0]; q.z = x[1]; q.w = y[1]; return q; }
__device__ __forceinline__ int opaque_tid() { int t = threadIdx.x; asm volatile("" : "+v"(t)); return t; }
#define XB_TMO      128
#define XB_XCNT(j)  (256  + 64 * (j))
#define XB_XSUB(j)  (1280 + 64 * (j))
#define XB_XGEN(j)  (2304 + 64 * (j))
#define XB_TOP      3328
#define XB_TOPGEN   3392
#define XCD_BAR_WORDS 3456
#define XB_SPIN_CAP (1u << 18)

__device__ __forceinline__ unsigned xb_ld(unsigned* p)              { return __hip_atomic_load(p, __ATOMIC_RELAXED, __HIP_MEMORY_SCOPE_AGENT); }
__device__ __forceinline__ unsigned xb_add(unsigned* p, unsigned v) { return __hip_atomic_fetch_add(p, v, __ATOMIC_RELAXED, __HIP_MEMORY_SCOPE_AGENT); }
__device__ __forceinline__ unsigned xb_xcc_id() { return (unsigned)__builtin_amdgcn_s_getreg((3 << 11) | 20) & 0xFu; }
#define XB_SPIN(cond, bar) do { unsigned _sp = 0; while (cond) { __builtin_amdgcn_s_sleep(1); \
    if ((++_sp & 255u) == 0u) { if (xb_ld(&(bar)[XB_TMO])) break; if (_sp > XB_SPIN_CAP) { atomicAdd(&(bar)[XB_TMO], 1u); break; } } } } while (0)

struct XcdBarrier {
    unsigned* bar; unsigned x;
    volatile LAS unsigned* st;
};

__device__ __forceinline__ XcdBarrier xcd_barrier_post(unsigned* bar, volatile LAS unsigned* st) {
    XcdBarrier b; b.bar = bar; b.x = xb_xcc_id(); b.st = st;
    if (threadIdx.x == 0) st[2] = xb_add(&bar[XB_XCNT(b.x)], 1u);
    return b;
}
__device__ __forceinline__ void xcd_barrier_complete(unsigned* bar, unsigned x, unsigned& nloc, unsigned& nx) {
    const unsigned G = gridDim.x * gridDim.y * gridDim.z;
    unsigned sum, cnt, mine, sp = 0u;
    for (;;) {
        sum = 0u; cnt = 0u; mine = 0u;
#pragma unroll
        for (unsigned j = 0; j < 16; ++j) { const unsigned c = xb_ld(&bar[XB_XCNT(j)]); sum += c; cnt += (c > 0u) ? 1u : 0u; mine = (j == x) ? c : mine; }
        if (sum == G) break;
        __builtin_amdgcn_s_sleep(1);
        if ((++sp & 255u) == 0u) { if (xb_ld(&bar[XB_TMO])) break; if (sp > XB_SPIN_CAP) { atomicAdd(&bar[XB_TMO], 1u); break; } }
    }
    nloc = mine > 0u ? mine : 1u; nx = cnt > 0u ? cnt : 1u;
}

__device__ __forceinline__ void xcd_barrier(const XcdBarrier& b) {
    asm volatile("s_waitcnt vmcnt(0)" ::: "memory");
    __syncthreads();
    if (threadIdx.x == 0) {
        unsigned* bar = b.bar; unsigned bx_ = (unsigned)__builtin_amdgcn_readfirstlane((int)b.x); asm volatile("" : "+s"(bx_));
        __builtin_amdgcn_s_waitcnt(0);
        unsigned nloc = b.st[0], nx = b.st[1];
        if (nloc == 0u) { xcd_barrier_complete(bar, bx_, nloc, nx); b.st[0] = nloc; b.st[1] = nx; }
        const unsigned old = xb_add(&bar[XB_XSUB(bx_)], 1u);
        const unsigned gen = old / nloc;
        if (old + 1u == (gen + 1u) * nloc) {
            __builtin_amdgcn_fence(__ATOMIC_RELEASE, "agent");
            asm volatile("s_waitcnt vmcnt(0)" ::: "memory");
            asm volatile("buffer_inv sc1" ::: "memory");
            const unsigned og = xb_add(&bar[XB_TOP], 1u);
            const unsigned tg = og / nx;
            if (og + 1u == (tg + 1u) * nx) xb_add(&bar[XB_TOPGEN], 1u);
            else XB_SPIN(xb_ld(&bar[XB_TOPGEN]) == tg, bar);
            xb_add(&bar[XB_XGEN(bx_)], 1u);
            asm volatile("s_waitcnt vmcnt(0)" ::: "memory");
        } else {
            asm volatile("buffer_inv sc1" ::: "memory");
            XB_SPIN(xb_ld(&bar[XB_XGEN(bx_)]) == gen, bar);
            asm volatile("s_waitcnt vmcnt(0)" ::: "memory");
        }
    }
    __syncthreads();
}

__device__ __forceinline__ void xcc_local_barrier(const XcdBarrier& b, unsigned* gb, unsigned nloc) {
    asm volatile("s_waitcnt vmcnt(0)" ::: "memory");
    __syncthreads();
    if (threadIdx.x == 0) {
        unsigned* bar = b.bar; unsigned bx_ = (unsigned)__builtin_amdgcn_readfirstlane((int)b.x); asm volatile("" : "+s"(bx_));
        __builtin_amdgcn_s_waitcnt(0);
        const unsigned k = b.st[5] + 1u; b.st[5] = k;
        (void)xb_add(&gb[32u * bx_], 1u);
        asm volatile("buffer_inv sc1" ::: "memory");
        XB_SPIN(xb_ld(&gb[32u * bx_]) < k * nloc, bar);
        asm volatile("s_waitcnt vmcnt(0)" ::: "memory");
    }
    __syncthreads();
}
constexpr int AT_Q = 0, AT_RING = 18432, AT_NSLOT = 6, AT_SLOT = 16384, AT_CMB = AT_RING + AT_NSLOT * AT_SLOT;
static_assert(AT_CMB + 32768 <= LDS_BYTES - 64, "attention LDS map");
#define EX2(x) __builtin_amdgcn_exp2f(x)
__device__ __forceinline__ void attn_mask(f32x16& s0, f32x16& s1, int kb0, int qrel, int hh) {
#pragma unroll
    for (int i = 0; i < 16; ++i) { const int kv = kb0 + crow(i, hh); if (kv > qrel) s0[i] = -INFINITY; if (kv + 32 > qrel) s1[i] = -INFINITY; }
}
__device__ __forceinline__ float xhalf_max(float v) { auto rr = __builtin_amdgcn_permlane32_swap(__float_as_uint(v), __float_as_uint(v), false, false); return fmaxf(__uint_as_float(rr[0]), __uint_as_float(rr[1])); }
__device__ __forceinline__ bf16x8 pack8(const f32x16& c, int b) {
    u32x4 w; w.x = pk2(c[b], c[b + 1]); w.y = pk2(c[b + 2], c[b + 3]); w.z = pk2(c[b + 4], c[b + 5]); w.w = pk2(c[b + 6], c[b + 7]); return __builtin_bit_cast(bf16x8, w);
}
__device__ __forceinline__ bf16x8 tr2(const LAS unsigned char* p) {
    const v4i16 a = __builtin_amdgcn_ds_read_tr16_b64_v4i16((LAS v4i16*)p), b = __builtin_amdgcn_ds_read_tr16_b64_v4i16((LAS v4i16*)(p + 1024));
    return (bf16x8){a[0], a[1], a[2], a[3], b[0], b[1], b[2], b[3]};
}
__device__ __forceinline__ void glds16(const void* gsrc, unsigned lds_dst) { unsigned keep;
    asm volatile("s_mov_b32 %0, m0\n\ts_mov_b32 m0, %2\n\ts_nop 0\n\tglobal_load_lds_dwordx4 %1, off\n\ts_mov_b32 m0, %0" : "=&s"(keep) : "v"(gsrc), "s"(lds_dst) : "memory"); }
__device__ __forceinline__ void attn_unit(LAS unsigned char* lds, const bf16* proj, bf16* mix, int b, int h, int qb, float lam, const float* normg, float oscale, bool first, int nb, int nh, int nqb, u32x4 (&qn)[2]) {
    const int tid = opaque_tid(), lane = tid & 63, wid = __builtin_amdgcn_readfirstlane(tid >> 6), ws = wid & 3, comp = wid >> 2, r32 = lane & 31, hh = lane >> 5;
    const size_t tb = (size_t)b * SEQ;
    LAS unsigned char* Qs = lds + AT_Q; LAS unsigned char* ring = lds + AT_RING; const unsigned ring0 = (unsigned)(uintptr_t)ring;
    const bf16* qsrc = proj + (tb + qb * 128) * PP + C_DQ + h * 64;
    const int NT = 2 * qb + 2, qrel = ws * 32 + r32;
    const bf16* kdma = proj + (tb + 8 * wid + (lane >> 3)) * PP + C_DK + h * 64 + (((lane & 7) ^ (lane >> 3)) << 3);
    const bf16* vdma = kdma + (C_DV - C_DK);
#define DMA_TILE_P(kp, nt, tile, slot) do { const int tl_ = (tile) < (nt) ? (tile) : (nt) - 1; \
        glds16((kp) + (size_t)tl_ * 64 * PP, (unsigned)__builtin_amdgcn_readfirstlane((int)(ring0 + (slot) * AT_SLOT + wid * 1024))); \
        glds16((kp) + (C_DV - C_DK) + (size_t)tl_ * 64 * PP, (unsigned)__builtin_amdgcn_readfirstlane((int)(ring0 + (slot) * AT_SLOT + 8192 + wid * 1024))); } while (0)
    if (first) { DMA_TILE_P(kdma, NT, 0, 0); DMA_TILE_P(kdma, NT, 1, 1); DMA_TILE_P(kdma, NT, 2, 2); DMA_TILE_P(kdma, NT, 3, 3);
#pragma unroll
        for (int i = 0; i < 2; ++i) { const int id = tid + 512 * i; qn[i] = *(const u32x4*)(qsrc + (size_t)(id >> 3) * PP + (id & 7) * 8); } }
    const float c2 = 0.25503486f;
#pragma unroll
    for (int i = 0; i < 2; ++i) { const int id = tid + 512 * i, row = id >> 3, ch = id & 7; const u32x4 q = qn[i];
        u32x4 o; o.x = pk2(bflo(q.x) * c2, bfhi(q.x) * c2); o.y = pk2(bflo(q.y) * c2, bfhi(q.y) * c2); o.z = pk2(bflo(q.z) * c2, bfhi(q.z) * c2); o.w = pk2(bflo(q.w) * c2, bfhi(q.w) * c2);
        *(LAS u32x4*)(Qs + row * 144 + ch * 16) = o; }
    asm volatile("s_waitcnt vmcnt(0) lgkmcnt(0)" ::: "memory"); __builtin_amdgcn_s_barrier(); asm volatile("" ::: "memory");
    bf16x8 qf[2];
    qf[0] = fragN(Qs, 144, ws * 32, comp * 32, lane); qf[1] = fragN(Qs, 144, ws * 32, comp * 32 + 16, lane);
    const int kx = r32 & 7;
    const int koff0 = r32 * 128 + (((comp * 4 + hh) ^ kx) << 4), koff1 = r32 * 128 + (((comp * 4 + 2 + hh) ^ kx) << 4);
    const int g_ = lane >> 4, i_ = lane & 15, q_ = i_ >> 2, pp_ = i_ & 3, vrow = 4 * (g_ >> 1) + q_, vch = 2 * (g_ & 1) + (pp_ >> 1);
    const int voff0 = 8192 + vrow * 128 + (((vch) ^ vrow) << 4) + 8 * (pp_ & 1), voff1 = 8192 + vrow * 128 + (((vch + 4) ^ vrow) << 4) + 8 * (pp_ & 1);
    float l = 0.f;
    f32x16 o0 = ZERO16, o1 = ZERO16, negm = ZERO16; float m = 0.f;
    f32x16 sA0, sA1, sB0, sB1;
    bf16x8 pA[4], pB[4];
#pragma unroll
    for (int i = 0; i < 4; ++i) pA[i] = (bf16x8){0, 0, 0, 0, 0, 0, 0, 0};
#define QK4(N0, N1, k00, k10, k01, k11) do { \
        asm volatile("s_nop 1\n\tv_mfma_f32_32x32x16_bf16 %0, %1, %2, %3" : "=&v"(N0) : "v"(k00), "v"(qf[0]), "v"(negm)); \
        asm volatile("v_mfma_f32_32x32x16_bf16 %0, %1, %2, %3" : "=&v"(N1) : "v"(k10), "v"(qf[0]), "v"(negm)); \
        asm volatile("v_mfma_f32_32x32x16_bf16 %0, %1, %2, %0" : "+v"(N0) : "v"(k01), "v"(qf[1])); \
        asm volatile("v_mfma_f32_32x32x16_bf16 %0, %1, %2, %0\n\ts_nop 15\n\ts_nop 3" : "+v"(N1) : "v"(k11), "v"(qf[1])); } while (0)
#define KFR(Kb) const bf16x8 k00 = *(const LAS bf16x8*)((Kb) + koff0), k10 = *(const LAS bf16x8*)((Kb) + 4096 + koff0), k01 = *(const LAS bf16x8*)((Kb) + koff1), k11 = *(const LAS bf16x8*)((Kb) + 4096 + koff1)
    { KFR(ring); QK4(sA0, sA1, k00, k10, k01, k11); }
    if (qb == 0) attn_mask(sA0, sA1, 0, qrel, hh);
#define SB() __builtin_amdgcn_sched_barrier(0)
#define E4(X, B) do { X[B] = EX2(X[B]); X[B + 1] = EX2(X[B + 1]); X[B + 2] = EX2(X[B + 2]); X[B + 3] = EX2(X[B + 3]); l += X[B]; l += X[B + 1]; l += X[B + 2]; l += X[B + 3]; } while (0)
#define ATT_STEP(C0, C1, N0, N1, PP_, PN_, tt, SV, SK, SD) do { \
        const bool nx = (tt) + 1 < NT; \
        { const int tl_ = (tt) + 4 < NT ? (tt) + 4 : NT - 1; \
          glds16(kdma + (size_t)tl_ * 64 * PP, (unsigned)__builtin_amdgcn_readfirstlane((int)(ring0 + (SD) * AT_SLOT + wid * 1024))); \
          glds16(vdma + (size_t)tl_ * 64 * PP, (unsigned)__builtin_amdgcn_readfirstlane((int)(ring0 + (SD) * AT_SLOT + 8192 + wid * 1024))); } \
        const LAS unsigned char* Vb = ring + (SV) * AT_SLOT; const LAS unsigned char* Kb = ring + (SK) * AT_SLOT; \
        bf16x8 va0 = tr2(Vb + voff0), vb0 = tr2(Vb + voff1), va1 = tr2(Vb + 2048 + voff0), vb1 = tr2(Vb + 2048 + voff1); \
        float mx = fmaxf(C0[0], C1[0]); \
        _Pragma("unroll") for (int i = 1; i < 16; ++i) mx = fmaxf(fmaxf(mx, C0[i]), C1[i]); \
        mx = xhalf_max(mx); \
        if ((tt) == 0 || __any(mx > 8.0f)) { const float d = ((tt) == 0) ? mx : fmaxf(mx, 0.f), al = EX2(-d); m += d; \
            _Pragma("unroll") for (int i = 0; i < 16; ++i) { o0[i] *= al; o1[i] *= al; C0[i] -= d; C1[i] -= d; negm[i] = -m; } l *= al; \
            _Pragma("unroll") for (int i = 0; i < 4; ++i) { u32x4 w = __builtin_bit_cast(u32x4, PP_[i]); \
                w.x = pk2(bflo(w.x) * al, bfhi(w.x) * al); w.y = pk2(bflo(w.y) * al, bfhi(w.y) * al); w.z = pk2(bflo(w.z) * al, bfhi(w.z) * al); w.w = pk2(bflo(w.w) * al, bfhi(w.w) * al); PP_[i] = __builtin_bit_cast(bf16x8, w); } } \
        SB(); \
        o0 = MFMA32(va0, PP_[0], o0); E4(C0, 0); SB(); \
        o1 = MFMA32(vb0, PP_[0], o1); E4(C0, 4); SB(); \
        const bf16x8 va2 = tr2(Vb + 4096 + voff0), vb2 = tr2(Vb + 4096 + voff1), va3 = tr2(Vb + 6144 + voff0), vb3 = tr2(Vb + 6144 + voff1); \
        o0 = MFMA32(va1, PP_[1], o0); E4(C0, 8); SB(); \
        o1 = MFMA32(vb1, PP_[1], o1); E4(C0, 12); SB(); \
        o0 = MFMA32(va2, PP_[2], o0); PN_[0] = pack8(C0, 0); PN_[1] = pack8(C0, 8); SB(); \
        o1 = MFMA32(vb2, PP_[2], o1); E4(C1, 0); SB(); \
        KFR(Kb); \
        o0 = MFMA32(va3, PP_[3], o0); E4(C1, 4); SB(); \
        o1 = MFMA32(vb3, PP_[3], o1); E4(C1, 8); SB(); \
        E4(C1, 12); PN_[2] = pack8(C1, 0); PN_[3] = pack8(C1, 8); SB(); \
        QK4(N0, N1, k00, k10, k01, k11); \
        if (nx && (tt) + 1 >= 2 * qb) attn_mask(N0, N1, ((tt) + 1 - 2 * qb) * 64, qrel, hh); \
        asm volatile("s_waitcnt vmcnt(4)" ::: "memory"); asm volatile("s_waitcnt lgkmcnt(0)" ::: "memory"); __builtin_amdgcn_s_barrier(); asm volatile("" ::: "memory"); \
    } while (0)
    int t = 0;
    for (; t + 6 <= NT; t += 6) {
        ATT_STEP(sA0, sA1, sB0, sB1, pA, pB, t, (t == 0 ? 0 : 5), 1, 4);
        ATT_STEP(sB0, sB1, sA0, sA1, pB, pA, t + 1, 0, 2, 5);
        ATT_STEP(sA0, sA1, sB0, sB1, pA, pB, t + 2, 1, 3, 0);
        ATT_STEP(sB0, sB1, sA0, sA1, pB, pA, t + 3, 2, 4, 1);
        ATT_STEP(sA0, sA1, sB0, sB1, pA, pB, t + 4, 3, 5, 2);
        ATT_STEP(sB0, sB1, sA0, sA1, pB, pA, t + 5, 4, 0, 3);
    }
    if (t < NT) {
        ATT_STEP(sA0, sA1, sB0, sB1, pA, pB, t, (t == 0 ? 0 : 5), 1, 4);
        ATT_STEP(sB0, sB1, sA0, sA1, pB, pA, t + 1, 0, 2, 5);
        if (t + 2 < NT) {
            ATT_STEP(sA0, sA1, sB0, sB1, pA, pB, t + 2, 1, 3, 0);
            ATT_STEP(sB0, sB1, sA0, sA1, pB, pA, t + 3, 2, 4, 1);
        }
    }
#undef ATT_STEP
#undef QK4
#undef KFR
    { const LAS unsigned char* Vb = ring + ((NT - 1) % AT_NSLOT) * AT_SLOT;
#pragma unroll
      for (int kk = 0; kk < 4; ++kk) { o0 = MFMA32(tr2(Vb + kk * 2048 + voff0), pA[kk], o0); o1 = MFMA32(tr2(Vb + kk * 2048 + voff1), pA[kk], o1); } }
#undef E4
#undef SB
    l = xor32_add(l);
    const float inv = 1.0f / l;
    LAS float* cmb = (LAS float*)(lds + AT_CMB) + ws * 2048;
    if (comp == 1) {
#pragma unroll
        for (int i = 0; i < 16; ++i) { cmb[i * 64 + lane] = o0[i] * inv; cmb[(16 + i) * 64 + lane] = o1[i] * inv; }
    }
    asm volatile("s_waitcnt vmcnt(0) lgkmcnt(0)" ::: "memory"); __builtin_amdgcn_s_barrier(); asm volatile("" ::: "memory");
    {
        const bool hn = nqb >= 0; const int nqb_ = hn ? nqb : 0;
        if (hn) { const bf16* nk = proj + ((size_t)nb * SEQ + 8 * wid + (lane >> 3)) * PP + C_DK + nh * 64 + (((lane & 7) ^ (lane >> 3)) << 3); const int nnt = 2 * nqb + 2;
            DMA_TILE_P(nk, nnt, 0, 0); DMA_TILE_P(nk, nnt, 1, 1); DMA_TILE_P(nk, nnt, 2, 2); DMA_TILE_P(nk, nnt, 3, 3); }
        const bf16* nq = proj + ((size_t)nb * SEQ + nqb_ * 128) * PP + C_DQ + nh * 64;
#pragma unroll
        for (int i = 0; i < 2; ++i) { const int id = tid + 512 * i; qn[i] = *(const u32x4*)(nq + (size_t)(id >> 3) * PP + (id & 7) * 8); } }
#undef DMA_TILE_P
    if (comp == 0) {
        float ss = 0.f;
#pragma unroll
        for (int i = 0; i < 16; ++i) { o0[i] = o0[i] * inv - lam * cmb[i * 64 + lane]; o1[i] = o1[i] * inv - lam * cmb[(16 + i) * 64 + lane]; ss += o0[i] * o0[i] + o1[i] * o1[i]; }
        ss = xor32_add(ss);
        const float rn = rsqrtf(ss * (1.0f / 64.0f) + RMS_EPS) * oscale;
        bf16* orow = mix + (tb + qb * 128 + ws * 32 + r32) * 1024 + 768 + h * 64;
#pragma unroll
        for (int p = 0; p < 2; ++p) { u32x2 w0[2], w1[2];
#pragma unroll
            for (int q = 0; q < 2; ++q) { const int g4 = 2 * p + q, e0 = 8 * g4 + 4 * hh;
                const f32x4 n0 = *(const f32x4*)(normg + e0), n1 = *(const f32x4*)(normg + 32 + e0);
                w0[q].x = pk2(o0[4 * g4] * rn * n0[0], o0[4 * g4 + 1] * rn * n0[1]); w0[q].y = pk2(o0[4 * g4 + 2] * rn * n0[2], o0[4 * g4 + 3] * rn * n0[3]);
                w1[q].x = pk2(o1[4 * g4] * rn * n1[0], o1[4 * g4 + 1] * rn * n1[1]); w1[q].y = pk2(o1[4 * g4 + 2] * rn * n1[2], o1[4 * g4 + 3] * rn * n1[3]); }
            const auto ax = __builtin_amdgcn_permlane32_swap(w0[0].x, w0[1].x, false, false), ay = __builtin_amdgcn_permlane32_swap(w0[0].y, w0[1].y, false, false);
            const auto bx2 = __builtin_amdgcn_permlane32_swap(w1[0].x, w1[1].x, false, false), by2 = __builtin_amdgcn_permlane32_swap(w1[0].y, w1[1].y, false, false);
            u32x4 q0, q1; q0.x = ax[0]; q0.y = ay[0]; q0.z = ax[1]; q0.w = ay[1]; q1.x = bx2[0]; q1.y = by2[0]; q1.z = bx2[1]; q1.w = by2[1];
            *(u32x4*)(orow + 16 * p + 8 * hh) = q0; *(u32x4*)(orow + 32 + 16 * p + 8 * hh) = q1; }
    }
    __syncthreads();
}

__device__ __forceinline__ void conv_unit(const bf16* proj, bf16* mix, const float* cw, int t0) {
    const int tid = opaque_tid();
    const int c = 8 * (tid & 31), tg = tid >> 5;
    float w0[8], w1[8], w2[8];
#pragma unroll
    for (int i = 0; i < 8; ++i) { w0[i] = cw[c + i]; w1[i] = cw[256 + c + i]; w2[i] = cw[512 + c + i]; }
#pragma unroll
    for (int pass = 0; pass < 2; ++pass) {
        const int ts = t0 + pass * 64 + tg * 4, spos = ts & (SEQ - 1);
        float z[6][8];
#pragma unroll
        for (int r = 0; r < 6; ++r) {
            if (spos - 2 + r >= 0) { const bf16* p = proj + (size_t)(ts - 2 + r) * PP; const u32x4 u = *(const u32x4*)(p + C_CU + c), g = *(const u32x4*)(p + C_CGC + c);
                z[r][0] = bflo(u.x) * bflo(g.x); z[r][1] = bfhi(u.x) * bfhi(g.x); z[r][2] = bflo(u.y) * bflo(g.y); z[r][3] = bfhi(u.y) * bfhi(g.y);
                z[r][4] = bflo(u.z) * bflo(g.z); z[r][5] = bfhi(u.z) * bfhi(g.z); z[r][6] = bflo(u.w) * bflo(g.w); z[r][7] = bfhi(u.w) * bfhi(g.w); }
            else {
#pragma unroll
                for (int i = 0; i < 8; ++i) z[r][i] = 0.f; } }
#pragma unroll
        for (int r = 0; r < 4; ++r) { const u32x4 bb = *(const u32x4*)(proj + (size_t)(ts + r) * PP + C_CGB + c);
            const float g8[8] = {bflo(bb.x), bfhi(bb.x), bflo(bb.y), bfhi(bb.y), bflo(bb.z), bfhi(bb.z), bflo(bb.w), bfhi(bb.w)};
            float y[8];
#pragma unroll
            for (int i = 0; i < 8; ++i) y[i] = g8[i] * (w0[i] * z[r][i] + w1[i] * z[r + 1][i] + w2[i] * z[r + 2][i]);
            u32x4 o; o.x = pk2(y[0], y[1]); o.y = pk2(y[2], y[3]); o.z = pk2(y[4], y[5]); o.w = pk2(y[6], y[7]);
            *(u32x4*)(mix + (size_t)(ts + r) * 1024 + c) = o; }
    }
}

__device__ __forceinline__ void scan128(float& v0, float& v1, int lane) {
    float s = v0 + v1, inc = s;
#pragma unroll
    for (int o = 1; o < 64; o <<= 1) { const float t = shfl_from(inc, lane >= o ? lane - o : lane, lane); if (lane >= o) inc += t; }
    const float ex = inc - s; v0 = ex + v0; v1 = v0 + v1;
}

template <int ROWS, int NCOLS> struct TileRegs { static constexpr int CPR = NCOLS / 8, N = ROWS * CPR, IT = (N + NTHREADS - 1) / NTHREADS; u32x4 v[IT]; };
template <int ROWS, int NCOLS> __device__ __forceinline__ void tile_fetch(TileRegs<ROWS, NCOLS>& r, const bf16* src, int pitch, int tid) {
    typedef TileRegs<ROWS, NCOLS> TR;
#pragma unroll
    for (int i = 0; i < TR::IT; ++i) { int id = tid + NTHREADS * i; if (TR::N % NTHREADS != 0) id = id < TR::N ? id : TR::N - 1; const int row = id / TR::CPR, ch = id % TR::CPR; r.v[i] = *(const u32x4*)(src + (size_t)row * pitch + ch * 8); }
}
template <int NCOLS> __device__ __forceinline__ void conv_fetch(TileRegs<131, NCOLS>& r, const bf16* proj, int col, int t0, int tid) {
    typedef TileRegs<131, NCOLS> TR; const bool first = (t0 & (SEQ - 1)) == 0;
#pragma unroll
    for (int i = 0; i < TR::IT; ++i) { int id = tid + NTHREADS * i; id = id < TR::N ? id : TR::N - 1; const int row = id / TR::CPR, ch = id % TR::CPR; const bool z = first && row < 3;
        const u32x4 v = *(const u32x4*)(proj + (size_t)(t0 - 3 + (z ? 3 : row)) * PP + col + ch * 8); r.v[i] = z ? (u32x4){0u, 0u, 0u, 0u} : v; }
}
template <int ROWS, int NCOLS> __device__ __forceinline__ void tile_commit(const TileRegs<ROWS, NCOLS>& r, LAS unsigned char* dst, int dstride, int tid) {
    typedef TileRegs<ROWS, NCOLS> TR;
#pragma unroll
    for (int i = 0; i < TR::IT; ++i) { const int id = tid + NTHREADS * i; if (TR::N % NTHREADS == 0 || id < TR::N) { const int row = id / TR::CPR, ch = id % TR::CPR; *(LAS u32x4*)(dst + row * dstride + ch * 16) = r.v[i]; } }
}
struct ConvWin { float h0a, h0b, h1a, h1b, h2a, h2b; };
__device__ __forceinline__ void conv_win_init(ConvWin& w, const LAS unsigned char* tile, int stride, int col, int j0) {
    const unsigned u0 = *(const LAS unsigned*)(tile + j0 * stride + col * 2), u1 = *(const LAS unsigned*)(tile + (j0 + 1) * stride + col * 2), u2 = *(const LAS unsigned*)(tile + (j0 + 2) * stride + col * 2);
    w.h0a = bflo(u0); w.h0b = bfhi(u0); w.h1a = bflo(u1); w.h1b = bfhi(u1); w.h2a = bflo(u2); w.h2b = bfhi(u2);
}
__device__ __forceinline__ void conv_run(ConvWin& w, LAS unsigned char* tile, int stride, int col, int j0, int nj, const float* cw, const float* cb, int xc, const LAS float* sc, int scs) {
    const float w0a = cw[xc], w0b = cw[xc + 1], w1a = cw[768 + xc], w1b = cw[769 + xc], w2a = cw[1536 + xc], w2b = cw[1537 + xc], w3a = cw[2304 + xc], w3b = cw[2305 + xc];
    const float ba = cb[xc], bb = cb[xc + 1];
    unsigned raw[16];
#pragma unroll
    for (int i = 0; i < 16; ++i) raw[i] = *(const LAS unsigned*)(tile + (j0 + i + 3) * stride + col * 2);
#pragma unroll
    for (int i = 0; i < 16; ++i) { const int j = j0 + i;
        const unsigned u = raw[i]; const float xa = bflo(u), xb = bfhi(u);
        float ya = siluf(w0a * w.h0a + w1a * w.h1a + w2a * w.h2a + w3a * xa + ba), yb = siluf(w0b * w.h0b + w1b * w.h1b + w2b * w.h2b + w3b * xb + bb);
        if (sc) { const float f = sc[j * scs]; ya *= f; yb *= f; }
        *(LAS unsigned*)(tile + (j + 3) * stride + col * 2) = pk2(ya, yb);
        w.h0a = w.h1a; w.h0b = w.h1b; w.h1a = w.h2a; w.h1b = w.h2b; w.h2a = xa; w.h2b = xb; }
    (void)nj;
}

constexpr int SA_X = 0, SA_B = 69632, SA_DT = 139264, SA_SC = 141312, SA_OFF = 3 * 528;
__device__ __forceinline__ void ssd_a_unit(LAS unsigned char* lds, const Args& A, int l, const bf16* proj, int b, int ch) {
    const int tid = opaque_tid(), lane = tid & 63, wid = __builtin_amdgcn_readfirstlane(tid >> 6), r32 = lane & 31, hh = lane >> 5;
    const int t0 = b * SEQ + ch * 128;
    LAS float* dts = (LAS float*)(lds + SA_DT); LAS float* scs = (LAS float*)(lds + SA_SC);
    const float* alog = A.in[I_SSD_ALOG] + l * 4; const float* dtb = A.in[I_SSD_DTB] + l * 4;
    { TileRegs<131, 256> rx, rb; conv_fetch<256>(rx, proj, C_SX, t0, tid); conv_fetch<256>(rb, proj, C_SB, t0, tid);
      const unsigned short dt_raw = proj[(size_t)(t0 + (tid >> 2)) * PP + C_SDT + (tid & 3)];
      tile_commit<131, 256>(rx, lds + SA_X, 528, tid); tile_commit<131, 256>(rb, lds + SA_B, 528, tid);
      dts[(tid >> 2) * 4 + (tid & 3)] = softplusf(bf2f(dt_raw) + dtb[tid & 3]); }
    __syncthreads();
    ConvWin cwn[4];
#pragma unroll
    for (int k = 0; k < 4; ++k) { const int id = tid + NTHREADS * k, cp = id & 255, rg = id >> 8, xc = 2 * cp; conv_win_init(cwn[k], lds + (xc < 256 ? SA_X : SA_B), 528, xc & 255, rg * 16); }
    if (wid < 4) { const int hd = wid; const float a = -__expf(alog[hd]); const float d0 = dts[(2 * lane) * 4 + hd], d1 = dts[(2 * lane + 1) * 4 + hd];
        float c0 = d0 * a, c1 = d1 * a; scan128(c0, c1, lane);
        const float cl = shfl_from(c1, 63, lane);
        scs[(2 * lane) * 4 + hd] = d0 * __expf(cl - c0); scs[(2 * lane + 1) * 4 + hd] = d1 * __expf(cl - c1);
        if (lane == 0) ((float*)(A.ws + WS_SSDDEC))[(b * 16 + ch) * 4 + hd] = __expf(cl); }
    __syncthreads();
#pragma unroll
    for (int k = 0; k < 4; ++k) { const int id = tid + NTHREADS * k, cp = id & 255, rg = id >> 8, xc = 2 * cp;
        conv_run(cwn[k], lds + (xc < 256 ? SA_X : SA_B), 528, xc & 255, rg * 16, 16, A.in[I_SSD_CW] + l * 4 * 768, A.in[I_SSD_CB] + l * 768, xc, xc < 256 ? scs + (xc >> 6) : nullptr, 4); }
    __syncthreads();
    { const int hd = wid >> 1, tp = wid & 1, g = hd >> 1;
      const LAS unsigned char* Xd = lds + SA_X + SA_OFF; const LAS unsigned char* Bd = lds + SA_B + SA_OFF;
      f32x16 acc[4] = {ZERO16, ZERO16, ZERO16, ZERO16};
#pragma unroll 2
      for (int ks = 0; ks < 8; ++ks) { const bf16x8 a = fragT(Xd, 528, ks * 16, hd * 64 + tp * 32, lane);
#pragma unroll
          for (int tn = 0; tn < 4; ++tn) acc[tn] = MFMA32(a, fragT(Bd, 528, ks * 16, g * 128 + tn * 32, lane), acc[tn]); }
      float* st = (float*)(A.ws + A_ST) + ((size_t)((b * 16 + ch) * 4 + hd)) * 8192;
#pragma unroll
      for (int tn = 0; tn < 4; ++tn)
#pragma unroll
          for (int i = 0; i < 16; ++i) st[(tp * 32 + crow(i, hh)) * 128 + tn * 32 + r32] = acc[tn][i]; }
    __syncthreads();
}

__device__ __forceinline__ void gla_cum(const LAS unsigned char* lrs, LAS float* cum, const float* wlr, const float* blr, int tid) {
    LAS float* tot = cum + 64 * 128;
    const int col = tid & 127, seg = tid >> 7;
    float c16[16];
    { float w[16];
#pragma unroll
      for (int r = 0; r < 16; ++r) w[r] = wlr[r * 128 + col];
      const float bias = blr[col]; float run = 0.f;
#pragma unroll
      for (int i = 0; i < 16; ++i) { const int j = seg * 16 + i; const u32x4 a = *(const LAS u32x4*)(lrs + j * 48), c = *(const LAS u32x4*)(lrs + j * 48 + 16);
          float d = bias;
          d += bflo(a.x) * w[0] + bfhi(a.x) * w[1] + bflo(a.y) * w[2] + bfhi(a.y) * w[3] + bflo(a.z) * w[4] + bfhi(a.z) * w[5] + bflo(a.w) * w[6] + bfhi(a.w) * w[7];
          d += bflo(c.x) * w[8] + bfhi(c.x) * w[9] + bflo(c.y) * w[10] + bfhi(c.y) * w[11] + bflo(c.z) * w[12] + bfhi(c.z) * w[13] + bflo(c.w) * w[14] + bfhi(c.w) * w[15];
          run += logsigmoidf(d) * (1.0f / 16.0f); c16[i] = run; }
      tot[seg * 128 + col] = run; }
    __syncthreads();
    { float off = 0.f;
#pragma unroll
      for (int q = 0; q < 3; ++q) off += (q < seg) ? tot[q * 128 + col] : 0.f;
#pragma unroll
      for (int i = 0; i < 16; ++i) cum[(seg * 16 + i) * 128 + col] = c16[i] + off; }
    __syncthreads();
}
constexpr int GA_LR = 0, GA_K = 3072, GA_V = 20480, GA_CUM = 54272;
__device__ __forceinline__ void gla_a_unit(LAS unsigned char* lds, const Args& A, int l, const bf16* proj, int b, int ch) {
    const int tid = opaque_tid(), lane = tid & 63, wid = __builtin_amdgcn_readfirstlane(tid >> 6), r32 = lane & 31, hh = lane >> 5;
    const size_t t0 = (size_t)b * SEQ + ch * 64;
    LAS float* cum = (LAS float*)(lds + GA_CUM);
    { TileRegs<64, 16> rl; TileRegs<64, 128> rk; TileRegs<64, 256> rv;
      tile_fetch<64, 16>(rl, proj + t0 * PP + C_GLR, PP, tid); tile_fetch<64, 128>(rk, proj + t0 * PP + C_GK, PP, tid); tile_fetch<64, 256>(rv, proj + t0 * PP + C_GV, PP, tid);
      tile_commit<64, 16>(rl, lds + GA_LR, 48, tid); tile_commit<64, 128>(rk, lds + GA_K, 272, tid); tile_commit<64, 256>(rv, lds + GA_V, 528, tid); }
    __syncthreads();
    gla_cum(lds + GA_LR, cum, A.in[I_GLA_WLR] + l * 16 * 128, A.in[I_GLA_BLR] + l * 128, tid);
    if (tid < 128) ((float*)(A.ws + WS_GLACL))[(b * 32 + ch) * 128 + tid] = cum[63 * 128 + tid];
    for (int id = tid; id < 64 * 64; id += NTHREADS) { const int j = id >> 6, c = (id & 63) * 2;
        LAS unsigned* p = (LAS unsigned*)(lds + GA_K + j * 272 + c * 2); const unsigned u = *p;
        *p = pk2(bflo(u) * __expf(cum[63 * 128 + c] - cum[j * 128 + c]), bfhi(u) * __expf(cum[63 * 128 + c + 1] - cum[j * 128 + c + 1])); }
    __syncthreads();
    { const int h = wid >> 1, te = wid & 1; f32x16 acc = ZERO16;
#pragma unroll
      for (int ks = 0; ks < 4; ++ks) acc = MFMA32(fragT(lds + GA_K, 272, ks * 16, h * 32, lane), fragT(lds + GA_V, 528, ks * 16, h * 64 + te * 32, lane), acc);
      float* ds = (float*)(A.ws + A_DST) + ((size_t)((b * 32 + ch) * 4 + h)) * 2048;
#pragma unroll
      for (int i = 0; i < 16; ++i) ds[crow(i, hh) * 64 + te * 32 + r32] = acc[i]; }
    __syncthreads();
}
constexpr int SM_X = 816, SM_B = 35840 + 816, SM_C = 71680 + 816, SM_S = 107520, SM_DT = 142336, SM_CUM = 143360, SM_RED = 144384;
__device__ __forceinline__ void ssd_main_unit(LAS unsigned char* lds, const Args& A, int l, const bf16* proj, bf16* mix, int b, int ch, int g) {
    const int tid = opaque_tid(), lane = tid & 63, wid = __builtin_amdgcn_readfirstlane(tid >> 6), r32 = lane & 31, hh = lane >> 5;
    const int t0 = b * SEQ + ch * 128;
    LAS float* dts = (LAS float*)(lds + SM_DT); LAS float* cums = (LAS float*)(lds + SM_CUM); LAS float* red = (LAS float*)(lds + SM_RED);
    TileRegs<128, 128> rz;
    const unsigned short dt_raw = proj[(size_t)(t0 + ((tid & 255) >> 1)) * PP + C_SDT + 2 * g + (tid & 1)];
    { const bf16* sp = (const bf16*)(A.ws + A_SP) + ((size_t)((b * 16 + ch) * 4 + 2 * g)) * 8192;
      TileRegs<128, 128> rs; TileRegs<131, 128> rx, rb, rc;
      tile_fetch<128, 128>(rs, sp, 128, tid);
      conv_fetch<128>(rx, proj, C_SX + g * 128, t0, tid); conv_fetch<128>(rb, proj, C_SB + g * 128, t0, tid); conv_fetch<128>(rc, proj, C_SC + g * 128, t0, tid);
      tile_fetch<128, 128>(rz, proj + (size_t)t0 * PP + C_SZ + g * 128, PP, tid);
      tile_commit<128, 128>(rs, lds + SM_S, 272, tid);
      tile_commit<131, 128>(rx, lds + SM_X - 816, 272, tid); tile_commit<131, 128>(rb, lds + SM_B - 816, 272, tid); tile_commit<131, 128>(rc, lds + SM_C - 816, 272, tid); }
    if (tid < 256) { const int j = tid >> 1, r = tid & 1; dts[j * 2 + r] = softplusf(bf2f(dt_raw) + A.in[I_SSD_DTB][l * 4 + 2 * g + r]); }
    __syncthreads();
    if (wid < 2) { const int r = wid; const float a = -__expf(A.in[I_SSD_ALOG][l * 4 + 2 * g + r]); float c0 = dts[(2 * lane) * 2 + r] * a, c1 = dts[(2 * lane + 1) * 2 + r] * a; scan128(c0, c1, lane);
        cums[(2 * lane) * 2 + r] = c0; cums[(2 * lane + 1) * 2 + r] = c1; }
    { ConvWin cwn[3];
#pragma unroll
      for (int k = 0; k < 3; ++k) { const int id = tid + NTHREADS * k, cp = id % 192, rg = id / 192, c2 = 2 * cp, sel = c2 >> 7, cc = c2 & 127;
          conv_win_init(cwn[k], lds + (sel == 0 ? SM_X : sel == 1 ? SM_B : SM_C) - 816, 272, cc, rg * 16); }
      __syncthreads();
#pragma unroll
      for (int k = 0; k < 3; ++k) { const int id = tid + NTHREADS * k, cp = id % 192, rg = id / 192, c2 = 2 * cp, sel = c2 >> 7, cc = c2 & 127;
          conv_run(cwn[k], lds + (sel == 0 ? SM_X : sel == 1 ? SM_B : SM_C) - 816, 272, cc, rg * 16, 16, A.in[I_SSD_CW] + l * 4 * 768, A.in[I_SSD_CB] + l * 768, sel * 256 + g * 128 + cc, nullptr, 0); } }
    __syncthreads();
    const int ti = wid & 3, tp = wid >> 2;
    f32x16 cb0 = ZERO16, cb1 = ZERO16, of0 = ZERO16, of1 = ZERO16;
#pragma unroll 2
    for (int ks = 0; ks < 8; ++ks) { const bf16x8 cf = fragN(lds + SM_C, 272, ti * 32, ks * 16, lane);
        cb0 = MFMA32(fragN(lds + SM_B, 272, (2 * tp) * 32, ks * 16, lane), cf, cb0); cb1 = MFMA32(fragN(lds + SM_B, 272, (2 * tp + 1) * 32, ks * 16, lane), cf, cb1);
        of0 = MFMA32(fragN(lds + SM_S, 272, tp * 32, ks * 16, lane), cf, of0); of1 = MFMA32(fragN(lds + SM_S + 17408, 272, tp * 32, ks * 16, lane), cf, of1); }
    __syncthreads();
    const int irow = ti * 32 + r32;
    f32x16 dg[2] = {ZERO16, ZERO16};
#pragma unroll
    for (int r = 0; r < 2; ++r) {
        const float ci = cums[irow * 2 + r];
#pragma unroll
        for (int s = 0; s < 2; ++s) { const f32x16& cbv = s ? cb1 : cb0; const int jb = (2 * tp + s) * 32;
#pragma unroll
            for (int g4 = 0; g4 < 4; ++g4) { float w[4];
#pragma unroll
                for (int e = 0; e < 4; ++e) { const int j = jb + 8 * g4 + 4 * hh + e; w[e] = (j <= irow) ? cbv[4 * g4 + e] * __expf(ci - cums[j * 2 + r]) * dts[j * 2 + r] : 0.f; }
                u32x2 o; o.x = pk2(w[0], w[1]); o.y = pk2(w[2], w[3]); *(LAS u32x2*)(lds + SM_B + irow * 272 + (jb + 8 * g4 + 4 * hh) * 2) = o; } }
        __syncthreads();
#pragma unroll 2
        for (int ks = 0; ks < 8; ++ks) dg[r] = MFMA32(fragT(lds + SM_X, 272, ks * 16, r * 64 + tp * 32, lane), fragN(lds + SM_B, 272, ti * 32, ks * 16, lane), dg[r]);
        __syncthreads();
    }
    tile_commit<128, 128>(rz, lds + SM_B, 272, tid);
    __syncthreads();
    float ss = 0.f;
#pragma unroll
    for (int r = 0; r < 2; ++r) { const float ec = __expf(cums[irow * 2 + r]), dsk = A.in[I_SSD_D][l * 4 + 2 * g + r]; const f32x16& ofv = r ? of1 : of0;
#pragma unroll
        for (int g4 = 0; g4 < 4; ++g4) { const int col = r * 64 + tp * 32 + 8 * g4 + 4 * hh;
            const u32x2 xu = *(const LAS u32x2*)(lds + SM_X + irow * 272 + col * 2), zu = *(const LAS u32x2*)(lds + SM_B + irow * 272 + col * 2);
            const float xv[4] = {bflo(xu.x), bfhi(xu.x), bflo(xu.y), bfhi(xu.y)}, zv[4] = {bflo(zu.x), bfhi(zu.x), bflo(zu.y), bfhi(zu.y)};
#pragma unroll
            for (int e = 0; e < 4; ++e) { const int i = 4 * g4 + e; const float y = (dg[r][i] + ec * ofv[i] + dsk * xv[e]) * siluf(zv[e]); dg[r][i] = y; ss += y * y; } } }
    ss = xor32_add(ss);
    if (hh == 0) red[tp * 128 + irow] = ss;
    __syncthreads();
    const float rn = rsqrtf((red[irow] + red[128 + irow]) * (1.0f / 128.0f) + RMS_EPS);
    const float* ng = A.in[I_SSD_NG] + l * 256 + g * 128;
    bf16* orow = mix + (size_t)(t0 + irow) * 1024 + 512 + g * 128;
#pragma unroll
    for (int r = 0; r < 2; ++r)
#pragma unroll
        for (int p = 0; p < 2; ++p) { u32x2 o[2];
#pragma unroll
            for (int q = 0; q < 2; ++q) { const int g4 = 2 * p + q, c0 = r * 64 + tp * 32 + 8 * g4 + 4 * hh; const f32x4 nv = *(const f32x4*)(ng + c0);
                o[q].x = pk2(dg[r][4 * g4] * rn * nv[0], dg[r][4 * g4 + 1] * rn * nv[1]); o[q].y = pk2(dg[r][4 * g4 + 2] * rn * nv[2], dg[r][4 * g4 + 3] * rn * nv[3]); }
            *(u32x4*)(orow + r * 64 + tp * 32 + 16 * p + 8 * hh) = pair16(o[0], o[1]); }
    __syncthreads();
}

constexpr int GM_LR = 0, GM_Q = 3072, GM_K = 20480, GM_V = 37888, GM_E = 71680, GM_S = 108544;
__device__ __forceinline__ void gla_main_unit(LAS unsigned char* lds, const Args& A, int l, const bf16* proj, bf16* mix, int b, int ch) {
    const int tid = opaque_tid(), lane = tid & 63, wid = __builtin_amdgcn_readfirstlane(tid >> 6), r32 = lane & 31, hh = lane >> 5;
    const size_t t0 = (size_t)b * SEQ + ch * 64;
    LAS float* cum = (LAS float*)(lds + GM_E);
    TileRegs<64, 256> rg;
    { TileRegs<64, 16> rl; TileRegs<64, 128> rq, rk; TileRegs<64, 256> rv; TileRegs<128, 64> rs;
      tile_fetch<64, 16>(rl, proj + t0 * PP + C_GLR, PP, tid); tile_fetch<64, 128>(rq, proj + t0 * PP + C_GQ, PP, tid); tile_fetch<64, 128>(rk, proj + t0 * PP + C_GK, PP, tid);
      tile_fetch<64, 256>(rv, proj + t0 * PP + C_GV, PP, tid);
      tile_fetch<128, 64>(rs, (const bf16*)(A.ws + A_GP) + ((size_t)(b * 32 + ch) * 4) * 2048, 64, tid);
      tile_fetch<64, 256>(rg, proj + t0 * PP + C_GG, PP, tid);
      tile_commit<64, 16>(rl, lds + GM_LR, 48, tid); tile_commit<64, 128>(rq, lds + GM_Q, 272, tid); tile_commit<64, 128>(rk, lds + GM_K, 272, tid);
      tile_commit<64, 256>(rv, lds + GM_V, 528, tid); tile_commit<128, 64>(rs, lds + GM_S, 144, tid); }
    __syncthreads();
    gla_cum(lds + GM_LR, cum, A.in[I_GLA_WLR] + l * 16 * 128, A.in[I_GLA_BLR] + l * 128, tid);
    for (int id = tid; id < 64 * 64; id += NTHREADS) { const int j = id >> 6, c = (id & 63) * 2; const float c0 = cum[j * 128 + c], c1 = cum[j * 128 + c + 1];
        LAS unsigned* qp = (LAS unsigned*)(lds + GM_Q + j * 272 + c * 2); LAS unsigned* kp = (LAS unsigned*)(lds + GM_K + j * 272 + c * 2); const unsigned qu = *qp, ku = *kp;
        *qp = pk2(bflo(qu) * 0.17677669529663687f * __expf(c0), bfhi(qu) * 0.17677669529663687f * __expf(c1));
        *kp = pk2(bflo(ku) * __expf(-c0), bfhi(ku) * __expf(-c1)); }
    __syncthreads();
    const int h = wid >> 1, ti = wid & 1, irow = ti * 32 + r32;
    { f32x16 a0 = ZERO16, a1 = ZERO16;
#pragma unroll
      for (int ks = 0; ks < 2; ++ks) { const bf16x8 qf = fragN(lds + GM_Q, 272, ti * 32, h * 32 + ks * 16, lane);
          a0 = MFMA32(fragN(lds + GM_K, 272, 0, h * 32 + ks * 16, lane), qf, a0); a1 = MFMA32(fragN(lds + GM_K, 272, 32, h * 32 + ks * 16, lane), qf, a1); }
      LAS unsigned char* ar = lds + GM_E + h * 9216 + irow * 144;
#pragma unroll
      for (int g4 = 0; g4 < 4; ++g4) { float w0[4], w1[4];
#pragma unroll
          for (int e = 0; e < 4; ++e) { const int j = 8 * g4 + 4 * hh + e; w0[e] = (j <= irow) ? a0[4 * g4 + e] : 0.f; w1[e] = (j + 32 <= irow) ? a1[4 * g4 + e] : 0.f; }
          u32x2 o0, o1; o0.x = pk2(w0[0], w0[1]); o0.y = pk2(w0[2], w0[3]); o1.x = pk2(w1[0], w1[1]); o1.y = pk2(w1[2], w1[3]);
          *(LAS u32x2*)(ar + (8 * g4 + 4 * hh) * 2) = o0; *(LAS u32x2*)(ar + (32 + 8 * g4 + 4 * hh) * 2) = o1; } }
    __syncthreads();
    f32x16 o[2] = {ZERO16, ZERO16};
#pragma unroll
    for (int te = 0; te < 2; ++te) {
#pragma unroll
        for (int ks = 0; ks < 4; ++ks) o[te] = MFMA32(fragT(lds + GM_V, 528, ks * 16, h * 64 + te * 32, lane), fragN(lds + GM_E + h * 9216, 144, ti * 32, ks * 16, lane), o[te]);
#pragma unroll
        for (int ks = 0; ks < 2; ++ks) o[te] = MFMA32(fragT(lds + GM_S + h * 4608, 144, ks * 16, te * 32, lane), fragN(lds + GM_Q, 272, ti * 32, h * 32 + ks * 16, lane), o[te]); }
    __syncthreads();
    tile_commit<64, 256>(rg, lds + GM_V, 528, tid);
    __syncthreads();
    { float ss = 0.f;
#pragma unroll
      for (int i = 0; i < 16; ++i) ss += o[0][i] * o[0][i] + o[1][i] * o[1][i];
      ss = xor32_add(ss);
      const float rn = rsqrtf(ss * (1.0f / 64.0f) + RMS_EPS);
      const float* ng = A.in[I_GLA_NG] + l * 64;
      bf16* orow = mix + (t0 + irow) * 1024 + 256 + h * 64;
#pragma unroll
      for (int te = 0; te < 2; ++te)
#pragma unroll
          for (int p = 0; p < 2; ++p) { u32x2 w[2];
#pragma unroll
              for (int q = 0; q < 2; ++q) { const int g4 = 2 * p + q, e0 = te * 32 + 8 * g4 + 4 * hh; const f32x4 nv = *(const f32x4*)(ng + e0);
                  const u32x2 gz = *(const LAS u32x2*)(lds + GM_V + irow * 528 + (h * 64 + e0) * 2);
                  w[q].x = pk2(o[te][4 * g4] * rn * nv[0] * siluf(bflo(gz.x)), o[te][4 * g4 + 1] * rn * nv[1] * siluf(bfhi(gz.x)));
                  w[q].y = pk2(o[te][4 * g4 + 2] * rn * nv[2] * siluf(bflo(gz.y)), o[te][4 * g4 + 3] * rn * nv[3] * siluf(bfhi(gz.y))); }
              *(u32x4*)(orow + te * 32 + 16 * p + 8 * hh) = pair16(w[0], w[1]); } }
    __syncthreads();
}

__device__ __forceinline__ void scan_phase(const Args& A, int gtid, int gthreads) {
    for (int gi = gtid; gi < NB * 4 * 2048; gi += gthreads) {
        const int bh = gi >> 11, b = bh >> 2, h = bh & 3, i4 = (gi & 2047) * 4;
        const float* st = (const float*)(A.ws + A_ST) + ((size_t)(b * 16) * 4 + h) * 8192 + i4;
        const float* dec = (const float*)(A.ws + WS_SSDDEC) + (b * 16) * 4 + h;
        bf16* sp = (bf16*)(A.ws + A_SP) + ((size_t)(b * 16) * 4 + h) * 8192 + i4;
        f32x4 v[16];
#pragma unroll
        for (int c = 0; c < 16; ++c) v[c] = *(const f32x4*)(st + (size_t)c * 4 * 8192);
        f32x4 s = {0.f, 0.f, 0.f, 0.f};
#pragma unroll
        for (int c = 0; c < 16; ++c) { u32x2 o; o.x = pk2(s[0], s[1]); o.y = pk2(s[2], s[3]); *(u32x2*)(sp + (size_t)c * 4 * 8192) = o; s = s * dec[c * 4] + v[c]; }
    }
    for (int gi = gtid; gi < NB * 4 * 2048; gi += gthreads) {
        const int bh = gi >> 11, b = bh >> 2, h = bh & 3, idx = gi & 2047, d = idx >> 6;
        const float* ds = (const float*)(A.ws + A_DST) + ((size_t)(b * 32) * 4 + h) * 2048 + idx;
        const float* cl = (const float*)(A.ws + WS_GLACL) + (size_t)(b * 32) * 128 + h * 32 + d;
        bf16* gp = (bf16*)(A.ws + A_GP) + ((size_t)(b * 32) * 4 + h) * 2048 + idx;
        float v[32], dc[32];
#pragma unroll
        for (int c = 0; c < 32; ++c) { v[c] = ds[(size_t)c * 4 * 2048]; dc[c] = cl[c * 128]; }
        float s = 0.f;
#pragma unroll
        for (int c = 0; c < 32; ++c) { gp[(size_t)c * 4 * 2048] = f2bf(s); s = s * __expf(dc[c]) + v[c]; }
    }
}
constexpr int R4_W = 0, R4_WS = 99072, R4_G = 124672, R4_B = 128768, R4_HIST = 132864, R4_CS = 132992, R4_ASG = 133376;
__device__ __forceinline__ void p4_route(LAS unsigned char* lds, const Args& A, int l, int blk) {
    const int tid = opaque_tid(), lane = tid & 63, wid = __builtin_amdgcn_readfirstlane(tid >> 6);
    const bf16* v = (const bf16*)(A.ws + A_V); bf16* x1 = (bf16*)(A.ws + A_X1);
    { const bf16* wrt = (const bf16*)(A.ws + WS_WRT + l * WRT_LAYER);
      { TileRegs<48, 1024> rt; tile_fetch<48, 1024>(rt, wrt, 1024, tid); tile_commit<48, 1024>(rt, lds + R4_W, 2064, tid); }
      LAS float* gs = (LAS float*)(lds + R4_G); LAS float* bs = (LAS float*)(lds + R4_B);
      for (int k = tid; k < 1024; k += NTHREADS) { gs[k] = A.in[I_LN1G][l * 1024 + k]; bs[k] = A.in[I_LN1B][l * 1024 + k]; }
      if (tid < 32) ((LAS int*)(lds + R4_HIST))[tid] = 0;
      if (tid < 96) ((LAS float*)(lds + R4_CS))[tid] = ((const float*)(A.ws + WS_RCS + l * WRT_LAYER))[tid]; }
    __syncthreads();
    const int tok0 = blk * 128 + wid * 16, fr = lane & 15, fq = lane >> 4;
    LAS float* stat = (LAS float*)(lds + R4_WS + wid * 3200); LAS float* lg = stat + 32;
    const LAS float* cs = (const LAS float*)(lds + R4_CS);
    pg8::f32x4 acc[3] = {{0.f, 0.f, 0.f, 0.f}, {0.f, 0.f, 0.f, 0.f}, {0.f, 0.f, 0.f, 0.f}};
    float s1 = 0.f, s2 = 0.f;
    const bf16* vrow = v + (size_t)(tok0 + fr) * 1024 + 8 * fq;
#pragma unroll 8
    for (int s = 0; s < 32; ++s) {
        const u32x4 au = *(const u32x4*)(vrow + 32 * s); const bf16x8 a = __builtin_bit_cast(bf16x8, au);
#pragma unroll
        for (int bk = 0; bk < 3; ++bk) { const bf16x8 bfr = *(const LAS bf16x8*)(lds + R4_W + (bk * 16 + fr) * 2064 + (32 * s + 8 * fq) * 2);
            acc[bk] = __builtin_amdgcn_mfma_f32_16x16x32_bf16(a, bfr, acc[bk], 0, 0, 0); }
        const float e0 = bflo(au.x), e1 = bfhi(au.x), e2 = bflo(au.y), e3 = bfhi(au.y), e4 = bflo(au.z), e5 = bfhi(au.z), e6 = bflo(au.w), e7 = bfhi(au.w);
        s1 += ((e0 + e1) + (e2 + e3)) + ((e4 + e5) + (e6 + e7));
        s2 += ((e0 * e0 + e1 * e1) + (e2 * e2 + e3 * e3)) + ((e4 * e4 + e5 * e5) + (e6 * e6 + e7 * e7));
    }
    s1 += shflx(s1, 16, lane); s1 = xor32_add(s1); s2 += shflx(s2, 16, lane); s2 = xor32_add(s2);
    { const float mean = s1 * (1.0f / 1024.0f), var = fmaxf(s2 * (1.0f / 1024.0f) - mean * mean, 0.f), rstd = rsqrtf(var + LN_EPS);
      if (lane < 16) { stat[2 * lane] = mean; stat[2 * lane + 1] = rstd; f32x2 mr; mr.x = mean; mr.y = rstd; ((f32x2*)(A.ws + WS_LNSTAT))[tok0 + lane] = mr; } }
#pragma unroll
    for (int r = 0; r < 4; ++r) { const int tk = 4 * fq + r; const float mean = stat[2 * tk], rstd = stat[2 * tk + 1];
#pragma unroll
        for (int bk = 0; bk < 3; ++bk) { const int j = bk * 16 + fr; lg[tk * 48 + j] = rstd * (acc[bk][r] - mean * cs[j]) + cs[48 + j]; } }
    if (lane < 16) {
        const LAS float* q = lg + lane * 48;
        int grp = 0; float gm = q[0];
#pragma unroll
        for (int i = 1; i < 4; ++i) if (q[i] > gm) { gm = q[i]; grp = i; }
        float gsum = 0.f;
#pragma unroll
        for (int i = 0; i < 4; ++i) gsum += __expf(q[i] - gm);
        const float pg = 1.0f / gsum;
        float el[8];
#pragma unroll
        for (int i = 0; i < 8; ++i) el[i] = q[4 + grp * 8 + i];
        int i1 = 0; float m1 = el[0];
#pragma unroll
        for (int i = 1; i < 8; ++i) if (el[i] > m1) { m1 = el[i]; i1 = i; }
        int i2 = -1; float m2 = -INFINITY;
#pragma unroll
        for (int i = 0; i < 8; ++i) if (i != i1 && el[i] > m2) { m2 = el[i]; i2 = i; }
        const float p2 = __expf(m2 - m1), den = 1.0f / (1.0f + p2);
        const int tokn = tok0 + lane, ex1 = grp * 8 + i1, ex2 = grp * 8 + i2;
        LAS int* hist = (LAS int*)(lds + R4_HIST);
        const int r1 = atomicAdd((int*)(hist + ex1), 1), r2 = atomicAdd((int*)(hist + ex2), 1);
        LAS int* ae = (LAS int*)(lds + R4_ASG); LAS float* ag = (LAS float*)(lds + R4_ASG + 1024); LAS int* ar = (LAS int*)(lds + R4_ASG + 2048); const int lt = wid * 16 + lane; (void)tokn;
        ae[2 * lt] = ex1; ae[2 * lt + 1] = ex2; ag[2 * lt] = pg * den; ag[2 * lt + 1] = pg * p2 * den; ar[2 * lt] = r1; ar[2 * lt + 1] = r2;
    }
    __syncthreads();
    if (tid < NSLOT_MAX / 256) ((int*)(A.ws + WS_SLOTTOK))[blk * (NSLOT_MAX / 256) + tid] = 0;
    if (tid < 32) __hip_atomic_store((int*)(A.ws + WS_WGCNT) + blk * 32 + tid, ((LAS int*)(lds + R4_HIST))[tid], __ATOMIC_RELAXED, __HIP_MEMORY_SCOPE_AGENT);
    asm volatile("s_waitcnt vmcnt(0)" ::: "memory"); __syncthreads();
    unsigned* pubcnt = (unsigned*)(A.ws + WS_BAR + 14336) + l * 64;
    if (tid == 0) __hip_atomic_fetch_add(pubcnt, 1u, __ATOMIC_RELAXED, __HIP_MEMORY_SCOPE_AGENT);
    { const LAS float* gs = (const LAS float*)(lds + R4_G); const LAS float* bs = (const LAS float*)(lds + R4_B); unsigned char* x8 = A.ws + A_X8;
      for (int tk0 = 0; tk0 < 16; tk0 += 8) {
          u32x4 uu[8][2];
#pragma unroll
          for (int q = 0; q < 8; ++q)
#pragma unroll
              for (int i = 0; i < 2; ++i) uu[q][i] = *(const u32x4*)(v + (size_t)(tok0 + tk0 + q) * 1024 + (lane + 64 * i) * 8);
#pragma unroll
          for (int q = 0; q < 8; ++q) { const int tk = tk0 + q; const float mean = stat[2 * tk], rstd = stat[2 * tk + 1];
#pragma unroll
              for (int i = 0; i < 2; ++i) { const int k0 = (lane + 64 * i) * 8; const u32x4 u = uu[q][i];
                  const f32x4 ga = *(const LAS f32x4*)(gs + k0), gb = *(const LAS f32x4*)(gs + k0 + 4), ba = *(const LAS f32x4*)(bs + k0), bb = *(const LAS f32x4*)(bs + k0 + 4);
                  const float y0 = (bflo(u.x) - mean) * rstd * ga[0] + ba[0], y1 = (bfhi(u.x) - mean) * rstd * ga[1] + ba[1], y2 = (bflo(u.y) - mean) * rstd * ga[2] + ba[2], y3 = (bfhi(u.y) - mean) * rstd * ga[3] + ba[3];
                  const float y4 = (bflo(u.z) - mean) * rstd * gb[0] + bb[0], y5 = (bfhi(u.z) - mean) * rstd * gb[1] + bb[1], y6 = (bflo(u.w) - mean) * rstd * gb[2] + bb[2], y7 = (bfhi(u.w) - mean) * rstd * gb[3] + bb[3];
                  u32x4 o; o.x = pk2(y0, y1); o.y = pk2(y2, y3); o.z = pk2(y4, y5); o.w = pk2(y6, y7);
                  if (!MOE_FP8) *(u32x4*)(x1 + (size_t)(tok0 + tk) * 1024 + k0) = o;
                  if (MOE_FP8) { u32x2 qv; qv.x = pg8::pk4_fp8(8.f * y0, 8.f * y1, 8.f * y2, 8.f * y3); qv.y = pg8::pk4_fp8(8.f * y4, 8.f * y5, 8.f * y6, 8.f * y7); *(u32x2*)(x8 + (size_t)(tok0 + tk) * 1024 + k0) = qv; } } } } }
    if (tid == 0) { unsigned sp = 0; while (__hip_atomic_load(pubcnt, __ATOMIC_RELAXED, __HIP_MEMORY_SCOPE_AGENT) < (unsigned)gridDim.x) { __builtin_amdgcn_s_sleep(2); if (++sp > (1u << 22)) break; }
        }
    __syncthreads();
    LAS int* base = (LAS int*)lds;
    const int* wgc = (const int*)(A.ws + WS_WGCNT);
    LAS int* part_tot = base + 128; LAS int* part_bef = part_tot + 512;
    { const int e = tid & 31, part = tid >> 5; int tot = 0, before = 0;
#pragma unroll
      for (int i = 0; i < 16; ++i) { const int w = part * 16 + i; const int c = __hip_atomic_load(wgc + w * 32 + e, __ATOMIC_RELAXED, __HIP_MEMORY_SCOPE_AGENT); tot += c; before += (w < blk) ? c : 0; }
      part_tot[part * 32 + e] = tot; part_bef[part * 32 + e] = before; }
    __syncthreads();
    if (tid < 32) {
        int tot = 0, before = 0;
#pragma unroll
        for (int p = 0; p < 16; ++p) { tot += part_tot[p * 32 + tid]; before += part_bef[p * 32 + tid]; }
        const int padded = (tot + 255) & ~255;
        int inc = padded;
#pragma unroll
        for (int o = 1; o < 32; o <<= 1) { const int t = __builtin_amdgcn_ds_bpermute((lane >= o ? lane - o : lane) << 2, inc); if (lane >= o) inc += t; }
        const int start = inc - padded;
        base[tid] = start + before;
        if (blk == 0) { int* be = (int*)(A.ws + WS_BLKEXP); for (int k = 0; k < (padded >> 8); ++k) be[(start >> 8) + k] = tid; be[NBLK_MAX + 1 + tid] = start >> 8; if (tid == 31) { be[NBLK_MAX] = inc >> 8; be[NBLK_MAX + 33] = inc >> 8; } }
    }
    __syncthreads();
    if (tid < 256) { const LAS int* ae = (const LAS int*)(lds + R4_ASG); const LAS float* ag = (const LAS float*)(lds + R4_ASG + 1024); const LAS int* ar = (const LAS int*)(lds + R4_ASG + 2048);
        const int a = blk * 256 + tid; const int slot = base[ae[tid]] + ar[tid]; ((int*)(A.ws + WS_SLOTOF))[a] = slot; ((float*)(A.ws + WS_SLOTGATE))[slot] = ag[tid]; ((int*)(A.ws + WS_SLOTTOK))[slot] = blk * 128 + (tid >> 1); }
    __syncthreads();
}

#ifndef P8_NT
#define P8_NT 4
#endif
__device__ __forceinline__ void p8_ln2(const Args& A, int l, bool last, int t0, int tstep, int ntok, int lane) {
    const bf16* x1 = (const bf16*)(A.ws + A_X1); const bf16* Y = (const bf16*)(A.ws + A_Y); const int* so = (const int*)(A.ws + WS_SLOTOF);
    bf16* xb = (bf16*)(A.ws + A_XB);
    const float* g2 = A.in[I_LN2G] + l * 1024; const float* b2 = A.in[I_LN2B] + l * 1024;
    f32x4 gv[4], bv[4];
#pragma unroll
    for (int i = 0; i < 2; ++i) { const int k0 = (lane + 64 * i) * 8; gv[2 * i] = *(const f32x4*)(g2 + k0); gv[2 * i + 1] = *(const f32x4*)(g2 + k0 + 4); bv[2 * i] = *(const f32x4*)(b2 + k0); bv[2 * i + 1] = *(const f32x4*)(b2 + k0 + 4); }
    const bf16* v = (const bf16*)(A.ws + A_V); const f32x2* lnst = (const f32x2*)(A.ws + WS_LNSTAT);
    f32x4 g1v[4], b1v[4];
#pragma unroll
    for (int i = 0; i < 2; ++i) { const int k0 = (lane + 64 * i) * 8; const float* g1 = A.in[I_LN1G] + l * 1024; const float* b1 = A.in[I_LN1B] + l * 1024;
        g1v[2 * i] = *(const f32x4*)(g1 + k0) * ALPHA; g1v[2 * i + 1] = *(const f32x4*)(g1 + k0 + 4) * ALPHA; b1v[2 * i] = *(const f32x4*)(b1 + k0) * ALPHA; b1v[2 * i + 1] = *(const f32x4*)(b1 + k0 + 4) * ALPHA; }
    static_assert(MOE_FP8, "p8_ln2 reads the fp8 expert outputs"); (void)x1;
    constexpr int NT = P8_NT;
    for (int kb = 0; kb < ntok; kb += NT) {
        int s0[NT], s1[NT]; f32x2 mr[NT]; u32x4 av[NT][2]; u32x2 ya[NT][2], yc[NT][2];
#pragma unroll
        for (int n = 0; n < NT; ++n) { const int t = t0 + min(kb + n, ntok - 1) * tstep; s0[n] = so[2 * t]; s1[n] = so[2 * t + 1]; mr[n] = lnst[t];
#pragma unroll
            for (int i = 0; i < 2; ++i) av[n][i] = *(const u32x4*)(v + (size_t)t * 1024 + (lane + 64 * i) * 8); }
#pragma unroll
        for (int n = 0; n < NT; ++n)
#pragma unroll
            for (int i = 0; i < 2; ++i) { const int k0 = (lane + 64 * i) * 8; const unsigned char* Y8 = (const unsigned char*)Y; ya[n][i] = *(const u32x2*)(Y8 + (size_t)s0[n] * 1024 + k0); yc[n][i] = *(const u32x2*)(Y8 + (size_t)s1[n] * 1024 + k0); }
#pragma unroll
        for (int n = 0; n < NT; ++n) { const int t = t0 + (kb + n) * tstep; if (kb + n < ntok) {
        float x[16]; float sum = 0.f;
#pragma unroll
        for (int i = 0; i < 2; ++i) { const u32x4 a = av[n][i]; const u32x2 y0 = ya[n][i], y1 = yc[n][i];
                typedef float f32x2_ __attribute__((ext_vector_type(2)));
                const f32x2_ a0 = __builtin_amdgcn_cvt_pk_f32_fp8(y0.x, false), a1 = __builtin_amdgcn_cvt_pk_f32_fp8(y0.x, true), a2 = __builtin_amdgcn_cvt_pk_f32_fp8(y0.y, false), a3 = __builtin_amdgcn_cvt_pk_f32_fp8(y0.y, true);
                const f32x2_ b0 = __builtin_amdgcn_cvt_pk_f32_fp8(y1.x, false), b1 = __builtin_amdgcn_cvt_pk_f32_fp8(y1.x, true), b2 = __builtin_amdgcn_cvt_pk_f32_fp8(y1.y, false), b3 = __builtin_amdgcn_cvt_pk_f32_fp8(y1.y, true);
                const float ys = 1.0f / 64.0f;
                const float mean = mr[n].x, rstd = mr[n].y; const f32x4 ga = g1v[2 * i], gb = g1v[2 * i + 1], ba = b1v[2 * i], bb = b1v[2 * i + 1];
                x[8 * i + 0] = ((bflo(a.x) - mean) * rstd * ga[0] + ba[0]) + (a0[0] + b0[0]) * ys; x[8 * i + 1] = ((bfhi(a.x) - mean) * rstd * ga[1] + ba[1]) + (a0[1] + b0[1]) * ys;
                x[8 * i + 2] = ((bflo(a.y) - mean) * rstd * ga[2] + ba[2]) + (a1[0] + b1[0]) * ys; x[8 * i + 3] = ((bfhi(a.y) - mean) * rstd * ga[3] + ba[3]) + (a1[1] + b1[1]) * ys;
                x[8 * i + 4] = ((bflo(a.z) - mean) * rstd * gb[0] + bb[0]) + (a2[0] + b2[0]) * ys; x[8 * i + 5] = ((bfhi(a.z) - mean) * rstd * gb[1] + bb[1]) + (a2[1] + b2[1]) * ys;
                x[8 * i + 6] = ((bflo(a.w) - mean) * rstd * gb[2] + bb[2]) + (a3[0] + b3[0]) * ys; x[8 * i + 7] = ((bfhi(a.w) - mean) * rstd * gb[3] + bb[3]) + (a3[1] + b3[1]) * ys; }
#pragma unroll
        for (int u = 0; u < 16; ++u) sum += x[u];
        const float mean = wave_sum(sum, lane) * (1.0f / 1024.0f); float sq = 0.f;
#pragma unroll
        for (int u = 0; u < 16; ++u) { x[u] -= mean; sq += x[u] * x[u]; }
        const float rstd = rsqrtf(wave_sum(sq, lane) * (1.0f / 1024.0f) + LN_EPS);
#pragma unroll
        for (int i = 0; i < 2; ++i) { const int k0 = (lane + 64 * i) * 8;
            float o[8];
#pragma unroll
            for (int u = 0; u < 4; ++u) { o[u] = x[8 * i + u] * rstd * gv[2 * i][u] + bv[2 * i][u]; o[4 + u] = x[8 * i + 4 + u] * rstd * gv[2 * i + 1][u] + bv[2 * i + 1][u]; }
            if (last) { float* op = A.out + (size_t)t * 1024 + k0; *(f32x4*)op = (f32x4){o[0], o[1], o[2], o[3]}; *(f32x4*)(op + 4) = (f32x4){o[4], o[5], o[6], o[7]}; }
            else { u32x4 w; w.x = pk2(o[0], o[1]); w.y = pk2(o[2], o[3]); w.z = pk2(o[4], o[5]); w.w = pk2(o[6], o[7]); *(u32x4*)(xb + (size_t)t * 1024 + k0) = w; } }
        } }
    }
}
constexpr int LDS_ST = LDS_BYTES - 64;
#ifndef USE_CG_SYNC
#define SYNC() xcd_barrier(xbar)
#else
#define SYNC() grid.sync()
#endif
#ifndef SKIP_MASK
#define SKIP_MASK 0
#endif
#define ON(k) (!((SKIP_MASK) & (1 << (k))))
#ifndef DUP_PHASE
#define DUP_PHASE -1
#endif
#ifndef DUP_SUB
#define DUP_SUB -1
#endif
#define REPS(k) for (int reps_ = 0; reps_ < ((DUP_SUB) == (k) ? 2 : 1); ++reps_)
#define REP(k) for (int rep_ = 0; rep_ < ((DUP_PHASE) == (k) ? 2 : 1); ++rep_)
__global__ void __launch_bounds__(NTHREADS, 2) fwd_kernel(Args A) {
    extern __shared__ __attribute__((aligned(16))) unsigned char lds_raw[];
    LAS unsigned char* lds = (LAS unsigned char*)lds_raw;
#ifdef USE_CG_SYNC
    cg::grid_group grid = cg::this_grid();
#endif
    const int G = gridDim.x, ngw = G * NWAVES;
#define WAVE_IDS() const int tid = opaque_tid(), lane = tid & 63, wave = __builtin_amdgcn_readfirstlane(tid >> 6), gw = bx * NWAVES + wave; (void)tid; (void)lane; (void)gw
    unsigned char* ws = A.ws;
    if (threadIdx.x < 16) ((LAS unsigned*)(lds + LDS_ST))[threadIdx.x] = 0u;
    __syncthreads();
    XcdBarrier xbar = xcd_barrier_post((unsigned*)(ws + WS_BAR), (volatile LAS unsigned*)(lds + LDS_ST));
    { const int bx = blockIdx.x;
    REP(0) if (ON(10)) { WAVE_IDS(); convert_weights(A, 0, lds, gw, ngw, wave, lane, 0, CV_IT_IN + 512, true);
      convert_x(A, bx * NTHREADS + tid, G * NTHREADS); } }
    if (threadIdx.x == 0) { volatile LAS unsigned* st = (volatile LAS unsigned*)(lds + LDS_ST); unsigned nloc, nx; xcd_barrier_complete(xbar.bar, xbar.x, nloc, nx); st[0] = nloc; st[1] = nx;
        bool ok = (G == 256) && xbar.x < 8u;
#pragma unroll
        for (unsigned j = 0; j < 16; ++j) { const unsigned c = xb_ld(&xbar.bar[XB_XCNT(j)]); ok = ok && (c == (j < 8u ? 32u : 0u)); }
        st[3] = ok ? 1u : 0u; st[2] = ok ? st[2] * 8u + xbar.x : blockIdx.x; }
    __syncthreads();
    const int bx = __builtin_amdgcn_readfirstlane((int)((volatile LAS unsigned*)(lds + LDS_ST))[2]); const bool xloc = __builtin_amdgcn_readfirstlane((int)((volatile LAS unsigned*)(lds + LDS_ST))[3]) != 0;
    const int vcu = (G % 8 == 0) ? (bx % 8) * (G / 8) + bx / 8 : bx, xq = bx & 7, jq = bx >> 3;
#define GSYNC() do { if (xloc) xcc_local_barrier(xbar, (unsigned*)(ws + WS_GB), 32u); else xcd_barrier(xbar); } while (0)
    bf16* xb = (bf16*)(ws + A_XB); bf16* proj = (bf16*)(ws + A_PROJ); bf16* mix = (bf16*)(ws + A_MIX); bf16* vbuf = (bf16*)(ws + A_V);
    bf16* hb = (bf16*)(ws + A_H); bf16* yb = (bf16*)(ws + A_Y);

    SYNC();

    static_assert(DEPTH == 2 && W_END - WS_W <= (size_t)T * D * 4, "layer 1's weights live in the output buffer");
    for (int l = 0; l < DEPTH; ++l) {
        REP(1) { pg8::Gemm g{xb, (const bf16*)(wbuf(A, l) + (W_WIN - WS_W)), T, PP, 1024}; pg8::StaticOrder S; S.init(T, PP, G, bx); pg8::EpiStore E{proj, PP};
          const int kx = (l == 0) ? (jq & 7) : 0;
          for (int part = 0; part < 2; ++part) {
              if (part == 0) { S.i0 = 0; S.ni = kx; } else { S.i0 = kx; S.ni = 1 << 30; }
              pg8::gemm_phase<pg8::EpiStore, pg8::StaticOrder, true, true>(lds, g, S, E);
              if (part == 0 && l == 0) { WAVE_IDS(); __syncthreads(); convert_weights(A, 0, lds, gw, ngw, wave, lane, CV_IT_IN + 512, CV_NIT, false); convert_weights(A, 1, lds, gw, ngw, wave, lane, 0, CV_NIT, true); __syncthreads(); } } }
        GSYNC();
        REP(2) { const float lam_init = (l == 0) ? 0.2f : 0.35550907f, lam = ((const float*)(ws + WS_LAM))[l];
          const bool attn_first = (jq & 1) != 0;
          for (int ps = 0; ps < 2; ++ps) {
          if ((ps == 1) == attn_first) {
          REPS(0) if (ON(0)) for (int u = vcu; u < 256; u += G) ssd_a_unit(lds, A, l, proj, u >> 4, u & 15);
          REPS(1) if (ON(1)) for (int r = 0; r < 2; ++r) gla_a_unit(lds, A, l, proj, 2 * xq + r, jq);
          REPS(2) if (ON(2)) for (int u = vcu; u < 256; u += G) conv_unit(proj, mix, A.in[I_CONVW] + l * 768, u * 128);
          } else {
          REPS(3) if (ON(3)) { u32x4 qn[2] = {{0u, 0u, 0u, 0u}, {0u, 0u, 0u, 0u}}; bool first = true;
              for (int r = 0; r < 2; ++r) { const int b = 2 * xq + r, h = jq >> 3, s = jq & 7; const bool more = r == 0;
                  attn_unit(lds, proj, mix, b, h, 15 - s, lam, A.in[I_DIFF_NG] + l * 64, 1.0f - lam_init, first, b, h, s, qn); first = false;
                  attn_unit(lds, proj, mix, b, h, s, lam, A.in[I_DIFF_NG] + l * 64, 1.0f - lam_init, false, more ? b + 1 : b, h, more ? 15 - s : -1, qn); } }
          } } }
        GSYNC();
        REP(11) if (ON(6)) { const int tid = opaque_tid(); scan_phase(A, vcu * NTHREADS + tid, G * NTHREADS); }
        GSYNC();
        REP(3) { const bool gla_first = (jq & 1) != 0;
          for (int ps = 0; ps < 2; ++ps) {
            if ((ps == 1) == gla_first) { REPS(4) if (ON(4)) for (int r = 0; r < 2; ++r) ssd_main_unit(lds, A, l, proj, mix, 2 * xq + r, (jq >> 1) & 15, jq & 1); }
            else { REPS(5) if (ON(5)) for (int r = 0; r < 2; ++r) gla_main_unit(lds, A, l, proj, mix, 2 * xq + r, jq); } } }
        GSYNC();
        REP(4) { pg8::Gemm g{mix, (const bf16*)(wbuf(A, l) + (W_WO - WS_W)), T, 1024, 1024}; pg8::StaticOrder S; S.init(T, 1024, G, bx); pg8::EpiRes E{vbuf, xb, 1024, ALPHA};
          pg8::gemm_phase<pg8::EpiRes, pg8::StaticOrder, true, true>(lds, g, S, E); }
        GSYNC();
        REP(5) if (ON(7)) for (int blk = vcu; blk < 256; blk += G) p4_route(lds, A, l, blk);
        SYNC();
        const int nblk = ((const int*)(ws + WS_BLKEXP))[NBLK_MAX];
        REP(7) { if (MOE_FP8) { pg8::Gemm g{(const bf16*)(ws + A_X8), (const bf16*)(wbuf(A, l) + (W_WGU - WS_W)), NSLOT_MAX, NEXP * 1024, 512}; pg8::MoeOrder S; S.init((const int*)(ws + WS_BLKEXP), G, bx); S.ready = (unsigned*)(ws + WS_RDY) + (size_t)l * NBLK_MAX * 64; S.mode = 1; pg8::EpiSwiglu8 E{(unsigned char*)hb, xloc};
            pg8::gemm_phase_gather<pg8::EpiSwiglu8, pg8::MoeOrder, true>(lds, g, (const int*)(ws + WS_SLOTTOK), S, E); }
          else { pg8::Gemm g{(const bf16*)(ws + A_X1), (const bf16*)(wbuf(A, l) + (W_WGU - WS_W)), NSLOT_MAX, NEXP * 1024, 1024}; pg8::MoeOrder S; S.init((const int*)(ws + WS_BLKEXP), G, bx); pg8::EpiSwiglu E{hb};
            pg8::gemm_phase_gather<pg8::EpiSwiglu, pg8::MoeOrder, false>(lds, g, (const int*)(ws + WS_SLOTTOK), S, E); } }
        if (!MOE_FP8) SYNC();
        REP(8) { pg8::Gemm g{hb, (const bf16*)(wbuf(A, l) + (W_WD - WS_W)), NSLOT_MAX, NEXP * 1024, MOE_FP8 ? 256 : 512}; pg8::MoeOrder S; S.init((const int*)(ws + WS_BLKEXP), G, bx);
          if (MOE_FP8) { S.ready = (unsigned*)(ws + WS_RDY) + (size_t)l * NBLK_MAX * 64; S.mode = 2;
            if (G == 256) { volatile LAS unsigned* st = (volatile LAS unsigned*)(lds + LDS_ST);
              if (threadIdx.x < 64) { const int i = threadIdx.x, L = i * S.nj + S.j; const bool act = i < 32 && L < S.nu; unsigned v = 0u;
                  if (act) v = __hip_atomic_load(S.ready + 64 * (S.b0 + (L >> 2)), __ATOMIC_RELAXED, __HIP_MEMORY_SCOPE_AGENT);
                  const unsigned long long bal = __builtin_amdgcn_ballot_w64(act && v >= 32u);
                  __builtin_amdgcn_fence(__ATOMIC_ACQUIRE, "agent"); asm volatile("s_waitcnt vmcnt(0)" ::: "memory");
                  if (threadIdx.x == 0) st[4] = (unsigned)bal; }
              __syncthreads();
              S.rmask = (unsigned)__builtin_amdgcn_readfirstlane((int)st[4]); }
            pg8::EpiDown8 E{(unsigned char*)yb, (const float*)(ws + WS_SLOTGATE), 0.00390625f}; pg8::gemm_phase<pg8::EpiDown8, pg8::MoeOrder, true, true, true>(lds, g, S, E); }
          else { pg8::EpiDown E{yb, (const float*)(ws + WS_SLOTGATE), 1.0f}; pg8::gemm_phase<pg8::EpiDown, pg8::MoeOrder, true, true, false>(lds, g, S, E); } }
        SYNC();
        REP(9) if (ON(9)) { WAVE_IDS(); p8_ln2(A, l, l == DEPTH - 1, 4096 * xq + jq * NWAVES + wave, 256, 16, lane); }
        if (l + 1 < DEPTH) SYNC();
    }
}

extern "C" void kernel_launch(void* const* d_in, const int* in_sizes, int n_in, void* d_out, int out_size, void* d_ws, size_t ws_size, hipStream_t stream) {
    static int grid = 0;
    if (grid == 0) {
        if (n_in != N_IN || in_sizes[0] != T * D || out_size != T * D || ws_size < WS_NEED) { fprintf(stderr, "kernel_launch: unexpected shapes (n_in %d, ws %zu < %zu)\n", n_in, ws_size, (size_t)WS_NEED); grid = -1; return; }
        int dev = 0, cus = 0, per_cu = 0;
        (void)hipGetDevice(&dev); (void)hipDeviceGetAttribute(&cus, hipDeviceAttributeMultiprocessorCount, dev);
        if (hipFuncSetAttribute((const void*)fwd_kernel, hipFuncAttributeMaxDynamicSharedMemorySize, LDS_BYTES) != hipSuccess) { fprintf(stderr, "kernel_launch: hipFuncSetAttribute failed\n"); }
        (void)hipOccupancyMaxActiveBlocksPerMultiprocessor(&per_cu, (const void*)fwd_kernel, NTHREADS, LDS_BYTES);
        (void)hipGetLastError();
        grid = (cus >= 256 && per_cu >= 1) ? 256 : -1;
        if (grid < 0) { fprintf(stderr, "kernel_launch: needs 256 CUs with one resident workgroup each (CUs %d, blocks per CU %d)\n", cus, per_cu); return; }
    }
    if (grid < 0) return;
    if (hipMemsetAsync((char*)d_ws + WS_BAR, 0, 16384 + (size_t)DEPTH * NBLK_MAX * 256 + 4096, stream) != hipSuccess) { fprintf(stderr, "kernel_launch: memset failed\n"); return; }
    Args a{};
    for (int i = 0; i < N_IN; ++i) a.in[i] = (const float*)d_in[i];
    a.out = (float*)d_out; a.ws = (unsigned char*)d_ws;
    void* args[] = {&a};
    const hipError_t e = hipLaunchCooperativeKernel((const void*)fwd_kernel, dim3(grid), dim3(NTHREADS), args, LDS_BYTES, stream);
    if (e != hipSuccess) fprintf(stderr, "kernel_launch: cooperative launch failed: %s (grid %d)\n", hipGetErrorString(e), grid);
}
```
